# Optimizing an MI355X kernel written in HIP

```python
import math
import jax
import jax.numpy as jnp
from jax import lax
import numpy as np

D_MODEL = 2048
BATCH = 8
SEQ = 2048
DEPTH = 2

GRID_W = 64
CTX_LEN = 256
EPS = 1e-6
F32 = jnp.float32
ROPE_THETA = 10000.0
HEAD_DIM = 128
MIX_W = D_MODEL // 2
Q_BLOCK = 128

A_HEADS = MIX_W // HEAD_DIM
A_KV_HEADS = A_HEADS // 4
WINDOW = 128

B_HEADS = MIX_W // HEAD_DIM
B_DIM = HEAD_DIM // 2
B_VDIM = 2 * B_DIM

C_WIDTH = MIX_W
C_BLOCKS = 8
C_BLOCK = C_WIDTH // C_BLOCKS
CONV_W = 4
CONV_LEFT = 2
LRU_C = 8.0

D_HEADS = MIX_W // HEAD_DIM
D_KDIM = HEAD_DIM
D_VDIM = HEAD_DIM
D_CHUNK = 64

N_BRANCH = 4
N_EXPERTS = 16
N_GROUPS = 4
TOP_K = 2
D_FF = D_MODEL // 4

A_Q = A_HEADS * HEAD_DIM
A_KV = A_KV_HEADS * HEAD_DIM
B_QK = B_HEADS * 2 * B_DIM
B_V = B_HEADS * B_VDIM
D_K = D_HEADS * D_KDIM
D_V = D_HEADS * D_VDIM
SPLITS = (A_Q, A_KV, A_KV, B_QK, B_QK, B_V, C_WIDTH, C_WIDTH, D_K, D_K, D_K, D_V, D_V, N_BRANCH * D_MODEL)
IN_W = A_Q + 2 * A_KV + 2 * B_QK + B_V + 2 * C_WIDTH + 3 * D_K + 2 * D_V + N_BRANCH * D_MODEL

kernel_name = 'hybrid_gated_parallel_mixer_moe_trunk'


def rms_norm(x, g):
    xf = x.astype(F32)
    y = xf * lax.rsqrt(jnp.mean(xf * xf, axis=-1, keepdims=True) + EPS)
    return (y * g.astype(F32)).astype(x.dtype)


def modulate(x, g, shift, scale):
    return rms_norm(x, g) * (1 + scale) + shift


def flip_seq(t):
    return jnp.flip(t, axis=1)


def rope_1d(x, pos):
    half = x.shape[-1] // 2
    inv = ROPE_THETA ** (-jnp.arange(half, dtype=F32) / half)
    ang = pos.astype(F32)[:, None] * inv[None, :]
    bshape = (1, x.shape[1]) + (1,) * (x.ndim - 3) + (half,)
    cos = jnp.cos(ang).reshape(bshape)
    sin = jnp.sin(ang).reshape(bshape)
    xf = x.astype(F32)
    x1, x2 = xf[..., :half], xf[..., half:]
    return jnp.concatenate([x1 * cos - x2 * sin, x2 * cos + x1 * sin], axis=-1).astype(x.dtype)


def rope_2d(x, rows, cols):
    half = x.shape[-1] // 2
    return jnp.concatenate([rope_1d(x[..., :half], rows), rope_1d(x[..., half:], cols)], axis=-1)


def window_attention(qc, kc, vc, ql, kl, vl, sink, ctx_out):
    Bn, L, H, d = ql.shape
    Hk = kl.shape[2]
    G = H // Hk
    Lc = kc.shape[1]
    nb = L // Q_BLOCK
    scale = d ** -0.5
    qb = ql.reshape(Bn, nb, Q_BLOCK, Hk, G, d)

    def band(t):
        tp = jnp.pad(t, ((0, 0), (Q_BLOCK, Q_BLOCK), (0, 0), (0, 0))).reshape(Bn, nb + 2, Q_BLOCK, Hk, d)
        return jnp.concatenate([tp[:, :-2], tp[:, 1:-1], tp[:, 2:]], axis=2)

    kw, vw = band(kl), band(vl)
    qpos = jnp.arange(nb)[:, None] * Q_BLOCK + jnp.arange(Q_BLOCK)[None, :]
    kpos = jnp.arange(nb)[:, None] * Q_BLOCK - Q_BLOCK + jnp.arange(3 * Q_BLOCK)[None, :]
    valid = ((jnp.abs(kpos[:, None, :] - qpos[:, :, None]) <= WINDOW)
             & (kpos[:, None, :] >= 0) & (kpos[:, None, :] < L))
    s_loc = jnp.einsum('bnqhgd,bnkhd->bhgnqk', qb, kw).astype(F32) * scale
    s_loc = jnp.where(valid, s_loc, -jnp.inf)
    s_ctx = jnp.einsum('bnqhgd,bchd->bhgnqc', qb, kc).astype(F32) * scale
    sk = sink.astype(F32).reshape(1, Hk, G, 1, 1, 1)
    s_sink = jnp.broadcast_to(sk, s_ctx.shape[:-1] + (1,))
    p = jax.nn.softmax(jnp.concatenate([s_loc, s_ctx, s_sink], axis=-1), axis=-1)
    k3 = 3 * Q_BLOCK
    p_loc = p[..., :k3].astype(vl.dtype)
    p_ctx = p[..., k3:k3 + Lc].astype(vl.dtype)
    o = jnp.einsum('bhgnqk,bnkhd->bnqhgd', p_loc, vw) + jnp.einsum('bhgnqc,bchd->bnqhgd', p_ctx, vc)
    o_lat = o.reshape(Bn, L, H * d)
    if not ctx_out:
        return None, o_lat
    qcg = qc.reshape(Bn, Lc, Hk, G, d)
    sc = jnp.einsum('bqhgd,bkhd->bhgqk', qcg, kc).astype(F32) * scale
    sc_sink = jnp.broadcast_to(sink.astype(F32).reshape(1, Hk, G, 1, 1), sc.shape[:-1] + (1,))
    pc = jax.nn.softmax(jnp.concatenate([sc, sc_sink], axis=-1), axis=-1)
    oc = jnp.einsum('bhgqk,bkhd->bqhgd', pc[..., :Lc].astype(vc.dtype), vc).reshape(Bn, Lc, H * d)
    return oc, o_lat


def diff_attention(qc, kc, vc, ql, kl, vl, lam, lam_init, subln_g, ctx_out):
    scale = B_DIM ** -0.5

    def attend(q, k, v):
        s = jnp.einsum('bqhcd,bkhcd->bhcqk', q, k).astype(F32) * scale
        p = jax.nn.softmax(s, axis=-1)
        a = (p[:, :, 0] - lam * p[:, :, 1]).astype(v.dtype)
        return jnp.einsum('bhqk,bkhd->bqhd', a, v)

    def post(o):
        y = rms_norm(o, subln_g) * (1.0 - lam_init)
        return y.reshape(o.shape[0], o.shape[1], B_HEADS * B_VDIM)

    k_all = jnp.concatenate([kc, kl], axis=1)
    v_all = jnp.concatenate([vc, vl], axis=1)
    Bn, L = ql.shape[:2]
    nb = L // Q_BLOCK
    qblocks = jnp.moveaxis(ql.reshape((Bn, nb, Q_BLOCK) + ql.shape[2:]), 1, 0)
    o = lax.map(lambda qb: attend(qb, k_all, v_all), qblocks)
    o_lat = jnp.moveaxis(o, 0, 1).reshape(Bn, L, B_HEADS, B_VDIM)
    o_ctx = post(attend(qc, kc, vc)) if ctx_out else None
    return o_ctx, post(o_lat)


def centred_conv(x, w, b):
    L = x.shape[1]
    xp = jnp.pad(x, ((0, 0), (CONV_LEFT, CONV_W - 1 - CONV_LEFT), (0, 0)))
    out = b
    for tap in range(CONV_W):
        out = out + xp[:, tap:tap + L] * w[tap]
    return out


def block_diag(x, w, b):
    Bn, L, _ = x.shape
    y = jnp.einsum('blnc,ncd->blnd', x.reshape(Bn, L, C_BLOCKS, C_BLOCK), w)
    return y.reshape(Bn, L, C_WIDTH) + b


def linear_scan(a, u, h0):
    u = u.at[:, 0].add(a[:, 0] * h0)

    def comb(left, right):
        return (left[0] * right[0], right[0] * left[1] + right[1])

    return lax.associative_scan(comb, (a, u), axis=1)[1]


def rglru_mixer(xc, yc, xl, yl, conv_w, conv_b, w_r, b_r, w_i, b_i, lam, ctx_out):
    Lc = xc.shape[1]
    u = jnp.concatenate([centred_conv(xc, conv_w, conv_b), centred_conv(xl, conv_w, conv_b)], axis=1)
    hc_dirs, hl_dirs = [], []
    for d in range(2):
        r = jax.nn.sigmoid(block_diag(u, w_r[d], b_r[d]).astype(F32))
        i = jax.nn.sigmoid(block_diag(u, w_i[d], b_i[d]).astype(F32))
        log_a = -LRU_C * r * jax.nn.softplus(-lam[d].astype(F32))
        a = jnp.exp(log_a)
        v = jnp.sqrt(-jnp.expm1(2.0 * log_a)) * i * u.astype(F32)
        ac, al, vc, vl = a[:, :Lc], a[:, Lc:], v[:, :Lc], v[:, Lc:]
        if d == 1:
            ac, al, vc, vl = flip_seq(ac), flip_seq(al), flip_seq(vc), flip_seq(vl)
        hc = linear_scan(ac, vc, jnp.zeros_like(vc[:, 0]))
        hl = linear_scan(al, vl, hc[:, -1])
        if d == 1:
            hc, hl = flip_seq(hc), flip_seq(hl)
        hc_dirs.append(hc)
        hl_dirs.append(hl)
    out_l = (hl_dirs[0] + hl_dirs[1]).astype(yl.dtype) * jax.nn.gelu(yl)
    out_c = (hc_dirs[0] + hc_dirs[1]).astype(yc.dtype) * jax.nn.gelu(yc) if ctx_out else None
    return out_c, out_l


def chunk_gla(q, k, v, g, s0):
    Bn, L, H, _ = q.shape
    V = v.shape[-1]
    C = D_CHUNK
    n = L // C

    def chunks(t):
        return t.astype(F32).reshape(Bn, n, C, H, t.shape[-1]).transpose(1, 0, 3, 2, 4)

    q, k, v, g = chunks(q), chunks(k), chunks(v), chunks(g)
    b = jnp.cumsum(g, axis=3)
    causal = jnp.tril(jnp.ones((C, C), dtype=bool))[:, :, None]

    def step(S, xs):
        qn, kn, vn, bn = xs
        rel = bn[:, :, :, None, :] - bn[:, :, None, :, :]
        decay = jnp.exp(jnp.where(causal, rel, -jnp.inf))
        att = jnp.einsum('bhik,bhijk,bhjk->bhij', qn, decay, kn)
        blast = bn[:, :, -1:, :]
        o = jnp.einsum('bhij,bhjv->bhiv', att, vn) + jnp.einsum('bhik,bhkv->bhiv', qn * jnp.exp(bn), S)
        S = jnp.exp(blast[:, :, 0, :, None]) * S + jnp.einsum('bhjk,bhjv->bhkv', kn * jnp.exp(blast - bn), vn)
        return S, o

    S, o = lax.scan(step, s0.astype(F32), (q, k, v, b))
    return o.transpose(1, 0, 3, 2, 4).reshape(Bn, L, H, V), S


def hgrn2_mixer(qc, fc, ic, gc, ql, fl, il, gl, lb, onorm_g, ctx_out):
    Bn = ql.shape[0]
    oc_dirs, ol_dirs = [], []
    for d in range(2):
        lbd = lb[d].astype(F32).reshape(D_HEADS, D_KDIM)

        def gates(z):
            zf = z.astype(F32)
            log_f = jnp.log(lbd + (1.0 - lbd) * jax.nn.sigmoid(zf))
            return log_f, (1.0 - lbd) * jax.nn.sigmoid(-zf)

        gfc, kc = gates(fc[d])
        gfl, kl = gates(fl[d])
        seq_c = (qc, kc, ic, gfc)
        seq_l = (ql, kl, il, gfl)
        if d == 1:
            seq_c = tuple(flip_seq(t) for t in seq_c)
            seq_l = tuple(flip_seq(t) for t in seq_l)
        s0 = jnp.zeros((Bn, D_HEADS, D_KDIM, D_VDIM), F32)
        oc, s_ctx = chunk_gla(seq_c[0], seq_c[1], seq_c[2], seq_c[3], s0)
        ol, _ = chunk_gla(seq_l[0], seq_l[1], seq_l[2], seq_l[3], s_ctx)
        if d == 1:
            oc, ol = flip_seq(oc), flip_seq(ol)
        oc_dirs.append(oc)
        ol_dirs.append(ol)

    def finish(o, g):
        y = rms_norm(o.astype(g.dtype), onorm_g) * jax.nn.silu(g)
        return y.reshape(y.shape[0], y.shape[1], D_V)

    out_l = finish(ol_dirs[0] + ol_dirs[1], gl)
    out_c = finish(oc_dirs[0] + oc_dirs[1], gc) if ctx_out else None
    return out_c, out_l


def moe_ffn(h, w_router, b_router, w_gate, w_up, w_down):
    shape = h.shape
    t = h.reshape(-1, shape[-1])
    n_tok = t.shape[0]
    per = N_EXPERTS // N_GROUPS
    aff = jax.nn.sigmoid(jnp.dot(t, w_router).astype(F32))
    sel = aff + b_router.astype(F32)
    group_score = jnp.sum(lax.top_k(sel.reshape(n_tok, N_GROUPS, per), TOP_K)[0], axis=-1)
    group = jnp.argmax(group_score, axis=-1)
    in_group = (jnp.arange(N_EXPERTS) // per)[None, :] == group[:, None]
    _, idx = lax.top_k(jnp.where(in_group, sel, -jnp.inf), TOP_K)
    w = jnp.take_along_axis(aff, idx, axis=-1)
    w = w / jnp.sum(w, axis=-1, keepdims=True)
    gates = jnp.sum(jax.nn.one_hot(idx, N_EXPERTS, dtype=F32) * w[..., None], axis=1).astype(t.dtype)
    y = jnp.zeros_like(t)
    for e in range(N_EXPERTS):
        hid = jax.nn.silu(jnp.dot(t, w_gate[e])) * jnp.dot(t, w_up[e])
        y = y + gates[:, e:e + 1] * jnp.dot(hid, w_down[e])
    return y.reshape(shape)


def parallel_mixers(hc, hl, rows, cols, lp, layer_idx, ctx_out):
    split_at = np.cumsum(SPLITS)[:-1].tolist()
    (aqc, akc, avc, bqc, bkc, bvc, cxc, cyc, dqc, dffc, dfbc, dic, dgc, gtc) = jnp.split(jnp.dot(hc, lp['w_in']), split_at, axis=-1)
    (aql, akl, avl, bql, bkl, bvl, cxl, cyl, dql, dffl, dfbl, dil, dgl, gtl) = jnp.split(jnp.dot(hl, lp['w_in']), split_at, axis=-1)

    def heads(t, *shape):
        return t.reshape(t.shape[:2] + shape)

    def pos2d(t):
        return rope_2d(t, rows, cols)

    qa_c = rms_norm(heads(aqc, A_HEADS, HEAD_DIM), lp['qn_a'])
    ka_c = rms_norm(heads(akc, A_KV_HEADS, HEAD_DIM), lp['kn_a'])
    qa_l = pos2d(rms_norm(heads(aql, A_HEADS, HEAD_DIM), lp['qn_a']))
    ka_l = pos2d(rms_norm(heads(akl, A_KV_HEADS, HEAD_DIM), lp['kn_a']))
    oa_c, oa_l = window_attention(qa_c, ka_c, heads(avc, A_KV_HEADS, HEAD_DIM),
                                  qa_l, ka_l, heads(avl, A_KV_HEADS, HEAD_DIM), lp['sink_a'], ctx_out)

    qb_c = rms_norm(heads(bqc, B_HEADS, 2, B_DIM), lp['qn_b'])
    kb_c = rms_norm(heads(bkc, B_HEADS, 2, B_DIM), lp['kn_b'])
    qb_l = pos2d(rms_norm(heads(bql, B_HEADS, 2, B_DIM), lp['qn_b']))
    kb_l = pos2d(rms_norm(heads(bkl, B_HEADS, 2, B_DIM), lp['kn_b']))
    lq1, lk1, lq2, lk2 = lp['lam_b'].astype(F32)
    lam_init = 0.8 - 0.6 * math.exp(-0.3 * layer_idx)
    lam = jnp.exp(jnp.sum(lq1 * lk1)) - jnp.exp(jnp.sum(lq2 * lk2)) + lam_init
    ob_c, ob_l = diff_attention(qb_c, kb_c, heads(bvc, B_HEADS, B_VDIM), qb_l, kb_l, heads(bvl, B_HEADS, B_VDIM),
                                lam, lam_init, lp['subln_b'], ctx_out)

    oc_c, oc_l = rglru_mixer(cxc, cyc, cxl, cyl, lp['conv_w'], lp['conv_b'], lp['w_rg'], lp['b_rg'],
                             lp['w_ig'], lp['b_ig'], lp['lru_lambda'], ctx_out)

    od_c, od_l = hgrn2_mixer(heads(dqc, D_HEADS, D_KDIM), (heads(dffc, D_HEADS, D_KDIM), heads(dfbc, D_HEADS, D_KDIM)),
                             heads(dic, D_HEADS, D_VDIM), heads(dgc, D_HEADS, D_VDIM),
                             heads(dql, D_HEADS, D_KDIM), (heads(dffl, D_HEADS, D_KDIM), heads(dfbl, D_HEADS, D_KDIM)),
                             heads(dil, D_HEADS, D_VDIM), heads(dgl, D_HEADS, D_VDIM),
                             lp['lb'], lp['onorm_d'], ctx_out)

    def merge(outs, gate_pre):
        o = jnp.stack(outs, axis=2)
        g = jax.nn.sigmoid(gate_pre.reshape(gate_pre.shape[:2] + (N_BRANCH, D_MODEL)))
        y = jnp.sum(g * jnp.einsum('blnc,ncd->blnd', o, lp['w_branch']), axis=2)
        return jnp.dot(y, lp['w_out'])

    out_l = merge((oa_l, ob_l, oc_l, od_l), gtl)
    out_c = merge((oa_c, ob_c, oc_c, od_c), gtc) if ctx_out else None
    return out_c, out_l


def trunk_layer(xc, xl, c, c_ctx, rows, cols, lp, w_router, b_router, layer_idx, ctx_out):
    mod_l = (jnp.dot(jax.nn.silu(c), lp['w_ada']) + lp['b_ada'])[:, None, :]
    mod_c = (jnp.dot(jax.nn.silu(c_ctx), lp['w_ada']) + lp['b_ada'])[None, None, :]
    sh1l, sc1l, g1l, sh2l, sc2l, g2l = jnp.split(mod_l, 6, axis=-1)
    sh1c, sc1c, g1c, sh2c, sc2c, g2c = jnp.split(mod_c, 6, axis=-1)
    mix_c, mix_l = parallel_mixers(modulate(xc, lp['norm1'], sh1c, sc1c), modulate(xl, lp['norm1'], sh1l, sc1l),
                                   rows, cols, lp, layer_idx, ctx_out)
    xl = xl + g1l * mix_l
    xl = xl + g2l * moe_ffn(modulate(xl, lp['norm2'], sh2l, sc2l), w_router, b_router, lp['w_gate'], lp['w_up'], lp['w_down'])
    if ctx_out:
        xc = xc + g1c * mix_c
        xc = xc + g2c * moe_ffn(modulate(xc, lp['norm2'], sh2c, sc2c), w_router, b_router, lp['w_gate'], lp['w_up'], lp['w_down'])
    return xc, xl


def setup_inputs(seed: int = 0) -> dict:
    key = jax.random.key(seed)
    keys = jax.random.split(key, 40)
    counter = [0]

    def nrm(shape, s):
        k = keys[counter[0]]
        counter[0] += 1
        return jax.random.normal(k, shape, F32) * s

    L = DEPTH
    x = nrm((BATCH, SEQ, D_MODEL), 1.0)
    c = nrm((BATCH, D_MODEL), 1.0)
    ctx = nrm((BATCH, CTX_LEN, D_MODEL), 1.0)
    c_ctx = nrm((D_MODEL,), 1.0)
    w_ada = nrm((L, D_MODEL, 6 * D_MODEL), 0.5 * D_MODEL ** -0.5)
    b_ada = nrm((L, 6 * D_MODEL), 0.02)
    norm1_g = 1.0 + nrm((L, D_MODEL), 0.02)
    norm2_g = 1.0 + nrm((L, D_MODEL), 0.02)
    w_in = nrm((L, D_MODEL, IN_W), D_MODEL ** -0.5)
    qn_a = 1.0 + nrm((L, HEAD_DIM), 0.02)
    kn_a = 1.0 + nrm((L, HEAD_DIM), 0.02)
    sink_a = nrm((L, A_HEADS), 0.5)
    qn_b = 1.0 + nrm((L, B_DIM), 0.02)
    kn_b = 1.0 + nrm((L, B_DIM), 0.02)
    lam_b = nrm((L, 4, B_DIM), 0.1)
    subln_b = 1.0 + nrm((L, B_VDIM), 0.02)
    conv_w = nrm((L, CONV_W, C_WIDTH), CONV_W ** -0.5)
    conv_b = nrm((L, C_WIDTH), 0.02)
    w_rg = nrm((L, 2, C_BLOCKS, C_BLOCK, C_BLOCK), C_BLOCK ** -0.5)
    b_rg = nrm((L, 2, C_WIDTH), 0.02)
    w_ig = nrm((L, 2, C_BLOCKS, C_BLOCK, C_BLOCK), C_BLOCK ** -0.5)
    b_ig = nrm((L, 2, C_WIDTH), 0.02)
    a0 = jax.random.uniform(keys[39], (L, 2, C_WIDTH), F32, 0.9, 0.999)
    lru_lambda = jnp.log(a0) - jnp.log1p(-a0)
    lb_d = nrm((L, 2, D_K), 0.5)
    onorm_d = 1.0 + nrm((L, D_VDIM), 0.02)
    w_branch = nrm((L, N_BRANCH, MIX_W, D_MODEL), MIX_W ** -0.5)
    w_out = nrm((L, D_MODEL, D_MODEL), D_MODEL ** -0.5)
    w_router = nrm((D_MODEL, N_EXPERTS), D_MODEL ** -0.5)
    b_router = nrm((N_EXPERTS,), 0.01)
    w_gate = nrm((L, N_EXPERTS, D_MODEL, D_FF), D_MODEL ** -0.5)
    w_up = nrm((L, N_EXPERTS, D_MODEL, D_FF), D_MODEL ** -0.5)
    w_down = nrm((L, N_EXPERTS, D_FF, D_MODEL), D_FF ** -0.5)
    return {'x': x, 'c': c, 'ctx': ctx, 'c_ctx': c_ctx, 'w_ada': w_ada, 'b_ada': b_ada,
            'norm1_g': norm1_g, 'norm2_g': norm2_g, 'w_in': w_in, 'qn_a': qn_a, 'kn_a': kn_a,
            'sink_a': sink_a, 'qn_b': qn_b, 'kn_b': kn_b, 'lam_b': lam_b, 'subln_b': subln_b,
            'conv_w': conv_w, 'conv_b': conv_b, 'w_rg': w_rg, 'b_rg': b_rg, 'w_ig': w_ig, 'b_ig': b_ig,
            'lru_lambda': lru_lambda, 'lb_d': lb_d, 'onorm_d': onorm_d, 'w_branch': w_branch,
            'w_out': w_out, 'w_router': w_router, 'b_router': b_router, 'w_gate': w_gate,
            'w_up': w_up, 'w_down': w_down}


def reference(x, c, ctx, c_ctx, w_ada, b_ada, norm1_g, norm2_g, w_in, qn_a, kn_a, sink_a, qn_b, kn_b,
              lam_b, subln_b, conv_w, conv_b, w_rg, b_rg, w_ig, b_ig, lru_lambda, lb_d, onorm_d,
              w_branch, w_out, w_router, b_router, w_gate, w_up, w_down):
    n_rows = x.shape[1] // GRID_W
    rows = jnp.repeat(jnp.arange(n_rows), GRID_W)
    cols = jnp.tile(jnp.arange(GRID_W), n_rows)
    lb_w = jax.nn.softmax(lb_d.astype(F32), axis=0)
    lb_all = jnp.cumsum(lb_w, axis=0) - lb_w[0:1]
    xc, xl = ctx, x
    for l in range(DEPTH):
        lp = {'w_ada': w_ada[l], 'b_ada': b_ada[l], 'norm1': norm1_g[l], 'norm2': norm2_g[l],
              'w_in': w_in[l], 'qn_a': qn_a[l], 'kn_a': kn_a[l], 'sink_a': sink_a[l],
              'qn_b': qn_b[l], 'kn_b': kn_b[l], 'lam_b': lam_b[l], 'subln_b': subln_b[l],
              'conv_w': conv_w[l], 'conv_b': conv_b[l], 'w_rg': w_rg[l], 'b_rg': b_rg[l],
              'w_ig': w_ig[l], 'b_ig': b_ig[l], 'lru_lambda': lru_lambda[l], 'lb': lb_all[l],
              'onorm_d': onorm_d[l], 'w_branch': w_branch[l], 'w_out': w_out[l],
              'w_gate': w_gate[l], 'w_up': w_up[l], 'w_down': w_down[l]}
        xc, xl = trunk_layer(xc, xl, c, c_ctx, rows, cols, lp, w_router, b_router, l, l < DEPTH - 1)
    return xl
```

```cpp
#include <hip/hip_runtime.h>
#include <cstdio>
#include <cstdint>

#ifndef N_LAUNCH_MODE
#define N_LAUNCH_MODE 1
#endif
#ifndef ENABLE_C
#define ENABLE_C 1
#endif
#ifndef ENABLE_D
#define ENABLE_D 1
#endif
#ifndef ENABLE_MIX
#define ENABLE_MIX 1
#endif

#define LAS __attribute__((address_space(3)))
#define GAS __attribute__((address_space(1)))
typedef unsigned short bf16_t;
typedef short bf16x8 __attribute__((ext_vector_type(8)));
typedef short bf16x4 __attribute__((ext_vector_type(4)));
typedef float f32x2 __attribute__((ext_vector_type(2)));
typedef float f32x4 __attribute__((ext_vector_type(4)));
typedef float f32x16 __attribute__((ext_vector_type(16)));
typedef unsigned u32x2 __attribute__((ext_vector_type(2)));
typedef unsigned u32x4 __attribute__((ext_vector_type(4)));

constexpr int D = 2048, NB = 8, SEQ = 2048, CTXL = 256, DEPTH = 2;
constexpr int NCTX = NB * CTXL, NLAT = NB * SEQ, NTOK = NCTX + NLAT;
constexpr int N1 = 11776, NG = 8192, INW = N1 + NG;
constexpr int NEXP = 16, DFF = 512;
constexpr int NWAVES = 8, NTHR = 512;
constexpr int C_AQ = 0, C_AK = 1024, C_AV = 1280, C_BQ = 1536, C_BK = 2560, C_BV = 3584, C_CX = 4608, C_CY = 5632, C_DQ = 6656, C_DFF = 7680, C_DFB = 8704, C_DI = 9728, C_DG = 10752;

constexpr size_t MiB = 1u << 20;
constexpr size_t WS_CTL = 0, CTL_ZERO_BYTES = 2 * MiB;
constexpr size_t WS_MOD = 1 * MiB;
constexpr size_t WS_WIN = 2 * MiB;
constexpr size_t WS_WBR = 158 * MiB;
constexpr size_t WS_WOUT = 190 * MiB;
constexpr size_t WS_WGU = 206 * MiB;
constexpr size_t WS_WD = 334 * MiB;
constexpr size_t WS_H = 398 * MiB;
constexpr size_t WS_Y = 470 * MiB;
constexpr size_t WS_P1 = 542 * MiB;
constexpr size_t WS_O = 956 * MiB;
constexpr size_t WS_XC = 1100 * MiB;
constexpr size_t WS_HID = 1116 * MiB;
constexpr size_t WS_LIST = 1152 * MiB;
constexpr size_t WS_RW = 1154 * MiB;
constexpr size_t WS_DSCR = 1156 * MiB;
constexpr size_t WS_HB = 1192 * MiB;
constexpr size_t WS_END = 1228 * MiB;
constexpr int CW_BAR = 4096;
constexpr int CW_CNT = 8192;
constexpr int CW_QUEUE = 8448;

constexpr int LDS_BYTES = 147456;
constexpr int MISC_OFF = 131072 + 8192;

typedef __bf16 bf16x2_t __attribute__((ext_vector_type(2)));
__device__ __forceinline__ unsigned cvt_pk_bf16(float lo, float hi) { const bf16x2_t r = __builtin_convertvector((f32x2){lo, hi}, bf16x2_t); return __builtin_bit_cast(unsigned, r); }
__device__ __forceinline__ float bf_lo(unsigned u) { return __uint_as_float(u << 16); }
__device__ __forceinline__ float bf_hi(unsigned u) { return __uint_as_float(u & 0xffff0000u); }
__device__ __forceinline__ float bf2f(bf16_t b) { return __uint_as_float(((unsigned)b) << 16); }
__device__ __forceinline__ float shx(float v, int mask, int lane) { return __builtin_bit_cast(float, __builtin_amdgcn_ds_bpermute((lane ^ mask) << 2, __builtin_bit_cast(int, v))); }
__device__ __forceinline__ float wave_sum(float v, int lane) {
#pragma unroll
    for (int o = 1; o < 64; o <<= 1) v += shx(v, o, lane);
    return v;
}
__device__ __forceinline__ float wave_max(float v, int lane) {
#pragma unroll
    for (int o = 1; o < 64; o <<= 1) v = fmaxf(v, shx(v, o, lane));
    return v;
}
__device__ __forceinline__ float sigmoidf_(float x) { return __builtin_amdgcn_rcpf(1.0f + __expf(-x)); }
#define LDS_WAIT() asm volatile("s_waitcnt lgkmcnt(0)" ::: "memory")
#define VM_WAIT() asm volatile("s_waitcnt vmcnt(0)" ::: "memory")

__device__ __forceinline__ int opaque_int(int x);
template <class T> __device__ __forceinline__ T* opaque_ptr(T* p) { return (T*)((unsigned char*)p + opaque_int(0)); }
__device__ __forceinline__ int opaque_int(int x) { asm volatile("" : "+v"(x)); return __builtin_amdgcn_readfirstlane(x); }
#define XB_TMO      128
#define XB_XCNT(j)  (256  + 64 * (j))
#define XB_XSUB(j)  (1280 + 64 * (j))
#define XB_XGEN(j)  (2304 + 64 * (j))
#define XB_TOP      3328
#define XB_TOPGEN   3392
#define XCD_BAR_WORDS 3456
#define XB_SPIN_CAP (1u << 22)
__device__ __forceinline__ unsigned xb_ld(unsigned* p)              { return __hip_atomic_load(p, __ATOMIC_RELAXED, __HIP_MEMORY_SCOPE_AGENT); }
__device__ __forceinline__ unsigned xb_add(unsigned* p, unsigned v) { return __hip_atomic_fetch_add(p, v, __ATOMIC_RELAXED, __HIP_MEMORY_SCOPE_AGENT); }
__device__ __forceinline__ unsigned xb_xcc_id() { return (unsigned)__builtin_amdgcn_s_getreg((3 << 11) | 20) & 0xFu; }
#define XB_SPIN(cond, bar) do { unsigned _sp = 0; while (cond) { __builtin_amdgcn_s_sleep(1); \
    if ((++_sp & 255u) == 0u) { if (xb_ld(&(bar)[XB_TMO])) break; if (_sp > XB_SPIN_CAP) { atomicAdd(&(bar)[XB_TMO], 1u); break; } } } } while (0)
struct XcdBarrier { unsigned* bar; unsigned x; volatile LAS unsigned* st; };
__device__ __forceinline__ XcdBarrier xcd_barrier_post(unsigned* bar, volatile LAS unsigned* st) {
    XcdBarrier b; b.bar = bar; b.x = xb_xcc_id(); b.st = st;
    if (threadIdx.x == 0) (void)xb_add(&bar[XB_XCNT(b.x)], 1u);
    return b;
}
__device__ __forceinline__ void xcd_barrier_complete(unsigned* bar, unsigned x, unsigned& nloc, unsigned& nx) {
    const unsigned G = gridDim.x * gridDim.y * gridDim.z;
    unsigned sum, cnt, mine, sp = 0u;
    for (;;) {
        sum = 0u; cnt = 0u; mine = 0u;
#pragma unroll
        for (unsigned j = 0; j < 16; ++j) { const unsigned c = xb_ld(&bar[XB_XCNT(j)]); sum += c; cnt += (c > 0u) ? 1u : 0u; mine = (j == x) ? c : mine; }
        if (sum == G) break;
        __builtin_amdgcn_s_sleep(1);
        if ((++sp & 255u) == 0u) { if (xb_ld(&bar[XB_TMO])) break; if (sp > XB_SPIN_CAP) { atomicAdd(&bar[XB_TMO], 1u); break; } }
    }
    nloc = mine > 0u ? mine : 1u; nx = cnt > 0u ? cnt : 1u;
}
__device__ __forceinline__ void xcd_barrier(const XcdBarrier& b) {
    asm volatile("s_waitcnt vmcnt(0)" ::: "memory");
    __syncthreads();
    if (threadIdx.x == 0) {
        unsigned* bar = opaque_ptr(b.bar);
        __builtin_amdgcn_s_waitcnt(0);
        unsigned nloc = b.st[0], nx = b.st[1];
        if (nloc == 0u) { xcd_barrier_complete(bar, b.x, nloc, nx); b.st[0] = nloc; b.st[1] = nx; }
        const unsigned old = xb_add(&bar[XB_XSUB(b.x)], 1u);
        const unsigned gen = old / nloc;
        if (old + 1u == (gen + 1u) * nloc) {
            __builtin_amdgcn_fence(__ATOMIC_RELEASE, "agent");
            asm volatile("s_waitcnt vmcnt(0)" ::: "memory");
            const unsigned og = xb_add(&bar[XB_TOP], 1u);
            const unsigned tg = og / nx;
            if (og + 1u == (tg + 1u) * nx) xb_add(&bar[XB_TOPGEN], 1u);
            else XB_SPIN(xb_ld(&bar[XB_TOPGEN]) == tg, bar);
            __builtin_amdgcn_fence(__ATOMIC_ACQUIRE, "agent");
            xb_add(&bar[XB_XGEN(b.x)], 1u);
            asm volatile("s_waitcnt vmcnt(0)" ::: "memory");
        } else {
            XB_SPIN(xb_ld(&bar[XB_XGEN(b.x)]) == gen, bar);
            __builtin_amdgcn_fence(__ATOMIC_ACQUIRE, "agent");
            asm volatile("s_waitcnt vmcnt(0)" ::: "memory");
        }
    }
    __syncthreads();
}

struct Args { const float* in[32]; float* out; unsigned char* ws; int ph_lo, ph_hi; };
struct Frame {
    LAS unsigned char* lds;
    const Args* a;
    unsigned char* ws; float* out;
    int tid, lane, wave, G, vcu;
};
#define FIN(k) (F.a->in[k])
#define F_x FIN(0)
#define F_c FIN(1)
#define F_ctx FIN(2)
#define F_cctx FIN(3)
#define F_w_ada FIN(4)
#define F_b_ada FIN(5)
#define F_norm1_g FIN(6)
#define F_norm2_g FIN(7)
#define F_w_in FIN(8)
#define F_qn_a FIN(9)
#define F_kn_a FIN(10)
#define F_sink_a FIN(11)
#define F_qn_b FIN(12)
#define F_kn_b FIN(13)
#define F_lam_b FIN(14)
#define F_subln_b FIN(15)
#define F_conv_w FIN(16)
#define F_conv_b FIN(17)
#define F_w_rg FIN(18)
#define F_b_rg FIN(19)
#define F_w_ig FIN(20)
#define F_b_ig FIN(21)
#define F_lru_lambda FIN(22)
#define F_lb_d FIN(23)
#define F_onorm_d FIN(24)
#define F_w_branch FIN(25)
#define F_w_out FIN(26)
#define F_w_router FIN(27)
#define F_b_router FIN(28)
#define F_w_gate FIN(29)
#define F_w_up FIN(30)
#define F_w_down FIN(31)
#define F_ctl ((unsigned*)(F.ws + WS_CTL))
#define F_MOD ((float*)(F.ws + WS_MOD))
#define F_WIN ((bf16_t*)(F.ws + WS_WIN))
#define F_WBR ((bf16_t*)(F.ws + WS_WBR))
#define F_WOUT ((bf16_t*)(F.ws + WS_WOUT))
#define F_WGU ((bf16_t*)(F.ws + WS_WGU))
#define F_WD ((bf16_t*)(F.ws + WS_WD))
#define F_H ((bf16_t*)(F.ws + WS_H))
#define F_Y ((bf16_t*)(F.ws + WS_Y))
#define F_P1 ((bf16_t*)(F.ws + WS_P1))
#define F_O ((bf16_t*)(F.ws + WS_O))
#define F_HID ((bf16_t*)(F.ws + WS_HID))
#define F_XC ((float*)(F.ws + WS_XC))
#define F_LIST ((unsigned*)(F.ws + WS_LIST))
#define F_RW ((float*)(F.ws + WS_RW))
__device__ __forceinline__ Frame phase_frame(const Frame& F) {
    Frame P = F;
    P.ws = opaque_ptr(F.ws); P.out = opaque_ptr(F.out);
    P.wave = opaque_int(F.wave); P.G = opaque_int(F.G); P.vcu = opaque_int(F.vcu);
    unsigned ln; asm volatile("v_mbcnt_lo_u32_b32 %0, -1, 0\n\tv_mbcnt_hi_u32_b32 %0, -1, %0" : "=v"(ln));
    P.lane = (int)ln; P.tid = P.wave * 64 + (int)ln;
    return P;
}
__device__ __forceinline__ int mod_index(int row) { return row < NCTX ? 8 : ((row - NCTX) >> 11); }
__device__ __forceinline__ float* xrow_ptr(const Frame& F, int row) { return row < NCTX ? F_XC + (size_t)row * D : F.out + (size_t)(row - NCTX) * D; }
__device__ __forceinline__ const float* xin_ptr(const Frame& F, int row) { return row < NCTX ? F_ctx + (size_t)row * D : F_x + (size_t)(row - NCTX) * D; }

__device__ __forceinline__ void p0_mod(const Frame& F) {
    LAS float* sl = (LAS float*)F.lds;
    LAS float* part = (LAS float*)(F.lds + 9 * D * 4);
    for (int idx = F.tid; idx < 9 * D; idx += NTHR) { const int i = idx >> 11, k = idx & (D - 1); const float v = (i < 8) ? F_c[i * D + k] : F_cctx[k]; sl[idx] = v / (1.0f + __expf(-v)); }
    __syncthreads();
    for (int it = F.vcu; it < DEPTH * 96; it += F.G) {
        const int l = it / 96, jb = it % 96;
        const float* w = F_w_ada + ((size_t)l * D + F.wave * 256) * (6 * D) + jb * 128 + F.lane * 2;
        f32x2 acc[9];
#pragma unroll
        for (int i = 0; i < 9; ++i) acc[i] = (f32x2){0.f, 0.f};
#pragma unroll 8
        for (int k = 0; k < 256; ++k) {
            const f32x2 wv = *(const f32x2*)(w + (size_t)k * (6 * D));
#pragma unroll
            for (int i = 0; i < 9; ++i) acc[i] += sl[i * D + F.wave * 256 + k] * wv;
        }
#pragma unroll
        for (int i = 0; i < 9; ++i) *(LAS f32x2*)(part + (F.wave * 9 + i) * 128 + F.lane * 2) = acc[i];
        __syncthreads();
        for (int idx = F.tid; idx < 9 * 128; idx += NTHR) { const int i = idx >> 7, cidx = idx & 127; float sum = F_b_ada[(size_t)l * 6 * D + jb * 128 + cidx];
#pragma unroll
            for (int wv = 0; wv < 8; ++wv) sum += part[(wv * 9 + i) * 128 + cidx];
            F_MOD[((size_t)(l * 9 + i)) * (6 * D) + jb * 128 + cidx] = sum; }
        __syncthreads();
    }
    __syncthreads();
}
__device__ __forceinline__ void tr_item(const float* W, int ldw, int k0, int n0, bf16_t* dst, int ldd, LAS float* scr, int lane) {
    float tv[32];
#pragma unroll
    for (int i = 0; i < 32; ++i) { const int kk = 2 * i + (lane >> 5); tv[i] = W[(size_t)(k0 + kk) * ldw + n0 + (lane & 31)]; }
#pragma unroll
    for (int i = 0; i < 32; ++i) { const int kk = 2 * i + (lane >> 5); scr[kk * 33 + (lane & 31)] = tv[i]; }
    LDS_WAIT(); asm volatile("" ::: "memory");
    const int c = lane & 7;
#pragma unroll
    for (int j = 0; j < 4; ++j) { const int n = (lane >> 3) + 8 * j; const LAS float* s = scr + (8 * c) * 33 + n;
        u32x4 o; o.x = cvt_pk_bf16(s[0 * 33], s[1 * 33]); o.y = cvt_pk_bf16(s[2 * 33], s[3 * 33]); o.z = cvt_pk_bf16(s[4 * 33], s[5 * 33]); o.w = cvt_pk_bf16(s[6 * 33], s[7 * 33]);
        *(u32x4*)(dst + (size_t)n * ldd + k0 + 8 * c) = o; }
    LDS_WAIT(); asm volatile("" ::: "memory");
}
__device__ __forceinline__ void p0_weights(const Frame& F) {
    LAS float* scr = (LAS float*)(F.lds + F.wave * 8704);
    const int gw = F.vcu * NWAVES + F.wave, NGW = F.G * NWAVES;
    constexpr int I_IN = 32 * 624, I_BR = 16 * 64, I_OUT = 32 * 64, I_G = 32 * 16, I_D = 8 * 64;
    constexpr int S0 = DEPTH * I_IN, S1 = S0 + DEPTH * 4 * I_BR, S2 = S1 + DEPTH * I_OUT, S3 = S2 + DEPTH * NEXP * I_G, S4 = S3 + DEPTH * NEXP * I_G, S5 = S4 + DEPTH * NEXP * I_D;
    for (int it = gw; it < S5; it += NGW) {
        if (it < S0) { const int l = it / I_IN, r = it % I_IN, kb = r / 624, nb = r % 624;
            tr_item(F_w_in + (size_t)l * D * INW, INW, kb * 64, nb * 32, F_WIN + ((size_t)l * INW + nb * 32) * D, D, scr, F.lane); }
        else if (it < S1) { const int q = it - S0, m = q / I_BR, r = q % I_BR, kb = r / 64, nb = r % 64;
            tr_item(F_w_branch + (size_t)m * 1024 * D, D, kb * 64, nb * 32, F_WBR + ((size_t)m * D + nb * 32) * 1024, 1024, scr, F.lane); }
        else if (it < S2) { const int q = it - S1, l = q / I_OUT, r = q % I_OUT, kb = r / 64, nb = r % 64;
            tr_item(F_w_out + (size_t)l * D * D, D, kb * 64, nb * 32, F_WOUT + ((size_t)l * D + nb * 32) * D, D, scr, F.lane); }
        else if (it < S4) { const bool up = it >= S3; const int q = it - (up ? S3 : S2), m = q / I_G, r = q % I_G, kb = r / 16, nb = r % 16;
            const int n0 = nb * 32, drow = 256 * (n0 >> 7) + (n0 & 127) + (up ? 128 : 0);
            tr_item((up ? F_w_up : F_w_gate) + (size_t)m * D * DFF, DFF, kb * 64, n0, F_WGU + ((size_t)m * 1024 + drow) * D, D, scr, F.lane); }
        else { const int q = it - S4, m = q / I_D, r = q % I_D, kb = r / 64, nb = r % 64;
            tr_item(F_w_down + (size_t)m * DFF * D, D, kb * 64, nb * 32, F_WD + ((size_t)m * D + nb * 32) * DFF, DFF, scr, F.lane); }
    }
    __syncthreads();
}
__device__ __forceinline__ void p0_copy_x(const Frame& F) {
    const size_t gt = (size_t)F.vcu * NTHR + F.tid, NGT = (size_t)F.G * NTHR;
    for (size_t i = gt; i < (size_t)NTOK * D / 4; i += NGT) { const int row = (int)(i / (D / 4)); const int c4 = (int)(i % (D / 4));
        *((f32x4*)xrow_ptr(F, row) + c4) = *((const f32x4*)xin_ptr(F, row) + c4); }
}

template <int WHICH>
__device__ __forceinline__ void norm_phase(const Frame& F, int l) {
    const int gw = F.vcu * NWAVES + F.wave, NGW = F.G * NWAVES, lane = F.lane;
    LAS float* wrT = (LAS float*)F.lds;
    if (WHICH == 2) {
        for (int idx = F.tid; idx < D * NEXP; idx += NTHR) { const int e = idx >> 11, col = idx & (D - 1); wrT[idx] = F_w_router[col * NEXP + e]; }
        if (F.tid < 16) ((LAS unsigned*)(F.lds + 131072))[F.tid] = 0u;
        __syncthreads();
    }
    LAS unsigned* lcnt = (LAS unsigned*)(F.lds + 131072); LAS unsigned* lbase = lcnt + 16; LAS int* lrec = (LAS int*)(F.lds + 131072 + 256);
    int nrec = 0;
    const int row_lo = (WHICH == 3 || (WHICH == 2 && l == DEPTH - 1)) ? NCTX : 0;
    const bf16_t* Y2 = F_O;
    for (int row = row_lo + gw; row < NTOK; row += NGW) {
        const int mi = mod_index(row);
        f32x4 v[8];
        float* xr = xrow_ptr(F, row);
        if (WHICH == 1 && l == 0) { const float* xi = xin_ptr(F, row);
#pragma unroll
            for (int j = 0; j < 8; ++j) v[j] = *(const f32x4*)(xi + 4 * lane + 256 * j);
        } else {
#pragma unroll
            for (int j = 0; j < 8; ++j) v[j] = *(const f32x4*)(xr + 4 * lane + 256 * j);
        }
        if ((WHICH == 1 && l > 0) || WHICH == 3) {
            const int lp = (WHICH == 3) ? DEPTH - 1 : l - 1;
            const float* g2 = F_MOD + ((size_t)(lp * 9 + mi)) * (6 * D) + 5 * D;
            const f32x2 rw = *(const f32x2*)(F_RW + 2 * (size_t)row);
            const bf16_t* ya = Y2 + (size_t)(2 * row) * D; const bf16_t* yb = ya + D;
#pragma unroll
            for (int j = 0; j < 8; ++j) { const int col = 4 * lane + 256 * j; const f32x4 g = *(const f32x4*)(g2 + col);
                const u32x2 a = *(const u32x2*)(ya + col), b = *(const u32x2*)(yb + col);
                v[j].x += g.x * (rw.x * bf_lo(a.x) + rw.y * bf_lo(b.x)); v[j].y += g.y * (rw.x * bf_hi(a.x) + rw.y * bf_hi(b.x));
                v[j].z += g.z * (rw.x * bf_lo(a.y) + rw.y * bf_lo(b.y)); v[j].w += g.w * (rw.x * bf_hi(a.y) + rw.y * bf_hi(b.y));
                *(f32x4*)(xr + col) = v[j]; }
        }
        if (WHICH == 3) continue;
        float ss = 0.f;
#pragma unroll
        for (int j = 0; j < 8; ++j) ss += (v[j].x * v[j].x + v[j].y * v[j].y) + (v[j].z * v[j].z + v[j].w * v[j].w);
        const float rinv = rsqrtf(wave_sum(ss, lane) * (1.0f / D) + 1e-6f);
        const float* gn = (WHICH == 1 ? F_norm1_g : F_norm2_g) + (size_t)l * D;
        const float* md = F_MOD + ((size_t)(l * 9 + mi)) * (6 * D) + (WHICH == 1 ? 0 : 3) * D;
        bf16_t* hr = F_H + (size_t)row * D;
#pragma unroll
        for (int j = 0; j < 8; ++j) { const int col = 4 * lane + 256 * j; const f32x4 g = *(const f32x4*)(gn + col), sh = *(const f32x4*)(md + col), sc = *(const f32x4*)(md + D + col);
            v[j].x = v[j].x * rinv * g.x * (1.0f + sc.x) + sh.x; v[j].y = v[j].y * rinv * g.y * (1.0f + sc.y) + sh.y;
            v[j].z = v[j].z * rinv * g.z * (1.0f + sc.z) + sh.z; v[j].w = v[j].w * rinv * g.w * (1.0f + sc.w) + sh.w;
            u32x2 o; o.x = cvt_pk_bf16(v[j].x, v[j].y); o.y = cvt_pk_bf16(v[j].z, v[j].w); *(u32x2*)(hr + col) = o; }
        if (WHICH == 2) {
            float lg[NEXP];
#pragma unroll
            for (int e = 0; e < NEXP; ++e) { float a = 0.f;
#pragma unroll
                for (int j = 0; j < 8; ++j) { const f32x4 w = *(const LAS f32x4*)(wrT + e * D + 4 * lane + 256 * j); a += (v[j].x * w.x + v[j].y * w.y) + (v[j].z * w.z + v[j].w * w.w); }
                lg[e] = wave_sum(a, lane); }
            float aff[NEXP], sel[NEXP];
#pragma unroll
            for (int e = 0; e < NEXP; ++e) { aff[e] = 1.0f / (1.0f + expf(-lg[e])); sel[e] = aff[e] + F_b_router[e]; }
            int grp = 0; float best = -1e30f;
#pragma unroll
            for (int g = 0; g < 4; ++g) { float m1 = -1e30f, m2 = -1e30f;
#pragma unroll
                for (int q = 0; q < 4; ++q) { const float s = sel[4 * g + q]; if (s > m1) { m2 = m1; m1 = s; } else if (s > m2) m2 = s; }
                const float gs = m1 + m2; if (gs > best) { best = gs; grp = g; } }
            int i0 = 0, i1 = 0; float s0 = -1e30f, s1 = -1e30f, a0 = 0.f, a1 = 0.f;
#pragma unroll
            for (int g = 0; g < 4; ++g)
#pragma unroll
                for (int q = 0; q < 4; ++q) { const float s = sel[4 * g + q], a = aff[4 * g + q]; const bool in = (g == grp);
                    if (in && s > s0) { s1 = s0; i1 = i0; a1 = a0; s0 = s; i0 = 4 * g + q; a0 = a; } else if (in && s > s1) { s1 = s; i1 = 4 * g + q; a1 = a; } }
            if (lane == 0) {
                const float inv = 1.0f / (a0 + a1);
                *(f32x2*)(F_RW + 2 * (size_t)row) = (f32x2){a0 * inv, a1 * inv};
                LAS int* rec = lrec + (F.wave * 16 + nrec) * 4;
                rec[0] = i0; rec[1] = i1; rec[2] = (int)__hip_atomic_fetch_add(lcnt + i0, 1u, __ATOMIC_RELAXED, __HIP_MEMORY_SCOPE_WORKGROUP); rec[3] = (int)__hip_atomic_fetch_add(lcnt + i1, 1u, __ATOMIC_RELAXED, __HIP_MEMORY_SCOPE_WORKGROUP);
            }
            ++nrec;
        }
    }
    if (WHICH == 2) {
        __syncthreads();
        if (F.tid < 16) lbase[F.tid] = atomicAdd(F_ctl + CW_CNT + 64 * l + F.tid, lcnt[F.tid]);
        __syncthreads();
        if (lane < nrec) { const int row = row_lo + gw + lane * NGW; const LAS int* rec = lrec + (F.wave * 16 + lane) * 4; const int i0 = rec[0], i1 = rec[1];
            F_LIST[(size_t)i0 * NTOK + lbase[i0] + rec[2]] = 2u * row; F_LIST[(size_t)i1 * NTOK + lbase[i1] + rec[3]] = 2u * row + 1u; }
        __syncthreads();
    }
}

__device__ __forceinline__ constexpr int bitrev5(int v) { return ((v & 1) << 4) | ((v & 2) << 2) | (v & 4) | ((v & 8) >> 2) | ((v & 16) >> 4); }
__device__ __forceinline__ void norm2_phase(const Frame& F, int l) {
    const int gw = F.vcu * NWAVES + F.wave, NGW = F.G * NWAVES, lane = F.lane;
    LAS float* wrT = (LAS float*)F.lds;
    for (int idx = F.tid; idx < D * NEXP; idx += NTHR) { const int e = idx >> 11, col = idx & (D - 1); wrT[idx] = F_w_router[col * NEXP + e]; }
    LAS unsigned* lcnt = (LAS unsigned*)(F.lds + 131072); LAS unsigned* lbase = lcnt + 16; LAS int* lrec = (LAS int*)(F.lds + 131072 + 256);
    if (F.tid < 16) lcnt[F.tid] = 0u;
    int nrec = 0;
    __syncthreads();
    const int row_lo = (l == DEPTH - 1) ? NCTX : 0;
    float brt[NEXP];
#pragma unroll
    for (int e = 0; e < NEXP; ++e) brt[e] = F_b_router[e];
    for (int row0 = row_lo + 2 * gw; row0 < NTOK; row0 += 2 * NGW) {
        const int mi = mod_index(row0);
        f32x4 v[2][8];
#pragma unroll
        for (int r = 0; r < 2; ++r) { const float* xr = xrow_ptr(F, row0 + r);
#pragma unroll
            for (int j = 0; j < 8; ++j) v[r][j] = *(const f32x4*)(xr + 4 * lane + 256 * j); }
        float ss0 = 0.f, ss1 = 0.f;
#pragma unroll
        for (int j = 0; j < 8; ++j) { ss0 += (v[0][j].x * v[0][j].x + v[0][j].y * v[0][j].y) + (v[0][j].z * v[0][j].z + v[0][j].w * v[0][j].w); ss1 += (v[1][j].x * v[1][j].x + v[1][j].y * v[1][j].y) + (v[1][j].z * v[1][j].z + v[1][j].w * v[1][j].w); }
        const float rinv[2] = {rsqrtf(wave_sum(ss0, lane) * (1.0f / D) + 1e-6f), rsqrtf(wave_sum(ss1, lane) * (1.0f / D) + 1e-6f)};
        const float* gn = F_norm2_g + (size_t)l * D;
        const float* md = F_MOD + ((size_t)(l * 9 + mi)) * (6 * D) + 3 * D;
#pragma unroll
        for (int j = 0; j < 8; ++j) { const int col = 4 * lane + 256 * j; const f32x4 g = *(const f32x4*)(gn + col), sh = *(const f32x4*)(md + col), sc = *(const f32x4*)(md + D + col);
#pragma unroll
            for (int r = 0; r < 2; ++r) { f32x4& q = v[r][j];
                q.x = q.x * rinv[r] * g.x * (1.0f + sc.x) + sh.x; q.y = q.y * rinv[r] * g.y * (1.0f + sc.y) + sh.y; q.z = q.z * rinv[r] * g.z * (1.0f + sc.z) + sh.z; q.w = q.w * rinv[r] * g.w * (1.0f + sc.w) + sh.w;
                u32x2 o; o.x = cvt_pk_bf16(q.x, q.y); o.y = cvt_pk_bf16(q.z, q.w); *(u32x2*)(F_H + (size_t)(row0 + r) * D + col) = o; } }
        float x[32];
#pragma unroll
        for (int e = 0; e < NEXP; ++e) { float a0 = 0.f, a1 = 0.f;
#pragma unroll
            for (int j = 0; j < 8; ++j) { const f32x4 w = *(const LAS f32x4*)(wrT + e * D + 4 * lane + 256 * j);
                a0 += (v[0][j].x * w.x + v[0][j].y * w.y) + (v[0][j].z * w.z + v[0][j].w * w.w); a1 += (v[1][j].x * w.x + v[1][j].y * w.y) + (v[1][j].z * w.z + v[1][j].w * w.w); }
            x[e] = a0; x[16 + e] = a1; }
#pragma unroll
        for (int k = 0; k < 5; ++k) { const int half = 16 >> k; const bool bit = (lane >> k) & 1;
#pragma unroll
            for (int i = 0; i < half; ++i) { const float send = bit ? x[i] : x[i + half], keep = bit ? x[i + half] : x[i]; x[i] = keep + shx(send, 1 << k, lane); } }
        const float tot = x[0] + shx(x[0], 32, lane);
        const float affv = 1.0f / (1.0f + expf(-tot));
#pragma unroll
        for (int r = 0; r < 2; ++r) {
            float aff[NEXP], sel[NEXP];
#pragma unroll
            for (int e = 0; e < NEXP; ++e) { aff[e] = __builtin_bit_cast(float, __builtin_amdgcn_readlane(__builtin_bit_cast(int, affv), bitrev5(r * 16 + e))); sel[e] = aff[e] + brt[e]; }
            int grp = 0; float best = -1e30f;
#pragma unroll
            for (int g = 0; g < 4; ++g) { float m1 = -1e30f, m2 = -1e30f;
#pragma unroll
                for (int q = 0; q < 4; ++q) { const float s = sel[4 * g + q]; if (s > m1) { m2 = m1; m1 = s; } else if (s > m2) m2 = s; }
                const float gs = m1 + m2; if (gs > best) { best = gs; grp = g; } }
            int i0 = 0, i1 = 0; float s0 = -1e30f, s1 = -1e30f, a0 = 0.f, a1 = 0.f;
#pragma unroll
            for (int g = 0; g < 4; ++g)
#pragma unroll
                for (int q = 0; q < 4; ++q) { const float s = sel[4 * g + q], a = aff[4 * g + q]; const bool in = (g == grp);
                    if (in && s > s0) { s1 = s0; i1 = i0; a1 = a0; s0 = s; i0 = 4 * g + q; a0 = a; } else if (in && s > s1) { s1 = s; i1 = 4 * g + q; a1 = a; } }
            if (lane == 0) { const int row = row0 + r;
                const float inv = 1.0f / (a0 + a1);
                *(f32x2*)(F_RW + 2 * (size_t)row) = (f32x2){a0 * inv, a1 * inv};
                LAS int* rec = lrec + (F.wave * 16 + nrec) * 4;
                rec[0] = i0; rec[1] = i1; rec[2] = (int)__hip_atomic_fetch_add(lcnt + i0, 1u, __ATOMIC_RELAXED, __HIP_MEMORY_SCOPE_WORKGROUP); rec[3] = (int)__hip_atomic_fetch_add(lcnt + i1, 1u, __ATOMIC_RELAXED, __HIP_MEMORY_SCOPE_WORKGROUP); }
            ++nrec;
        }
    }
    __syncthreads();
    if (F.tid < 16) lbase[F.tid] = atomicAdd(F_ctl + CW_CNT + 64 * l + F.tid, lcnt[F.tid]);
    __syncthreads();
    if (lane < nrec) { const int row = row_lo + 2 * gw + (lane >> 1) * 2 * NGW + (lane & 1); const LAS int* rec = lrec + (F.wave * 16 + lane) * 4; const int i0 = rec[0], i1 = rec[1];
        F_LIST[(size_t)i0 * NTOK + lbase[i0] + rec[2]] = 2u * row; F_LIST[(size_t)i1 * NTOK + lbase[i1] + rec[3]] = 2u * row + 1u; }
    __syncthreads();
}

namespace g8 {
constexpr int BM = 256, BK = 64, HALF = 128, HTB = HALF * BK * 2, STAGE_BYTES = 8 * HTB;
__device__ __forceinline__ int lds_byte(int r, int c) { const int st = (r >> 4) * 2 + (c >> 5), rr = r & 15, cc = c & 31, ob = rr * 64 + cc * 2; return st * 1024 + (ob ^ (((ob >> 9) & 1) << 5)); }
__device__ __forceinline__ void stage_rc(int b, int& R, int& C) { const int st = b / 1024, sb = b % 1024, swz = sb ^ (((sb >> 9) & 1) << 5); R = (st >> 1) * 16 + swz / 64; C = (st & 1) * 32 + (swz % 64) / 2; }
__device__ __forceinline__ int perm32(int rho) { const int n = rho >> 4, i = rho & 15; return 8 * (i >> 2) + 4 * n + (i & 3); }
__device__ __forceinline__ void tile_order(int L, int nM, int nN, int& pm, int& pn) {
    const int nwg = nM * nN; int wgid = L;
    { const int q = nwg / 8, r = nwg % 8, xcd = wgid % 8, off = wgid / 8; wgid = (xcd < r ? xcd * (q + 1) : r * (q + 1) + (xcd - r) * q) + off; }
    const int nig = 8 * nN, gid = wgid / nig, fm = gid * 8, gsz = (nM - fm) < 8 ? (nM - fm) : 8;
    pm = fm + ((wgid % nig) % gsz); pn = (wgid % nig) / gsz;
}
struct GU { int pm, pn, aux, valid; const char* A; const char* B; };

template <class P>
__device__ __forceinline__ void gemm_phase(LAS unsigned char* lds, const P& S, const int tid) {
    const int wid = __builtin_amdgcn_readfirstlane(tid >> 6), lane = tid & 63, wr = wid >> 2, wc = wid & 3, fr = lane & 15, fq = lane >> 4;
    const int K = S.K, nt = K / BK;
    const unsigned lda = S.lda, ldb = S.ldb;
    int Rr[2], Cc[2]; unsigned voffB[2];
#pragma unroll
    for (int i = 0; i < 2; ++i) { stage_rc(tid * 16 + i * 8192, Rr[i], Cc[i]); const int Rb = P::PERM ? ((Rr[i] & ~31) + perm32(Rr[i] & 31)) : Rr[i]; voffB[i] = (unsigned)Rb * ldb + (unsigned)Cc[i] * 2u; }
    unsigned offA[2][2], offAn[2][2];
#pragma unroll
    for (int h = 0; h < 2; ++h)
#pragma unroll
        for (int i = 0; i < 2; ++i) { offA[h][i] = (unsigned)(h * HALF + Rr[i]) * lda + (unsigned)Cc[i] * 2u; offAn[h][i] = offA[h][i]; }
    const size_t kstep = (size_t)(BK * 2);
    const size_t hstepB = (size_t)HALF * ldb;
    const unsigned ldsw = (unsigned)wid * 1024u;
    const int aoff = lds_byte(wr * 64 + fr, fq * 8), boff = lds_byte(wc * 32 + fr, fq * 8);
#define G8_SA(b, h) (((b) * 2 + (h)) * HTB)
#define G8_SB(b, h) ((4 + (b) * 2 + (h)) * HTB)
#define G8_STAGE_A(bufoff, gbase, offs, h) do { _Pragma("unroll") for (int _i = 0; _i < 2; ++_i) \
        __builtin_amdgcn_global_load_lds((const unsigned*)((const char*)(gbase) + (offs)[h][_i]), (LAS unsigned*)(lds + (bufoff) + ldsw + _i * 8192), 16, 0, 0); } while (0)
#define G8_STAGE_B(bufoff, gbase) do { _Pragma("unroll") for (int _i = 0; _i < 2; ++_i) \
        __builtin_amdgcn_global_load_lds((const unsigned*)((const char*)(gbase) + voffB[_i]), (LAS unsigned*)(lds + (bufoff) + ldsw + _i * 8192), 16, 0, 0); } while (0)
#define G8_LDA(dst, b, h) do { _Pragma("unroll") for (int m = 0; m < 4; ++m) _Pragma("unroll") for (int k = 0; k < 2; ++k) dst[m][k] = *(const LAS bf16x8*)(lds + G8_SA(b, h) + aoff + m * 2048 + k * 1024); } while (0)
#define G8_LDB(dst, b, h) do { _Pragma("unroll") for (int n = 0; n < 2; ++n) _Pragma("unroll") for (int k = 0; k < 2; ++k) dst[n][k] = *(const LAS bf16x8*)(lds + G8_SB(b, h) + boff + n * 2048 + k * 1024); } while (0)
#define G8_MMA(ai, bj, At, Bt) do { __builtin_amdgcn_s_setprio(1); _Pragma("unroll") for (int m = 0; m < 4; ++m) _Pragma("unroll") for (int n = 0; n < 2; ++n) _Pragma("unroll") for (int k = 0; k < 2; ++k) \
        acc[ai][bj][m][n] = __builtin_amdgcn_mfma_f32_16x16x32_bf16(Bt[n][k], At[m][k], acc[ai][bj][m][n], 0, 0, 0); __builtin_amdgcn_s_setprio(0); } while (0)
#define G8_WAIT_V(n) asm volatile("s_waitcnt vmcnt(" #n ")" ::: "memory")
#define G8_WAIT_L(n) asm volatile("s_waitcnt lgkmcnt(" #n ")" ::: "memory")
#define G8_BAR __builtin_amdgcn_s_barrier()
#define G8_SCHED __builtin_amdgcn_sched_barrier(0)
    GU cur, nxt; int ui = 0;
    if (!S.next(0, cur)) return;
    if constexpr (P::GATHER) { S.rows(cur, offA); asm volatile("" : "+v"(offA[0][0]), "+v"(offA[0][1]), "+v"(offA[1][0]), "+v"(offA[1][1])); }
    f32x4 acc[2][2][4][2];
#pragma unroll
    for (int a = 0; a < 2; ++a)
#pragma unroll
        for (int b = 0; b < 2; ++b)
#pragma unroll
            for (int m = 0; m < 4; ++m)
#pragma unroll
                for (int n = 0; n < 2; ++n) acc[a][b][m][n] = (f32x4){0.f, 0.f, 0.f, 0.f};
    bf16x8 At[4][2], B0[2][2], B1[2][2];
    const char* cA = cur.A; const char* cB = cur.B;
    G8_STAGE_B(G8_SB(0, 0), cB); G8_STAGE_A(G8_SA(0, 0), cA, offA, 0); G8_STAGE_B(G8_SB(0, 1), cB + hstepB); G8_STAGE_A(G8_SA(0, 1), cA, offA, 1);
    if (wr == 1) G8_BAR;
    G8_WAIT_V(4); G8_BAR;
    G8_STAGE_B(G8_SB(1, 0), cB + kstep); G8_STAGE_A(G8_SA(1, 0), cA + kstep, offA, 0); G8_STAGE_B(G8_SB(1, 1), cB + hstepB + kstep);
    G8_WAIT_V(6); G8_BAR;
    for (;;) {
        const bool has_next = S.next(ui + 1, nxt);
        const char* nA = has_next ? nxt.A : cA; const char* nB = has_next ? nxt.B : cB;
        if constexpr (P::GATHER) {
            if (has_next) S.rows(nxt, offAn);
            else {
#pragma unroll
                for (int h = 0; h < 2; ++h)
#pragma unroll
                    for (int i = 0; i < 2; ++i) offAn[h][i] = offA[h][i]; }
            asm volatile("" : "+v"(offAn[0][0]), "+v"(offAn[0][1]), "+v"(offAn[1][0]), "+v"(offAn[1][1]));
        }
        for (int t = 0; t < nt; t += 2) {
            const bool last = (t == nt - 2);
            const char* a1 = cA + (size_t)(t + 1) * kstep;
            const char* a2 = last ? nA : cA + (size_t)(t + 2) * kstep; const char* b2 = last ? nB : cB + (size_t)(t + 2) * kstep;
            const char* a3 = a2 + kstep; const char* b3 = b2 + kstep;
            unsigned o2[2][2];
#pragma unroll
            for (int h = 0; h < 2; ++h)
#pragma unroll
                for (int i = 0; i < 2; ++i) o2[h][i] = (P::GATHER && last) ? offAn[h][i] : offA[h][i];
            G8_LDB(B0, 0, 0); G8_SCHED; G8_LDA(At, 0, 0); G8_STAGE_A(G8_SA(1, 1), a1, offA, 1);
            G8_WAIT_L(8); G8_BAR; G8_WAIT_L(0); G8_MMA(0, 0, At, B0); G8_BAR; G8_SCHED;
            G8_LDB(B1, 0, 1); G8_STAGE_B(G8_SB(0, 0), b2);
            G8_BAR; G8_WAIT_L(0); G8_MMA(0, 1, At, B1); G8_BAR;
            G8_LDA(At, 0, 1); G8_STAGE_A(G8_SA(0, 0), a2, o2, 0);
            G8_BAR; G8_WAIT_L(0); G8_MMA(1, 0, At, B0); G8_BAR; G8_SCHED;
            G8_STAGE_B(G8_SB(0, 1), b2 + hstepB);
            G8_WAIT_V(6); G8_BAR; G8_MMA(1, 1, At, B1); G8_BAR;
            G8_LDB(B0, 1, 0); G8_SCHED; G8_LDA(At, 1, 0); G8_STAGE_A(G8_SA(0, 1), a2, o2, 1);
            G8_WAIT_L(8); G8_BAR; G8_WAIT_L(0); G8_MMA(0, 0, At, B0); G8_BAR; G8_SCHED;
            G8_LDB(B1, 1, 1); G8_STAGE_B(G8_SB(1, 0), b3);
            G8_BAR; G8_WAIT_L(0); G8_MMA(0, 1, At, B1); G8_BAR;
            G8_LDA(At, 1, 1); G8_STAGE_A(G8_SA(1, 0), a3, o2, 0);
            G8_BAR; G8_WAIT_L(0); G8_MMA(1, 0, At, B0); G8_BAR; G8_SCHED;
            G8_STAGE_B(G8_SB(1, 1), b3 + hstepB);
            G8_WAIT_V(6); G8_BAR; G8_MMA(1, 1, At, B1); G8_BAR;
        }
        S.epi(acc, cur, wr, wc, fr, fq);
        if (!has_next) break;
#pragma unroll
        for (int a = 0; a < 2; ++a)
#pragma unroll
            for (int b = 0; b < 2; ++b)
#pragma unroll
                for (int m = 0; m < 4; ++m)
#pragma unroll
                    for (int n = 0; n < 2; ++n) acc[a][b][m][n] = (f32x4){0.f, 0.f, 0.f, 0.f};
        cur = nxt; cA = nA; cB = nB; ++ui;
        if constexpr (P::GATHER) {
#pragma unroll
            for (int h = 0; h < 2; ++h)
#pragma unroll
                for (int i = 0; i < 2; ++i) offA[h][i] = offAn[h][i]; }
    }
    G8_WAIT_V(0);
    if (wr == 0) G8_BAR;
    G8_BAR;
#undef G8_SA
#undef G8_SB
#undef G8_STAGE_A
#undef G8_STAGE_B
#undef G8_LDA
#undef G8_LDB
#undef G8_MMA
#undef G8_WAIT_V
#undef G8_WAIT_L
#undef G8_BAR
#undef G8_SCHED
}
}

struct PolDenseBf16 {
    static constexpr bool PERM = true, GATHER = false;
    int K; unsigned lda, ldb;
    const char* A; const char* B; bf16_t* C; int ldc; int nM, nN, pm0, G, c;
    __device__ __forceinline__ bool next(int i, g8::GU& u) const {
        const int L = i * G + c; if (L >= nM * nN) return false;
        g8::tile_order(L, nM, nN, u.pm, u.pn); u.pm += pm0; u.aux = 0; u.valid = 256;
        u.A = A + (size_t)u.pm * 256 * lda; u.B = B + (size_t)u.pn * 256 * ldb; return true;
    }
    __device__ __forceinline__ void epi(const f32x4 (&acc)[2][2][4][2], const g8::GU& u, int wr, int wc, int fr, int fq) const {
        const int row0 = u.pm * 256 + wr * 64 + fr, col0 = u.pn * 256 + wc * 32 + 8 * fq;
#pragma unroll
        for (int ai = 0; ai < 2; ++ai)
#pragma unroll
            for (int m = 0; m < 4; ++m) { bf16_t* rowp = C + (size_t)(row0 + ai * 128 + m * 16) * ldc + col0;
#pragma unroll
                for (int bj = 0; bj < 2; ++bj) { const f32x4 v0 = acc[ai][bj][m][0], v1 = acc[ai][bj][m][1];
                    u32x4 w; w.x = cvt_pk_bf16(v0[0], v0[1]); w.y = cvt_pk_bf16(v0[2], v0[3]); w.z = cvt_pk_bf16(v1[0], v1[1]); w.w = cvt_pk_bf16(v1[2], v1[3]);
                    *(u32x4*)(rowp + bj * 128) = w; } }
    }
};
template <int WHICH>
struct PolMoe {
    static constexpr bool PERM = true, GATHER = (WHICH == 1);
    int K; unsigned lda, ldb;
    const char* A; const char* Bw; bf16_t* C; const unsigned* list; int nN, G, c;
    int tid; LAS int* tab;
    __device__ __forceinline__ void init(const unsigned* cntw) {
        if (tid == 0) { int nt = 0;
            for (int e = 0; e < NEXP; ++e) { const int ce = (int)cntw[e];
                for (int t = 0; t * 256 < ce; ++t) { tab[4 + 4 * nt] = e; tab[5 + 4 * nt] = e * NTOK + t * 256; tab[6 + 4 * nt] = (ce - t * 256) < 256 ? (ce - t * 256) : 256; ++nt; } }
            tab[0] = nt; }
        __syncthreads();
    }
    __device__ __forceinline__ bool next(int i, g8::GU& u) const {
        const int L = i * G + c; if (L >= __builtin_amdgcn_readfirstlane(tab[0]) * nN) return false;
        const int mt = L / nN; u.pn = L % nN;
        const int e = __builtin_amdgcn_readfirstlane(tab[4 + 4 * mt]); u.pm = __builtin_amdgcn_readfirstlane(tab[5 + 4 * mt]); u.valid = __builtin_amdgcn_readfirstlane(tab[6 + 4 * mt]); u.aux = mt;
        u.A = (WHICH == 1) ? A : A + (size_t)mt * 256 * lda; u.B = Bw + ((size_t)e * (WHICH == 1 ? 1024 : D) + (size_t)u.pn * 256) * ldb; return true;
    }
    __device__ __forceinline__ unsigned slot_of(const g8::GU& u, int r) const { const int rr = r < u.valid ? r : 0; return list[u.pm + rr]; }
    __device__ __forceinline__ void rows(const g8::GU& u, unsigned (&off)[2][2]) const {
#pragma unroll
        for (int i = 0; i < 2; ++i) { int R, C; g8::stage_rc(tid * 16 + i * 8192, R, C);
#pragma unroll
            for (int h = 0; h < 2; ++h) { const unsigned s = slot_of(u, h * 128 + R); off[h][i] = (s >> 1) * lda + (unsigned)C * 2u; } }
    }
    __device__ __forceinline__ void epi(const f32x4 (&acc)[2][2][4][2], const g8::GU& u, int wr, int wc, int fr, int fq) const {
        if (WHICH == 1) {
#pragma unroll
            for (int ai = 0; ai < 2; ++ai)
#pragma unroll
                for (int m = 0; m < 4; ++m) { const int r = ai * 128 + wr * 64 + m * 16 + fr;
                    const f32x4 g0 = acc[ai][0][m][0], g1 = acc[ai][0][m][1], u0 = acc[ai][1][m][0], u1 = acc[ai][1][m][1];
                    float h[8];
#pragma unroll
                    for (int q = 0; q < 4; ++q) { h[q] = g0[q] * sigmoidf_(g0[q]) * u0[q]; h[4 + q] = g1[q] * sigmoidf_(g1[q]) * u1[q]; }
                    u32x4 w; w.x = cvt_pk_bf16(h[0], h[1]); w.y = cvt_pk_bf16(h[2], h[3]); w.z = cvt_pk_bf16(h[4], h[5]); w.w = cvt_pk_bf16(h[6], h[7]);
                    *(u32x4*)(C + ((size_t)u.aux * 256 + r) * DFF + u.pn * 128 + wc * 32 + 8 * fq) = w; }
        } else {
            unsigned sl[2][4];
#pragma unroll
            for (int ai = 0; ai < 2; ++ai)
#pragma unroll
                for (int m = 0; m < 4; ++m) sl[ai][m] = slot_of(u, ai * 128 + wr * 64 + m * 16 + fr);
#pragma unroll
            for (int ai = 0; ai < 2; ++ai)
#pragma unroll
                for (int m = 0; m < 4; ++m) { const int r = ai * 128 + wr * 64 + m * 16 + fr; const bool ok = r < u.valid;
#pragma unroll
                    for (int bj = 0; bj < 2; ++bj) { const f32x4 v0 = acc[ai][bj][m][0], v1 = acc[ai][bj][m][1];
                        u32x4 w; w.x = cvt_pk_bf16(v0[0], v0[1]); w.y = cvt_pk_bf16(v0[2], v0[3]); w.z = cvt_pk_bf16(v1[0], v1[1]); w.w = cvt_pk_bf16(v1[2], v1[3]);
                        if (ok) *(u32x4*)(C + (size_t)sl[ai][m] * D + u.pn * 256 + bj * 128 + wc * 32 + 8 * fq) = w; } }
        }
    }
};

struct PolMerge {
    static constexpr bool PERM = true, GATHER = false;
    int K; unsigned lda, ldb;
    const char* A; const char* B; bf16_t* Gt; bf16_t* Yo; int nM, pm0, G, c;
    __device__ __forceinline__ bool next(int i, g8::GU& u) const {
        const int L = (i >> 2) * G + c; if (L >= nM * 8) return false;
        g8::tile_order(L, nM, 8, u.pm, u.pn); u.pm += pm0; u.aux = i & 3; u.valid = 256;
        u.A = A + (size_t)u.pm * 256 * lda + (size_t)u.aux * 2048; u.B = B + ((size_t)u.aux * D + (size_t)u.pn * 256) * ldb; return true;
    }
    __device__ __forceinline__ void epi(const f32x4 (&acc)[2][2][4][2], const g8::GU& u, int wr, int wc, int fr, int fq) const {
        const int row0 = u.pm * 256 + wr * 64 + fr, col0 = u.pn * 256 + wc * 32 + 8 * fq, n = u.aux;
#pragma unroll
        for (int ai = 0; ai < 2; ++ai) {
            u32x4 gv[4][2]; unsigned long long pq[4][2][2];
#pragma unroll
            for (int m = 0; m < 4; ++m)
#pragma unroll
                for (int bj = 0; bj < 2; ++bj) { const bf16_t* gp = Gt + (size_t)(row0 + ai * 128 + m * 16) * NG + n * D + col0 + bj * 128;
                    gv[m][bj] = *(const u32x4*)gp;
                    if (n > 0) { const u32x4 pv = *(const u32x4*)(gp - D); pq[m][bj][0] = (unsigned long long)pv.x | ((unsigned long long)pv.y << 32); pq[m][bj][1] = (unsigned long long)pv.z | ((unsigned long long)pv.w << 32); }
                    else { pq[m][bj][0] = 0ull; pq[m][bj][1] = 0ull; } }
#pragma unroll
            for (int m = 0; m < 4; ++m) { bf16_t* grow = Gt + (size_t)(row0 + ai * 128 + m * 16) * NG + n * D + col0;
#pragma unroll
                for (int bj = 0; bj < 2; ++bj) { const f32x4 v0 = acc[ai][bj][m][0], v1 = acc[ai][bj][m][1]; const u32x4 g = gv[m][bj];
                    const unsigned p0 = (unsigned)pq[m][bj][0], p1 = (unsigned)(pq[m][bj][0] >> 32), p2 = (unsigned)pq[m][bj][1], p3 = (unsigned)(pq[m][bj][1] >> 32);
                    float r[8];
                    r[0] = v0[0] * sigmoidf_(bf_lo(g.x)) + bf_lo(p0); r[1] = v0[1] * sigmoidf_(bf_hi(g.x)) + bf_hi(p0); r[2] = v0[2] * sigmoidf_(bf_lo(g.y)) + bf_lo(p1); r[3] = v0[3] * sigmoidf_(bf_hi(g.y)) + bf_hi(p1);
                    r[4] = v1[0] * sigmoidf_(bf_lo(g.z)) + bf_lo(p2); r[5] = v1[1] * sigmoidf_(bf_hi(g.z)) + bf_hi(p2); r[6] = v1[2] * sigmoidf_(bf_lo(g.w)) + bf_lo(p3); r[7] = v1[3] * sigmoidf_(bf_hi(g.w)) + bf_hi(p3);
                    u32x4 w; w.x = cvt_pk_bf16(r[0], r[1]); w.y = cvt_pk_bf16(r[2], r[3]); w.z = cvt_pk_bf16(r[4], r[5]); w.w = cvt_pk_bf16(r[6], r[7]);
                    if (n < 3) *(u32x4*)(grow + bj * 128) = w;
                    else *(u32x4*)(Yo + (size_t)(row0 + ai * 128 + m * 16) * D + col0 + bj * 128) = w; } }
            asm volatile("" ::: "memory");
        }
    }
};
struct PolOut {
    static constexpr bool PERM = false, GATHER = false;
    int K; unsigned lda, ldb;
    const char* A; const char* B; const float* xin_c; const float* xin_l; float* xout_c; float* xout_l; const float* mod_l; int nM, pm0, G, c;
    __device__ __forceinline__ bool next(int i, g8::GU& u) const {
        const int L = i * G + c; if (L >= nM * 8) return false;
        g8::tile_order(L, nM, 8, u.pm, u.pn); u.pm += pm0; u.aux = 0; u.valid = 256;
        u.A = A + (size_t)u.pm * 256 * lda; u.B = B + (size_t)u.pn * 256 * ldb; return true;
    }
    __device__ __forceinline__ void epi(const f32x4 (&acc)[2][2][4][2], const g8::GU& u, int wr, int wc, int fr, int fq) const {
        const bool isc = u.pm < 8;
        const int mi = isc ? 8 : ((u.pm - 8) >> 3);
        const int lrow0 = (isc ? u.pm * 256 : (u.pm - 8) * 256) + wr * 64 + fr, col0 = u.pn * 256 + wc * 32 + 4 * fq;
        const float* xi = isc ? xin_c : xin_l; float* xo = isc ? xout_c : xout_l;
        const float* g1 = mod_l + (size_t)mi * (6 * D) + 2 * D + col0;
        f32x4 gv[2][2];
#pragma unroll
        for (int bj = 0; bj < 2; ++bj)
#pragma unroll
            for (int n = 0; n < 2; ++n) gv[bj][n] = *(const f32x4*)(g1 + bj * 128 + n * 16);
#pragma unroll
        for (int ai = 0; ai < 2; ++ai) {
            f32x4 xv[4][2][2];
#pragma unroll
            for (int m = 0; m < 4; ++m) { const size_t off = (size_t)(lrow0 + ai * 128 + m * 16) * D + col0;
#pragma unroll
                for (int bj = 0; bj < 2; ++bj)
#pragma unroll
                    for (int n = 0; n < 2; ++n) xv[m][bj][n] = *(const f32x4*)(xi + off + bj * 128 + n * 16); }
#pragma unroll
            for (int m = 0; m < 4; ++m) { const size_t off = (size_t)(lrow0 + ai * 128 + m * 16) * D + col0;
#pragma unroll
                for (int bj = 0; bj < 2; ++bj)
#pragma unroll
                    for (int n = 0; n < 2; ++n) *(f32x4*)(xo + off + bj * 128 + n * 16) = xv[m][bj][n] + gv[bj][n] * acc[ai][bj][m][n]; }
            asm volatile("" ::: "memory");
        }
    }
};

constexpr float LOG2E = 1.4426950408889634f;
constexpr int NKEY = CTXL + SEQ;
#define F_KB ((bf16_t*)(F.ws + WS_Y))
#define F_VTB ((bf16_t*)(F.ws + WS_Y + 36 * MiB))
#define F_KA ((bf16_t*)(F.ws + WS_HID))
#define F_VTA ((bf16_t*)(F.ws + WS_HID + 9 * MiB))
__device__ __forceinline__ void prep_phase(const Frame& F, int l) {
    const int gw = F.vcu * NWAVES + F.wave, NGW = F.G * NWAVES, lane = F.lane;
    bf16_t* P1 = F_P1;
    const f32x2 gqa = *(const f32x2*)(F_qn_a + l * 128 + 2 * lane), gka = *(const f32x2*)(F_kn_a + l * 128 + 2 * lane);
    const f32x2 gqb = *(const f32x2*)(F_qn_b + l * 64 + ((2 * lane) & 63)), gkb = *(const f32x2*)(F_kn_b + l * 64 + ((2 * lane) & 63));
    const float invA0 = exp2f(-(float)((2 * lane) & 31) * (13.287712379549449f / 32.0f)), invA1 = exp2f(-(float)((2 * lane + 1) & 31) * (13.287712379549449f / 32.0f));
    const float invB0 = exp2f(-(float)((2 * lane) & 15) * (13.287712379549449f / 16.0f)), invB1 = exp2f(-(float)((2 * lane + 1) & 15) * (13.287712379549449f / 16.0f));
    const float sgnA = (lane & 16) ? 1.f : -1.f, sgnB = (lane & 8) ? 1.f : -1.f;
    for (int row = gw; row < NTOK; row += NGW) {
        const bool isc = row < NCTX; const int b = isc ? (row >> 8) : ((row - NCTX) >> 11), t = isc ? (row & 255) : ((row - NCTX) & 2047);
        const int key = isc ? t : CTXL + t;
        const float prow = (float)(t >> 6), pcol = (float)(t & 63);
        bf16_t* pr = P1 + (size_t)row * N1;
        unsigned raw[26];
#pragma unroll
        for (int hh = 0; hh < 10; ++hh) raw[hh] = *(const unsigned*)(pr + (hh < 8 ? C_AQ + hh * 128 : C_AK + (hh - 8) * 128) + 2 * lane);
#pragma unroll
        for (int hh = 0; hh < 16; ++hh) raw[10 + hh] = *(const unsigned*)(pr + (hh < 8 ? C_BQ : C_BK) + (hh & 7) * 128 + 2 * lane);
        float cA0 = 1.f, sA0 = 0.f, cA1 = 1.f, sA1 = 0.f, cB0 = 1.f, sB0 = 0.f, cB1 = 1.f, sB1 = 0.f;
        if (!isc) { const float pa = (lane & 32) ? pcol : prow, pb = (lane & 16) ? pcol : prow;
            sincosf(pa * invA0, &sA0, &cA0); sincosf(pa * invA1, &sA1, &cA1); sincosf(pb * invB0, &sB0, &cB0); sincosf(pb * invB1, &sB1, &cB1); }
#pragma unroll
        for (int hh = 0; hh < 10; ++hh) {
            const bool isq = hh < 8;
            float a0 = bf_lo(raw[hh]), a1 = bf_hi(raw[hh]);
            const float rinv = rsqrtf(wave_sum(a0 * a0 + a1 * a1, lane) * (1.0f / 128.0f) + 1e-6f);
            a0 *= rinv * (isq ? gqa.x : gka.x); a1 *= rinv * (isq ? gqa.y : gka.y);
            const float p0 = shx(a0, 16, lane), p1 = shx(a1, 16, lane);
            float o0 = a0 * cA0 + sgnA * p0 * sA0, o1 = a1 * cA1 + sgnA * p1 * sA1;
            if (isq) { const float sc = 0.08838834764831845f * LOG2E; o0 *= sc; o1 *= sc; }
            bf16_t* dst = isq ? pr + C_AQ + hh * 128 : F_KA + (((size_t)(b * 2 + (hh - 8)) * NKEY + key) * 128);
            *(unsigned*)(dst + 2 * lane) = cvt_pk_bf16(o0, o1);
        }
#pragma unroll
        for (int hh = 0; hh < 16; ++hh) {
            const bool isq = hh < 8; const int h = hh & 7;
            float a0 = bf_lo(raw[10 + hh]), a1 = bf_hi(raw[10 + hh]);
            float ss = a0 * a0 + a1 * a1;
#pragma unroll
            for (int o = 1; o < 32; o <<= 1) ss += shx(ss, o, lane);
            const float rinv = rsqrtf(ss * (1.0f / 64.0f) + 1e-6f);
            a0 *= rinv * (isq ? gqb.x : gkb.x); a1 *= rinv * (isq ? gqb.y : gkb.y);
            const float p0 = shx(a0, 8, lane), p1 = shx(a1, 8, lane);
            float o0 = a0 * cB0 + sgnB * p0 * sB0, o1 = a1 * cB1 + sgnB * p1 * sB1;
            if (isq) { const float sc = 0.125f * LOG2E; o0 *= sc; o1 *= sc; }
            bf16_t* dst = isq ? pr + C_BQ + h * 128 : F_KB + (((size_t)(b * 8 + h) * NKEY + key) * 128);
            *(unsigned*)(dst + 2 * lane) = cvt_pk_bf16(o0, o1);
        }
    }
    for (int it = gw; it < 288 * 40; it += NGW) {
        const int tile = it / 40, q = it % 40; const bool isA = q < 8; const int head = isA ? (q >> 2) : ((q - 8) >> 2), slab = q & 3;
        const bool isc = tile < 32; const int b = isc ? (tile >> 2) : ((tile - 32) >> 5), t0 = isc ? ((tile & 3) * 64) : (((tile - 32) & 31) * 64);
        const int row = (isc ? b * CTXL : NCTX + b * SEQ) + t0 + lane, key = (isc ? 0 : CTXL) + t0 + lane;
        const bf16_t* src = P1 + (size_t)row * N1 + (isA ? C_AV : C_BV) + head * 128 + slab * 32;
        u32x4 v[4];
#pragma unroll
        for (int j = 0; j < 4; ++j) v[j] = *(const u32x4*)(src + 8 * j);
        const int keyp = (key & ~12) | ((key & 8) >> 1) | ((key & 4) << 1);
        bf16_t* dst = (isA ? F_VTA + ((size_t)(b * 2 + head) * 128 + slab * 32) * NKEY : F_VTB + ((size_t)(b * 8 + head) * 128 + slab * 32) * NKEY) + keyp;
#pragma unroll
        for (int j = 0; j < 4; ++j) { const unsigned w[4] = {v[j].x, v[j].y, v[j].z, v[j].w};
#pragma unroll
            for (int e = 0; e < 4; ++e) { dst[(size_t)(8 * j + 2 * e) * NKEY] = (bf16_t)(w[e] & 0xffffu); dst[(size_t)(8 * j + 2 * e + 1) * NKEY] = (bf16_t)(w[e] >> 16); } }
    }
}

constexpr int AT_KBYTES = 64 * 256, AT_VBYTES = 128 * 128, AT_BUF = AT_KBYTES + AT_VBYTES, AT_XCH = 0;
struct AttnUnit { bool isA, isc; int b, h, qt; };
template <bool IS_A>
__device__ __forceinline__ void attn_unit(const Frame& F, int l, const AttnUnit u) {
    constexpr int NS = IS_A ? 8 : 4;
    const int tid = F.tid, lane = F.lane, w = F.wave, r = lane & 31, h5 = lane >> 5;
    LAS unsigned char* lds = F.lds;
    int t, head, dofs, qcol0;
    if (IS_A) { const int g = w >> 1, qb = w & 1; t = u.qt * 64 + 32 * qb + r; head = u.h * 4 + g; dofs = 0; qcol0 = C_AQ + head * 128; }
    else { const int comp = w >> 2, qb = w & 3; t = u.qt * 128 + 32 * qb + r; head = u.h; dofs = comp * 64; qcol0 = C_BQ + head * 128 + comp * 64; }
    const int qrow = (u.isc ? u.b * CTXL : NCTX + u.b * SEQ) + t;
    const int nhk = IS_A ? 2 : 8;
    const bf16_t* Kb = (IS_A ? F_KA : F_KB) + (size_t)(u.b * nhk + u.h) * NKEY * 128;
    const bf16_t* Vt = (IS_A ? F_VTA : F_VTB) + (size_t)(u.b * nhk + u.h) * 128 * NKEY;
    int lt_lo = 0, ntile;
    if (u.isc) ntile = 4;
    else if (IS_A) { lt_lo = u.qt - 2 < 0 ? 0 : u.qt - 2; const int lt_hi = u.qt + 2 > 31 ? 31 : u.qt + 2; ntile = 4 + lt_hi - lt_lo + 1; }
    else ntile = 36;
    const int wu = __builtin_amdgcn_readfirstlane(w);
    auto tile_of = [&](int j) -> int { return (IS_A && !u.isc && j >= 4) ? 4 + lt_lo + (j - 4) : j; };
    auto dma = [&](int kt, int buf) {
#pragma unroll
        for (int i = 0; i < 2; ++i) { const int blk = 2 * wu + i; const int row = 4 * blk + (lane >> 4); const int c = (lane & 15) ^ (row & 15);
            __builtin_amdgcn_global_load_lds((const unsigned*)((const unsigned char*)Kb + ((size_t)(kt * 64 + row)) * 256 + c * 16), (LAS unsigned*)(lds + buf * AT_BUF + blk * 1024), 16, 0, 0); }
#pragma unroll
        for (int i = 0; i < 2; ++i) { const int blk = 2 * wu + i; const int row = 8 * blk + (lane >> 3); const int c = (lane & 7) ^ ((row >> 1) & 7);
            __builtin_amdgcn_global_load_lds((const unsigned*)((const unsigned char*)Vt + (size_t)row * (NKEY * 2) + kt * 128 + c * 16), (LAS unsigned*)(lds + buf * AT_BUF + AT_KBYTES + blk * 1024), 16, 0, 0); }
    };
    dma(tile_of(0), 0); if (!IS_A) dma(tile_of(1), 1);
    float bound2, sinkp = 0.f;
    if (IS_A) { const float gq = wave_max(fmaxf(fabsf(F_qn_a[l * 128 + lane]), fabsf(F_qn_a[l * 128 + 64 + lane])), lane), gk = wave_max(fmaxf(fabsf(F_kn_a[l * 128 + lane]), fabsf(F_kn_a[l * 128 + 64 + lane])), lane);
        bound2 = LOG2E * 11.313708498984761f * gq * gk; sinkp = exp2f(F_sink_a[l * 8 + head] * LOG2E - bound2); }
    else { const float gq = wave_max(fabsf(F_qn_b[l * 64 + lane]), lane), gk = wave_max(fabsf(F_kn_b[l * 64 + lane]), lane); bound2 = LOG2E * 8.0f * gq * gk; }
    bf16x8 qf[NS];
    { const bf16_t* qp = F_P1 + (size_t)qrow * N1 + qcol0 + 8 * h5;
#pragma unroll
        for (int s = 0; s < NS; ++s) qf[s] = *(const bf16x8*)(qp + 16 * s); }
    f32x16 oacc[4];
#pragma unroll
    for (int i = 0; i < 4; ++i)
#pragma unroll
        for (int j = 0; j < 16; ++j) oacc[i][j] = 0.f;
    float lsum = 0.f;
    const int koff0 = r * 256 + (((dofs >> 3) + h5) ^ (r & 15)) * 16;
    const int voff0 = r * 128 + (h5 ^ ((r >> 1) & 7)) * 16;
    asm volatile("s_waitcnt vmcnt(0)" ::: "memory");
    __syncthreads();
    constexpr int TPB = IS_A ? 1 : 2;
    for (int j = 0; j < ntile; j += TPB) {
        const int pair = (j / TPB) & 1;
        if (j + TPB < ntile) {
#pragma unroll
            for (int q = 0; q < TPB; ++q) dma(tile_of(j + TPB + q), (pair ^ 1) * TPB + q); }
#pragma unroll
        for (int q = 0; q < TPB; ++q) {
        const int kt = tile_of(j + q);
        const LAS unsigned char* kb = lds + (pair * TPB + q) * AT_BUF; const LAS unsigned char* vb = kb + AT_KBYTES;
        const bool band = IS_A && !u.isc && kt >= 4;
        const int kpos0 = (kt - 4) * 64;
        bf16x8 kf[NS]; u32x4 vf[8];
        auto kread = [&](int sub) {
#pragma unroll
            for (int s = 0; s < NS; ++s) kf[s] = *(const LAS bf16x8*)(kb + 8192 * sub + (koff0 ^ (32 * s))); };
        auto vread = [&](int sub) {
#pragma unroll
            for (int dvt = 0; dvt < 4; ++dvt)
#pragma unroll
                for (int s2 = 0; s2 < 2; ++s2) vf[2 * dvt + s2] = *(const LAS u32x4*)(vb + 4096 * dvt + (voff0 ^ (64 * sub + 32 * s2))); };
        kread(0);
        vread(0);
        __builtin_amdgcn_sched_barrier(0);
#pragma unroll
        for (int sub = 0; sub < 2; ++sub) {
            f32x16 sacc;
#pragma unroll
            for (int i = 0; i < 16; ++i) sacc[i] = -bound2;
#pragma unroll
            for (int s = 0; s < NS; ++s) sacc = __builtin_amdgcn_mfma_f32_32x32x16_bf16(kf[s], qf[s], sacc, 0, 0, 0);
            float p[16];
#pragma unroll
            for (int i = 0; i < 16; ++i) { float e = __builtin_amdgcn_exp2f(sacc[i]);
                if (band) { const int kpos = kpos0 + 32 * sub + (i & 3) + 8 * (i >> 2) + 4 * h5; const int dlt = kpos - t; e = (dlt <= 128 && dlt >= -128) ? e : 0.f; }
                p[i] = e; lsum += e; }
            bf16x8 pb[2];
#pragma unroll
            for (int s2 = 0; s2 < 2; ++s2) { u32x4 pk; pk.x = cvt_pk_bf16(p[8 * s2 + 0], p[8 * s2 + 1]); pk.y = cvt_pk_bf16(p[8 * s2 + 2], p[8 * s2 + 3]); pk.z = cvt_pk_bf16(p[8 * s2 + 4], p[8 * s2 + 5]); pk.w = cvt_pk_bf16(p[8 * s2 + 6], p[8 * s2 + 7]);
                pb[s2] = __builtin_bit_cast(bf16x8, pk); }
            __builtin_amdgcn_sched_barrier(0);
            if (sub == 0) { kread(1); __builtin_amdgcn_sched_barrier(0); }
#pragma unroll
            for (int dvt = 0; dvt < 4; ++dvt)
#pragma unroll
                for (int s2 = 0; s2 < 2; ++s2) oacc[dvt] = __builtin_amdgcn_mfma_f32_32x32x16_bf16(__builtin_bit_cast(bf16x8, vf[2 * dvt + s2]), pb[s2], oacc[dvt], 0, 0, 0);
            __builtin_amdgcn_sched_barrier(0);
            if (sub == 0) { vread(1); __builtin_amdgcn_sched_barrier(0); }
        }
        }
        asm volatile("s_waitcnt vmcnt(0)" ::: "memory");
        __syncthreads();
    }
    float ltot = lsum + shx(lsum, 32, lane) + sinkp;
    const float linv = 1.0f / ltot;
    bf16_t* orow = F_O + (size_t)qrow * 4096;
    if (IS_A) {
#pragma unroll
        for (int dvt = 0; dvt < 4; ++dvt)
#pragma unroll
            for (int g = 0; g < 4; ++g) { u32x2 o; o.x = cvt_pk_bf16(oacc[dvt][4 * g] * linv, oacc[dvt][4 * g + 1] * linv); o.y = cvt_pk_bf16(oacc[dvt][4 * g + 2] * linv, oacc[dvt][4 * g + 3] * linv);
                *(u32x2*)(orow + head * 128 + 32 * dvt + 8 * g + 4 * h5) = o; }
    } else {
        LAS float* xch = (LAS float*)(lds + AT_XCH) + (w & 3) * 4096;
        if (w >= 4) {
#pragma unroll
            for (int dvt = 0; dvt < 4; ++dvt)
#pragma unroll
                for (int i = 0; i < 16; ++i) xch[(dvt * 16 + i) * 64 + lane] = oacc[dvt][i] * linv;
        }
        __syncthreads();
        if (w < 4) {
            const float* lb = F_lam_b + l * 256;
            const float d1 = wave_sum(lb[lane] * lb[64 + lane], lane), d2 = wave_sum(lb[128 + lane] * lb[192 + lane], lane);
            const float lam_init = 0.8f - 0.6f * expf(-0.3f * (float)l), lam = expf(d1) - expf(d2) + lam_init;
            float ss = 0.f;
#pragma unroll
            for (int dvt = 0; dvt < 4; ++dvt)
#pragma unroll
                for (int i = 0; i < 16; ++i) { const float d = oacc[dvt][i] * linv - lam * xch[(dvt * 16 + i) * 64 + lane]; oacc[dvt][i] = d; ss += d * d; }
            ss += shx(ss, 32, lane);
            const float rn = rsqrtf(ss * (1.0f / 128.0f) + 1e-6f) * (1.0f - lam_init);
            const float* sg = F_subln_b + l * 128;
#pragma unroll
            for (int dvt = 0; dvt < 4; ++dvt)
#pragma unroll
                for (int g = 0; g < 4; ++g) { const int dv = 32 * dvt + 8 * g + 4 * h5; const f32x4 gg = *(const f32x4*)(sg + dv);
                    u32x2 o; o.x = cvt_pk_bf16(oacc[dvt][4 * g] * rn * gg.x, oacc[dvt][4 * g + 1] * rn * gg.y); o.y = cvt_pk_bf16(oacc[dvt][4 * g + 2] * rn * gg.z, oacc[dvt][4 * g + 3] * rn * gg.w);
                    *(u32x2*)(orow + 1024 + head * 128 + dv) = o; }
        }
    }
}
__device__ __forceinline__ float gelu_tanh(float x) { const float z = 0.7978845608028654f * (x + 0.044715f * x * x * x); const float e = __expf(2.0f * z); return 0.5f * x * (2.0f - 2.0f / (1.0f + e)); }
#define F_HB ((bf16_t*)(F.ws + WS_HB))
__device__ __forceinline__ void lru_unit(const Frame& F, int l, int b, int blk, int d) {
    const int tid = F.tid, lane = F.lane, w = F.wave, ch = tid & 127, tq = tid >> 7, fr = lane & 15, fq = lane >> 4;
    LAS float* U = (LAS float*)F.lds;
    LAS bf16_t* Ub = (LAS bf16_t*)(F.lds + 32768);
    LAS f32x2* AV = (LAS f32x2*)(F.lds + 32768 + 17408);
    LAS f32x2* SEG = (LAS f32x2*)(F.lds + 32768 + 17408 + 65536);
    LAS float* HC = (LAS float*)(F.lds + 32768 + 17408 + 65536 + 4096);
    const bf16_t* P1 = F_P1;
    const int cg = blk * 128 + ch;
    const float cw0 = F_conv_w[(l * 4 + 0) * 1024 + cg], cw1 = F_conv_w[(l * 4 + 1) * 1024 + cg], cw2 = F_conv_w[(l * 4 + 2) * 1024 + cg], cw3 = F_conv_w[(l * 4 + 3) * 1024 + cg], cb = F_conv_b[l * 1024 + cg];
    const bool ctx_out = l < DEPTH - 1;
    bf16_t* hout = (d == 0) ? F_O + 2048 + cg : F_HB + cg; const size_t hstride = (d == 0) ? 4096 : 1024;
    bf16x8 wr[4], wi[4];
    { const float* wrp = F_w_rg + ((size_t)((l * 2 + d) * 8 + blk) * 128) * 128 + 16 * w + fr; const float* wip = F_w_ig + ((size_t)((l * 2 + d) * 8 + blk) * 128) * 128 + 16 * w + fr;
#pragma unroll
        for (int ks = 0; ks < 4; ++ks) { u32x4 a, c2; const int c0 = 32 * ks + 8 * fq;
            a.x = cvt_pk_bf16(wrp[(c0 + 0) * 128], wrp[(c0 + 1) * 128]); a.y = cvt_pk_bf16(wrp[(c0 + 2) * 128], wrp[(c0 + 3) * 128]); a.z = cvt_pk_bf16(wrp[(c0 + 4) * 128], wrp[(c0 + 5) * 128]); a.w = cvt_pk_bf16(wrp[(c0 + 6) * 128], wrp[(c0 + 7) * 128]);
            c2.x = cvt_pk_bf16(wip[(c0 + 0) * 128], wip[(c0 + 1) * 128]); c2.y = cvt_pk_bf16(wip[(c0 + 2) * 128], wip[(c0 + 3) * 128]); c2.z = cvt_pk_bf16(wip[(c0 + 4) * 128], wip[(c0 + 5) * 128]); c2.w = cvt_pk_bf16(wip[(c0 + 6) * 128], wip[(c0 + 7) * 128]);
            wr[ks] = __builtin_bit_cast(bf16x8, a); wi[ks] = __builtin_bit_cast(bf16x8, c2); } }
    const int cj = blk * 128 + 16 * w + fr;
    const float br = F_b_rg[(l * 2 + d) * 1024 + cj], bi = F_b_ig[(l * 2 + d) * 1024 + cj];
    const float sp8 = 8.0f * log1pf(expf(-F_lru_lambda[(l * 2 + d) * 1024 + cj]));
    if (tid < 128) HC[tid] = 0.f;
    auto geom = [&](int step, int& rowbase, int& t0, int& seglen) { const bool isc = step < 4; const int idx = isc ? step : step - 4, nch = isc ? 4 : 32, ci = (d == 0) ? idx : nch - 1 - idx; t0 = ci * 64; seglen = isc ? CTXL : SEQ; rowbase = isc ? b * CTXL : NCTX + b * SEQ; };
    unsigned short xr[19];
    auto ldraw = [&](int step) { int rowbase, t0, seglen; geom(step, rowbase, t0, seglen); const int ts = t0 + tq * 16;
#pragma unroll
        for (int i = 0; i < 19; ++i) { const int t = ts - 2 + i; xr[i] = (t >= 0 && t < seglen) ? P1[(size_t)(rowbase + t) * N1 + C_CX + cg] : (unsigned short)0; } };
    ldraw(0);
    for (int step = 0; step < 36; ++step) {
        int rowbase, t0, seglen; geom(step, rowbase, t0, seglen);
        const bool isc = step < 4;
#pragma unroll
        for (int tt = 0; tt < 16; ++tt) { const float u = cb + cw0 * bf2f(xr[tt]) + cw1 * bf2f(xr[tt + 1]) + cw2 * bf2f(xr[tt + 2]) + cw3 * bf2f(xr[tt + 3]);
            U[(tq * 16 + tt) * 128 + ch] = u; Ub[(tq * 16 + tt) * 136 + ch] = (bf16_t)(cvt_pk_bf16(u, 0.f) & 0xffffu); }
        __syncthreads();
        if (step + 1 < 36) ldraw(step + 1);
#pragma unroll
        for (int mt = 0; mt < 4; ++mt) { f32x4 ar = (f32x4){0.f, 0.f, 0.f, 0.f}, ai = ar;
#pragma unroll
            for (int ks = 0; ks < 4; ++ks) { const bf16x8 a = *(const LAS bf16x8*)(Ub + (16 * mt + fr) * 136 + 32 * ks + 8 * fq);
                ar = __builtin_amdgcn_mfma_f32_16x16x32_bf16(a, wr[ks], ar, 0, 0, 0); ai = __builtin_amdgcn_mfma_f32_16x16x32_bf16(a, wi[ks], ai, 0, 0, 0); }
#pragma unroll
            for (int rg = 0; rg < 4; ++rg) { const int tok = 16 * mt + 4 * fq + rg, cl = 16 * w + fr;
                const float r = sigmoidf_(ar[rg] + br), ig = sigmoidf_(ai[rg] + bi); const float a_ = __expf(-sp8 * r);
                const float v = __builtin_amdgcn_sqrtf(fmaxf(1.0f - a_ * a_, 0.f)) * ig * U[tok * 128 + cl]; AV[tok * 128 + cl] = (f32x2){a_, v}; } }
        __syncthreads();
        float hl[16], cp[16];
        { float h = 0.f, pr = 1.f;
#pragma unroll
            for (int i = 0; i < 16; ++i) { const int p = 16 * tq + i, tok = (d == 0) ? p : 63 - p; const f32x2 av = AV[tok * 128 + ch]; h = av.x * h + av.y; pr *= av.x; hl[i] = h; cp[i] = pr; }
            SEG[tq * 128 + ch] = (f32x2){pr, h}; }
        __syncthreads();
        { float carry = HC[ch];
#pragma unroll
            for (int sg = 0; sg < 3; ++sg) { const f32x2 ps = SEG[sg * 128 + ch]; carry = (sg < tq) ? ps.x * carry + ps.y : carry; }
            const bool wr_out = !isc || ctx_out;
#pragma unroll
            for (int i = 0; i < 16; ++i) { const float h = hl[i] + cp[i] * carry; hl[i] = h;
                if (wr_out) { const int p = 16 * tq + i, tok = (d == 0) ? p : 63 - p; hout[(size_t)(rowbase + t0 + tok) * hstride] = (bf16_t)(cvt_pk_bf16(h, 0.f) & 0xffffu); } }
            __syncthreads();
            if (tq == 3) HC[ch] = hl[15]; }
    }
    __syncthreads();
}
__device__ __forceinline__ void lru_finish(const Frame& F, int l) {
    const size_t gt = (size_t)F.vcu * NTHR + F.tid, NGT = (size_t)F.G * NTHR;
    const size_t row_lo = (l == DEPTH - 1) ? NCTX : 0;
    for (size_t i = row_lo * 128 + gt; i < (size_t)NTOK * 128; i += NGT) { const size_t row = i >> 7; const int c8 = (int)(i & 127) * 8;
        bf16_t* op = F_O + row * 4096 + 2048 + c8;
        const u32x4 hf = *(const u32x4*)op, hb = *(const u32x4*)(F_HB + row * 1024 + c8), yv = *(const u32x4*)(F_P1 + row * N1 + C_CY + c8);
        u32x4 o;
        o.x = cvt_pk_bf16((bf_lo(hf.x) + bf_lo(hb.x)) * gelu_tanh(bf_lo(yv.x)), (bf_hi(hf.x) + bf_hi(hb.x)) * gelu_tanh(bf_hi(yv.x)));
        o.y = cvt_pk_bf16((bf_lo(hf.y) + bf_lo(hb.y)) * gelu_tanh(bf_lo(yv.y)), (bf_hi(hf.y) + bf_hi(hb.y)) * gelu_tanh(bf_hi(yv.y)));
        o.z = cvt_pk_bf16((bf_lo(hf.z) + bf_lo(hb.z)) * gelu_tanh(bf_lo(yv.z)), (bf_hi(hf.z) + bf_hi(hb.z)) * gelu_tanh(bf_hi(yv.z)));
        o.w = cvt_pk_bf16((bf_lo(hf.w) + bf_lo(hb.w)) * gelu_tanh(bf_lo(yv.w)), (bf_hi(hf.w) + bf_hi(hb.w)) * gelu_tanh(bf_hi(yv.w)));
        *(u32x4*)op = o; }
}

#define F_DSCR ((bf16_t*)(F.ws + WS_DSCR))
__device__ __forceinline__ void gla_unit(const Frame& F, int l, int b, int h, int d) {
    const int tid = F.tid, lane = F.lane, w = F.wave, kk_ = tid & 127, sc_ = tid >> 7, fr = lane & 15, fq = lane >> 4;
    LAS bf16_t* Qt = (LAS bf16_t*)F.lds;
    LAS bf16_t* Kh = (LAS bf16_t*)(F.lds + 17408);
    LAS bf16_t* KtT = (LAS bf16_t*)(F.lds + 34816);
    LAS bf16_t* Vt = (LAS bf16_t*)(F.lds + 34816 + 18432);
    LAS float* Dc = (LAS float*)(F.lds + 34816 + 36864);
    const bf16_t* P1 = F_P1;
    float lbv = 0.f;
    if (l > 0) { const float x0 = F_lb_d[(0 * 2 + d) * 1024 + h * 128 + kk_], x1 = F_lb_d[(1 * 2 + d) * 1024 + h * 128 + kk_]; lbv = 1.0f / (1.0f + expf(x0 - x1)); }
    const int zcol = (d == 0 ? C_DFF : C_DFB) + h * 128 + kk_, qcol = C_DQ + h * 128 + kk_, vcol = C_DI + h * 128 + kk_;
    f32x4 S[8];
#pragma unroll
    for (int i = 0; i < 8; ++i) S[i] = (f32x4){0.f, 0.f, 0.f, 0.f};
    bf16_t* dscr = (d == 0) ? F_O + 3072 : F_DSCR; const size_t dstride = (d == 0) ? 4096 : 1024;
    const bool ctx_out = l < DEPTH - 1;
    unsigned short zr[16], qr[16], vr[16];
    auto geom = [&](int step, int& rowbase, int& t0) { const bool isc = step < 4; const int idx = isc ? step : step - 4, nch = isc ? 4 : 32, ci = (d == 0) ? idx : nch - 1 - idx; t0 = ci * 64; rowbase = isc ? b * CTXL : NCTX + b * SEQ; };
    auto ldraw = [&](int step) { int rowbase, t0; geom(step, rowbase, t0);
#pragma unroll
        for (int tt = 0; tt < 16; ++tt) { const int p = 16 * sc_ + tt; const size_t row = (size_t)(rowbase + t0 + (d == 0 ? p : 63 - p)); zr[tt] = P1[row * N1 + zcol]; qr[tt] = P1[row * N1 + qcol]; vr[tt] = P1[row * N1 + vcol]; } };
    ldraw(0);
    for (int step = 0; step < 36; ++step) {
        const bool isc = step < 4; int rowbase, t0; geom(step, rowbase, t0);
        { float kh[16]; float eb = 1.0f;
#pragma unroll
            for (int tt = 0; tt < 16; ++tt) { const int p = 16 * sc_ + tt;
                const float z = bf2f(zr[tt]), q = bf2f(qr[tt]);
                const float sg = sigmoidf_(z); const float f = lbv + (1.0f - lbv) * sg; eb = fmaxf(eb * f, 1e-35f);
                const float ebi = __builtin_amdgcn_rcpf(eb);
                kh[tt] = (1.0f - lbv) * (1.0f - sg) * ebi;
                Qt[p * 136 + kk_] = (bf16_t)(cvt_pk_bf16(q * eb, 0.f) & 0xffffu);
                Kh[p * 136 + kk_] = (bf16_t)(cvt_pk_bf16(kh[tt], 0.f) & 0xffffu); }
            const float ebl = eb;
            u32x4 k0, k1, v0, v1;
            k0.x = cvt_pk_bf16(kh[0] * ebl, kh[1] * ebl); k0.y = cvt_pk_bf16(kh[2] * ebl, kh[3] * ebl); k0.z = cvt_pk_bf16(kh[4] * ebl, kh[5] * ebl); k0.w = cvt_pk_bf16(kh[6] * ebl, kh[7] * ebl);
            k1.x = cvt_pk_bf16(kh[8] * ebl, kh[9] * ebl); k1.y = cvt_pk_bf16(kh[10] * ebl, kh[11] * ebl); k1.z = cvt_pk_bf16(kh[12] * ebl, kh[13] * ebl); k1.w = cvt_pk_bf16(kh[14] * ebl, kh[15] * ebl);
            v0.x = (unsigned)vr[0] | ((unsigned)vr[1] << 16); v0.y = (unsigned)vr[2] | ((unsigned)vr[3] << 16); v0.z = (unsigned)vr[4] | ((unsigned)vr[5] << 16); v0.w = (unsigned)vr[6] | ((unsigned)vr[7] << 16);
            v1.x = (unsigned)vr[8] | ((unsigned)vr[9] << 16); v1.y = (unsigned)vr[10] | ((unsigned)vr[11] << 16); v1.z = (unsigned)vr[12] | ((unsigned)vr[13] << 16); v1.w = (unsigned)vr[14] | ((unsigned)vr[15] << 16);
            *(LAS u32x4*)(KtT + kk_ * 72 + 16 * sc_) = k0; *(LAS u32x4*)(KtT + kk_ * 72 + 16 * sc_ + 8) = k1;
            *(LAS u32x4*)(Vt + kk_ * 72 + 16 * sc_) = v0; *(LAS u32x4*)(Vt + kk_ * 72 + 16 * sc_ + 8) = v1;
            Dc[sc_ * 128 + kk_] = ebl; }
        __syncthreads();
        if (step + 1 < 36) ldraw(step + 1);
        u32x2 attb2[4];
#pragma unroll
        for (int sc = 0; sc < 4; ++sc) { f32x4 att = (f32x4){0.f, 0.f, 0.f, 0.f};
#pragma unroll
            for (int ks = 0; ks < 4; ++ks) { const bf16x8 a = *(const LAS bf16x8*)(Kh + (16 * sc + fr) * 136 + 32 * ks + 8 * fq), bq = *(const LAS bf16x8*)(Qt + (16 * sc + fr) * 136 + 32 * ks + 8 * fq);
                att = __builtin_amdgcn_mfma_f32_16x16x32_bf16(a, bq, att, 0, 0, 0); }
#pragma unroll
            for (int rg = 0; rg < 4; ++rg) att[rg] = (4 * fq + rg <= fr) ? att[rg] : 0.f;
            attb2[sc] = (u32x2){cvt_pk_bf16(att[0], att[1]), cvt_pk_bf16(att[2], att[3])}; }
#pragma unroll
        for (int sc = 0; sc < 4; ++sc) {
            const u32x4 attb = (u32x4){attb2[sc].x, attb2[sc].y, 0u, 0u};
            f32x4 o = (f32x4){0.f, 0.f, 0.f, 0.f};
#pragma unroll
            for (int ks = 0; ks < 4; ++ks) { u32x4 sa; sa.x = cvt_pk_bf16(S[2 * ks][0], S[2 * ks][1]); sa.y = cvt_pk_bf16(S[2 * ks][2], S[2 * ks][3]); sa.z = cvt_pk_bf16(S[2 * ks + 1][0], S[2 * ks + 1][1]); sa.w = cvt_pk_bf16(S[2 * ks + 1][2], S[2 * ks + 1][3]);
                const u32x2 q0 = *(const LAS u32x2*)(Qt + (16 * sc + fr) * 136 + 32 * ks + 4 * fq), q1 = *(const LAS u32x2*)(Qt + (16 * sc + fr) * 136 + 32 * ks + 16 + 4 * fq);
                const u32x4 qb = (u32x4){q0.x, q0.y, q1.x, q1.y};
                o = __builtin_amdgcn_mfma_f32_16x16x32_bf16(__builtin_bit_cast(bf16x8, sa), __builtin_bit_cast(bf16x8, qb), o, 0, 0, 0); }
            { const u32x2 v0 = *(const LAS u32x2*)(Vt + (16 * w + fr) * 72 + 16 * sc + 4 * fq); const u32x4 va = (u32x4){v0.x, v0.y, 0u, 0u};
                o = __builtin_amdgcn_mfma_f32_16x16x32_bf16(__builtin_bit_cast(bf16x8, va), __builtin_bit_cast(bf16x8, attb), o, 0, 0, 0); }
            if (!isc || ctx_out) { const int p = 16 * sc + fr; const size_t row = (size_t)(rowbase + t0 + (d == 0 ? p : 63 - p));
                u32x2 ov; ov.x = cvt_pk_bf16(o[0], o[1]); ov.y = cvt_pk_bf16(o[2], o[3]); *(u32x2*)(dscr + row * dstride + h * 128 + 16 * w + 4 * fq) = ov; }
            u32x4 vb = (u32x4){0u, 0u, 0u, 0u};
            if (fq < 2) vb = *(const LAS u32x4*)(Vt + (16 * w + fr) * 72 + 16 * sc + 8 * fq);
#pragma unroll
            for (int kt = 0; kt < 8; ++kt) { const f32x4 dc = *(const LAS f32x4*)(Dc + sc * 128 + 16 * kt + 4 * fq); S[kt] *= dc;
                u32x4 ka = (u32x4){0u, 0u, 0u, 0u};
                if (fq < 2) ka = *(const LAS u32x4*)(KtT + (16 * kt + fr) * 72 + 16 * sc + 8 * fq);
                S[kt] = __builtin_amdgcn_mfma_f32_16x16x32_bf16(__builtin_bit_cast(bf16x8, ka), __builtin_bit_cast(bf16x8, vb), S[kt], 0, 0, 0); }
        }
        __syncthreads();
    }
}
__device__ __forceinline__ void gla_finish(const Frame& F, int l) {
    const int gw = F.vcu * NWAVES + F.wave, NGW = F.G * NWAVES, lane = F.lane;
    const int row_lo = (l == DEPTH - 1) ? NCTX : 0;
    const int c0 = 16 * lane, hc = c0 & 127;
    float gn[16];
#pragma unroll
    for (int q = 0; q < 4; ++q) { const f32x4 g4 = *(const f32x4*)(F_onorm_d + l * 128 + hc + 4 * q); gn[4 * q] = g4.x; gn[4 * q + 1] = g4.y; gn[4 * q + 2] = g4.z; gn[4 * q + 3] = g4.w; }
    for (int row = row_lo + gw; row < NTOK; row += NGW) {
        bf16_t* op = F_O + (size_t)row * 4096 + 3072 + c0;
        const u32x4 a0 = *(const u32x4*)op, a1 = *(const u32x4*)(op + 8);
        const u32x4 b0 = *(const u32x4*)(F_DSCR + (size_t)row * 1024 + c0), b1 = *(const u32x4*)(F_DSCR + (size_t)row * 1024 + c0 + 8);
        const u32x4 g0 = *(const u32x4*)(F_P1 + (size_t)row * N1 + C_DG + c0), g1 = *(const u32x4*)(F_P1 + (size_t)row * N1 + C_DG + c0 + 8);
        const unsigned aw[8] = {a0.x, a0.y, a0.z, a0.w, a1.x, a1.y, a1.z, a1.w}, bw[8] = {b0.x, b0.y, b0.z, b0.w, b1.x, b1.y, b1.z, b1.w}, gw_[8] = {g0.x, g0.y, g0.z, g0.w, g1.x, g1.y, g1.z, g1.w};
        float o[16]; float ss = 0.f;
#pragma unroll
        for (int q = 0; q < 8; ++q) { o[2 * q] = bf_lo(aw[q]) + bf_lo(bw[q]); o[2 * q + 1] = bf_hi(aw[q]) + bf_hi(bw[q]); ss += o[2 * q] * o[2 * q] + o[2 * q + 1] * o[2 * q + 1]; }
        ss += shx(ss, 1, lane); ss += shx(ss, 2, lane); ss += shx(ss, 4, lane);
        const float rn = rsqrtf(ss * (1.0f / 128.0f) + 1e-6f);
        unsigned ow[8];
#pragma unroll
        for (int q = 0; q < 8; ++q) { const float ga = bf_lo(gw_[q]), gb = bf_hi(gw_[q]);
            ow[q] = cvt_pk_bf16(o[2 * q] * rn * gn[2 * q] * ga * sigmoidf_(ga), o[2 * q + 1] * rn * gn[2 * q + 1] * gb * sigmoidf_(gb)); }
        *(u32x4*)op = (u32x4){ow[0], ow[1], ow[2], ow[3]}; *(u32x4*)(op + 8) = (u32x4){ow[4], ow[5], ow[6], ow[7]};
    }
}
__device__ __forceinline__ void mix_phase(const Frame& F0, int l) {
    const Frame& F = F0;
    const bool ctx_out = l < DEPTH - 1;
    const int nBl = 8 * 8 * 16, nBc = ctx_out ? 8 * 8 * 2 : 0, nAl = 8 * 2 * 32, nAc = ctx_out ? 8 * 2 * 4 : 0;
    const int nC = ENABLE_C ? 128 : 0, nD = ENABLE_D ? 128 : 0;
    const int total = nC + nD + nBl + nBc + nAl + nAc;
    volatile LAS int* slot = (volatile LAS int*)(F.lds + MISC_OFF + 64);
    unsigned* head = F_ctl + CW_QUEUE + 64 * l;
    for (;;) {
        __syncthreads();
        if (F.tid == 0) *slot = (int)atomicAdd(head, 1u);
        __syncthreads();
        int q = *slot; q = __builtin_amdgcn_readfirstlane(q);
        if (q >= total) break;
        Frame U = F0;
        U.ws = opaque_ptr(F0.ws); U.out = opaque_ptr(F0.out); asm volatile("" : "+v"(U.tid)); U.lane = U.tid & 63;
        const Frame& F = U;
        AttnUnit u;
        if (q < nC) { lru_unit(F, l, q >> 4, (q >> 1) & 7, q & 1); continue; }
        q -= nC;
        if (q < nD) { gla_unit(F, l, q >> 4, (q >> 1) & 7, q & 1); continue; }
        q -= nD;
        if (q < nBl) { u.isA = false; u.isc = false; u.b = q >> 7; u.h = (q >> 4) & 7; u.qt = q & 15; attn_unit<false>(F, l, u); continue; }
        q -= nBl;
        if (q < nBc) { u.isA = false; u.isc = true; u.b = q >> 4; u.h = (q >> 1) & 7; u.qt = q & 1; attn_unit<false>(F, l, u); continue; }
        q -= nBc;
        if (q < nAl) { u.isA = true; u.isc = false; u.b = q >> 6; u.h = (q >> 5) & 1; u.qt = q & 31; attn_unit<true>(F, l, u); continue; }
        q -= nAl;
        { u.isA = true; u.isc = true; u.b = q >> 3; u.h = (q >> 2) & 1; u.qt = q & 3; attn_unit<true>(F, l, u); }
    }
}
__device__ __forceinline__ void zero_o_cols(const Frame& F, int c0, int c1) {
    const int w8 = (c1 - c0) / 8; const size_t gt = (size_t)F.vcu * NTHR + F.tid, NGT = (size_t)F.G * NTHR;
    unsigned z = 0u; asm volatile("" : "+v"(z));
    for (size_t i = gt; i < (size_t)NTOK * w8; i += NGT) { const size_t row = i / w8, c = i % w8; *(u32x4*)(F_O + row * 4096 + c0 + c * 8) = (u32x4){z, z, z, z}; }
}

constexpr int PH_P0 = 0, PH_PER_LAYER = 10, PH_FINAL = 1 + DEPTH * PH_PER_LAYER, N_PHASES = PH_FINAL + 1;
enum { L_NORM1 = 0, L_INPROJ, L_PREP, L_MIX, L_GATE, L_MERGE, L_OUT, L_NORM2, L_MOE1, L_MOE2 };
__global__ void __launch_bounds__(NTHR, 2) trunk_fwd(Args args) {
    extern __shared__ __attribute__((aligned(16))) unsigned char lds_raw[];
    Frame F;
    F.lds = (LAS unsigned char*)lds_raw;
    F.tid = threadIdx.x; F.lane = F.tid & 63; F.wave = __builtin_amdgcn_readfirstlane(F.tid >> 6);
    F.G = gridDim.x; { const int bx = blockIdx.x; F.vcu = (F.G % 8 == 0) ? (bx % 8) * (F.G / 8) + bx / 8 : bx; }
    F.a = &args; F.ws = args.ws; F.out = args.out;
    volatile LAS unsigned* MISC = (volatile LAS unsigned*)(F.lds + MISC_OFF);
    if (F.tid < 32) MISC[F.tid] = 0u;
    __syncthreads();
    const int lo = args.ph_lo, hi = args.ph_hi;
    XcdBarrier bar; bar.bar = F_ctl + CW_BAR; bar.x = 0; bar.st = nullptr;
    if (hi - lo > 1) bar = xcd_barrier_post(F_ctl + CW_BAR, MISC + 8);
#define IN(k) (lo <= (k) && (k) < hi)
#define SEAM(k) do { if (IN(k) && IN((k) + 1)) xcd_barrier(bar); } while (0)

    if (IN(PH_P0)) { { const Frame P = phase_frame(F); p0_mod(P); } { const Frame P = phase_frame(F); p0_weights(P); }
#if !ENABLE_MIX
        { const Frame P = phase_frame(F); p0_copy_x(P); }
#endif
    }
    SEAM(PH_P0);
    for (int l = 0; l < DEPTH; ++l) {
        const int base = 1 + l * PH_PER_LAYER;
        const int pm0 = (l == DEPTH - 1) ? 8 : 0;
        if (IN(base + L_NORM1)) { const Frame P = phase_frame(F); norm_phase<1>(P, l); }
        SEAM(base + L_NORM1);
#if ENABLE_MIX
        if (IN(base + L_INPROJ)) { const Frame Fo = F; const Frame F = phase_frame(Fo);
            PolDenseBf16 S; S.K = D; S.lda = D * 2; S.ldb = D * 2; S.A = (const char*)F_H; S.B = (const char*)(F_WIN + (size_t)l * INW * D); S.C = F_P1; S.ldc = N1; S.nM = 72; S.nN = 46; S.pm0 = 0; S.G = F.G; S.c = (int)blockIdx.x;
            g8::gemm_phase(F.lds, S, F.tid);
        }
        SEAM(base + L_INPROJ);
        if (IN(base + L_PREP)) { const Frame P = phase_frame(F); prep_phase(P, l); if (!ENABLE_C) zero_o_cols(P, 2048, 3072); if (!ENABLE_D) zero_o_cols(P, 3072, 4096); }
        SEAM(base + L_PREP);
        if (IN(base + L_MIX)) { const Frame P = phase_frame(F); mix_phase(P, l); }
        SEAM(base + L_MIX);
        if (IN(base + L_GATE)) { const Frame Fo = F; const Frame F = phase_frame(Fo);
            if (ENABLE_D) gla_finish(F, l);
            if (ENABLE_C) lru_finish(F, l);
            if (hi - lo > 1) xcd_barrier(bar);
            PolDenseBf16 S; S.K = D; S.lda = D * 2; S.ldb = D * 2; S.A = (const char*)F_H; S.B = (const char*)(F_WIN + ((size_t)l * INW + N1) * D); S.C = F_P1; S.ldc = NG; S.nM = 72 - pm0; S.nN = 32; S.pm0 = pm0; S.G = F.G; S.c = (int)blockIdx.x;
            g8::gemm_phase(F.lds, S, F.tid);
        }
        SEAM(base + L_GATE);
        if (IN(base + L_MERGE)) { const Frame Fo = F; const Frame F = phase_frame(Fo);
            PolMerge S; S.K = 1024; S.lda = 4096 * 2; S.ldb = 1024 * 2; S.A = (const char*)F_O; S.B = (const char*)(F_WBR + (size_t)l * 4 * D * 1024); S.Gt = F_P1; S.Yo = F_Y; S.nM = 64; S.pm0 = 8; S.G = F.G; S.c = (int)blockIdx.x;
            g8::gemm_phase(F.lds, S, F.tid);
        }
        SEAM(base + L_MERGE);
        if (IN(base + L_OUT)) {
            const bool split = (l < DEPTH - 1) && (F.G > 64);
            if (split && (int)blockIdx.x < 64) { const Frame Fo = F; const Frame F = phase_frame(Fo);
                PolMerge S; S.K = 1024; S.lda = 4096 * 2; S.ldb = 1024 * 2; S.A = (const char*)F_O; S.B = (const char*)(F_WBR + (size_t)l * 4 * D * 1024); S.Gt = F_P1; S.Yo = F_Y; S.nM = 8; S.pm0 = 0; S.G = 64; S.c = (int)blockIdx.x;
                g8::gemm_phase(F.lds, S, F.tid);
            } else { const Frame Fo = F; const Frame F = phase_frame(Fo);
                PolOut S; S.K = D; S.lda = D * 2; S.ldb = D * 2; S.A = (const char*)F_Y; S.B = (const char*)(F_WOUT + (size_t)l * D * D);
                S.xin_c = (l == 0) ? F_ctx : F_XC; S.xin_l = (l == 0) ? F_x : F.out; S.xout_c = F_XC; S.xout_l = F.out; S.mod_l = F_MOD + (size_t)l * 9 * 6 * D; S.nM = 64; S.pm0 = 8;
                S.G = split ? F.G - 64 : F.G; S.c = split ? (int)blockIdx.x - 64 : (int)blockIdx.x;
                g8::gemm_phase(F.lds, S, F.tid);
            }
            if (split) {
                if (hi - lo > 1) xcd_barrier(bar);
                const Frame Fo = F; const Frame F = phase_frame(Fo);
                PolOut S; S.K = D; S.lda = D * 2; S.ldb = D * 2; S.A = (const char*)F_Y; S.B = (const char*)(F_WOUT + (size_t)l * D * D);
                S.xin_c = (l == 0) ? F_ctx : F_XC; S.xin_l = (l == 0) ? F_x : F.out; S.xout_c = F_XC; S.xout_l = F.out; S.mod_l = F_MOD + (size_t)l * 9 * 6 * D; S.nM = 8; S.pm0 = 0; S.G = F.G; S.c = (int)blockIdx.x;
                g8::gemm_phase(F.lds, S, F.tid);
            }
        }
        SEAM(base + L_OUT);
#endif
        if (IN(base + L_NORM2)) { const Frame P = phase_frame(F); norm2_phase(P, l); }
        SEAM(base + L_NORM2);
        if (IN(base + L_MOE1)) { const Frame Fo = F; const Frame F = phase_frame(Fo);
            PolMoe<1> S; S.K = D; S.lda = D * 2; S.ldb = D * 2; S.A = (const char*)F_H; S.Bw = (const char*)(F_WGU + (size_t)l * NEXP * 1024 * D); S.C = (bf16_t*)(F.ws + WS_DSCR); S.list = F_LIST; S.nN = 4; S.G = F.G; S.c = (int)blockIdx.x; S.tab = (LAS int*)(F.lds + 131072); S.tid = F.tid;
            S.init(F_ctl + CW_CNT + 64 * l);
            g8::gemm_phase(F.lds, S, F.tid);
        }
        SEAM(base + L_MOE1);
        if (IN(base + L_MOE2)) { const Frame Fo = F; const Frame F = phase_frame(Fo);
            PolMoe<2> S; S.K = DFF; S.lda = DFF * 2; S.ldb = DFF * 2; S.A = (const char*)(F.ws + WS_DSCR); S.Bw = (const char*)(F_WD + (size_t)l * NEXP * D * DFF); S.C = F_O; S.list = F_LIST; S.nN = 8; S.G = F.G; S.c = (int)blockIdx.x; S.tab = (LAS int*)(F.lds + 131072); S.tid = F.tid;
            S.init(F_ctl + CW_CNT + 64 * l);
            g8::gemm_phase(F.lds, S, F.tid);
        }
        SEAM(base + L_MOE2);
        (void)pm0;
    }
    if (IN(PH_FINAL)) { const Frame P = phase_frame(F); norm_phase<3>(P, 0); }
#undef IN
#undef SEAM
}

extern "C" void kernel_launch(void* const* d_in, const int* in_sizes, int n_in, void* d_out, int out_size, void* d_ws, size_t ws_size, hipStream_t stream) {
    static int grid = 0;
    if (grid == 0) {
        if (n_in != 32 || out_size != NLAT * D || ws_size < WS_END) { fprintf(stderr, "kernel_launch: unexpected shapes (n_in %d, out %d, ws %zu)\n", n_in, out_size, ws_size); grid = -1; return; }
        int dev = 0, cus = 0, per_cu = 0;
        if (hipGetDevice(&dev) != hipSuccess || hipDeviceGetAttribute(&cus, hipDeviceAttributeMultiprocessorCount, dev) != hipSuccess) { grid = -1; return; }
        if (hipFuncSetAttribute((const void*)trunk_fwd, hipFuncAttributeMaxDynamicSharedMemorySize, LDS_BYTES) != hipSuccess) { fprintf(stderr, "kernel_launch: hipFuncSetAttribute failed\n"); grid = -1; return; }
        if (hipOccupancyMaxActiveBlocksPerMultiprocessor(&per_cu, (const void*)trunk_fwd, NTHR, LDS_BYTES) != hipSuccess || per_cu < 1) fprintf(stderr, "kernel_launch: occupancy query says %d\n", per_cu);
        (void)hipGetLastError();
        grid = cus;
    }
    if (grid < 0) return;
    if (hipMemsetAsync((char*)d_ws + WS_CTL, 0, CTL_ZERO_BYTES, stream) != hipSuccess) return;
    Args a{};
    for (int i = 0; i < 32; ++i) a.in[i] = (const float*)d_in[i];
    a.out = (float*)d_out; a.ws = (unsigned char*)d_ws;
#if N_LAUNCH_MODE == 1
    a.ph_lo = 0; a.ph_hi = N_PHASES;
    hipLaunchKernelGGL(trunk_fwd, dim3(grid), dim3(NTHR), LDS_BYTES, stream, a);
#else
    for (int p = 0; p < N_PHASES; ++p) {
        const int pl = (p - 1) % PH_PER_LAYER;
#if !ENABLE_MIX
        if (p >= 1 && p < PH_FINAL && pl >= L_INPROJ && pl <= L_OUT) continue;
#endif
        a.ph_lo = p; a.ph_hi = p + 1;
        hipLaunchKernelGGL(trunk_fwd, dim3(grid), dim3(NTHR), LDS_BYTES, stream, a);
    }
#endif
}
```

```cpp
#include <hip/hip_runtime.h>
#include <cstdio>
#include <cstdint>

#ifndef N_LAUNCH_MODE
#define N_LAUNCH_MODE 1
#endif
#ifndef ENABLE_C
#define ENABLE_C 1
#endif
#ifndef ENABLE_D
#define ENABLE_D 1
#endif
#ifndef ENABLE_MIX
#define ENABLE_MIX 1
#endif

#define LAS __attribute__((address_space(3)))
#define GAS __attribute__((address_space(1)))
typedef unsigned short bf16_t;
typedef short bf16x8 __attribute__((ext_vector_type(8)));
typedef short bf16x4 __attribute__((ext_vector_type(4)));
typedef float f32x2 __attribute__((ext_vector_type(2)));
typedef float f32x4 __attribute__((ext_vector_type(4)));
typedef float f32x16 __attribute__((ext_vector_type(16)));
typedef unsigned u32x2 __attribute__((ext_vector_type(2)));
typedef unsigned u32x4 __attribute__((ext_vector_type(4)));

constexpr int D = 2048, NB = 8, SEQ = 2048, CTXL = 256, DEPTH = 2;
constexpr int NCTX = NB * CTXL, NLAT = NB * SEQ, NTOK = NCTX + NLAT;
constexpr int N1 = 11776, NG = 8192, INW = N1 + NG;
constexpr int NEXP = 16, DFF = 512;
constexpr int NWAVES = 8, NTHR = 512;
constexpr int C_AQ = 0, C_AK = 1024, C_AV = 1280, C_BQ = 1536, C_BK = 2560, C_BV = 3584, C_CX = 4608, C_CY = 5632, C_DQ = 6656, C_DFF = 7680, C_DFB = 8704, C_DI = 9728, C_DG = 10752;

constexpr size_t MiB = 1u << 20;
constexpr size_t WS_CTL = 0, CTL_ZERO_BYTES = 2 * MiB;
constexpr size_t WS_MOD = 1 * MiB;
constexpr size_t WS_WIN = 2 * MiB;
constexpr size_t WS_WBR = 158 * MiB;
constexpr size_t WS_WOUT = 190 * MiB;
constexpr size_t WS_WGU = 206 * MiB;
constexpr size_t WS_WD = 334 * MiB;
constexpr size_t WS_H = 398 * MiB;
constexpr size_t WS_Y = 470 * MiB;
constexpr size_t WS_P1 = 542 * MiB;
constexpr size_t WS_O = 956 * MiB;
constexpr size_t WS_XC = 1100 * MiB;
constexpr size_t WS_HID = 1116 * MiB;
constexpr size_t WS_LIST = 1152 * MiB;
constexpr size_t WS_RW = 1154 * MiB;
constexpr size_t WS_DSCR = 1156 * MiB;
constexpr size_t WS_HB = 1192 * MiB;
constexpr size_t WS_END = 1228 * MiB;
constexpr int CW_BAR = 4096;
constexpr int CW_CNT = 8192;
constexpr int CW_QUEUE = 8448;
constexpr int CW_QX = 9472;

constexpr int LDS_BYTES = 147456;
constexpr int MISC_OFF = 131072 + 8192;

typedef __bf16 bf16x2_t __attribute__((ext_vector_type(2)));
__device__ __forceinline__ unsigned cvt_pk_bf16(float lo, float hi) { const bf16x2_t r = __builtin_convertvector((f32x2){lo, hi}, bf16x2_t); return __builtin_bit_cast(unsigned, r); }
__device__ __forceinline__ float bf_lo(unsigned u) { return __uint_as_float(u << 16); }
__device__ __forceinline__ float bf_hi(unsigned u) { return __uint_as_float(u & 0xffff0000u); }
__device__ __forceinline__ float bf2f(bf16_t b) { return __uint_as_float(((unsigned)b) << 16); }
__device__ __forceinline__ float shx(float v, int mask, int lane) { return __builtin_bit_cast(float, __builtin_amdgcn_ds_bpermute((lane ^ mask) << 2, __builtin_bit_cast(int, v))); }
__device__ __forceinline__ float wave_sum(float v, int lane) {
#pragma unroll
    for (int o = 1; o < 64; o <<= 1) v += shx(v, o, lane);
    return v;
}
__device__ __forceinline__ float wave_max(float v, int lane) {
#pragma unroll
    for (int o = 1; o < 64; o <<= 1) v = fmaxf(v, shx(v, o, lane));
    return v;
}
__device__ __forceinline__ float sigmoidf_(float x) { return __builtin_amdgcn_rcpf(1.0f + __expf(-x)); }
#define LDS_WAIT() asm volatile("s_waitcnt lgkmcnt(0)" ::: "memory")
#define VM_WAIT() asm volatile("s_waitcnt vmcnt(0)" ::: "memory")

__device__ __forceinline__ int opaque_int(int x);
template <class T> __device__ __forceinline__ T* opaque_ptr(T* p) { return (T*)((unsigned char*)p + opaque_int(0)); }
__device__ __forceinline__ int opaque_int(int x) { asm volatile("" : "+v"(x)); return __builtin_amdgcn_readfirstlane(x); }
#define XB_TMO      128
#define XB_XCNT(j)  (256  + 64 * (j))
#define XB_XSUB(j)  (1280 + 64 * (j))
#define XB_XGEN(j)  (2304 + 64 * (j))
#define XB_TOP      3328
#define XB_TOPGEN   3392
#define XCD_BAR_WORDS 3456
#define XB_SPIN_CAP (1u << 22)
__device__ __forceinline__ unsigned xb_ld(unsigned* p)              { return __hip_atomic_load(p, __ATOMIC_RELAXED, __HIP_MEMORY_SCOPE_AGENT); }
__device__ __forceinline__ unsigned xb_add(unsigned* p, unsigned v) { return __hip_atomic_fetch_add(p, v, __ATOMIC_RELAXED, __HIP_MEMORY_SCOPE_AGENT); }
__device__ __forceinline__ unsigned xb_xcc_id() { return (unsigned)__builtin_amdgcn_s_getreg((3 << 11) | 20) & 0xFu; }
#define XB_SPIN(cond, bar) do { unsigned _sp = 0; while (cond) { __builtin_amdgcn_s_sleep(1); \
    if ((++_sp & 255u) == 0u) { if (xb_ld(&(bar)[XB_TMO])) break; if (_sp > XB_SPIN_CAP) { atomicAdd(&(bar)[XB_TMO], 1u); break; } } } } while (0)
struct XcdBarrier { unsigned* bar; unsigned x; volatile LAS unsigned* st; };
__device__ __forceinline__ XcdBarrier xcd_barrier_post(unsigned* bar, volatile LAS unsigned* st) {
    XcdBarrier b; b.bar = bar; b.x = xb_xcc_id(); b.st = st;
    if (threadIdx.x == 0) (void)xb_add(&bar[XB_XCNT(b.x)], 1u);
    return b;
}
__device__ __forceinline__ void xcd_barrier_complete(unsigned* bar, unsigned x, unsigned& nloc, unsigned& nx) {
    const unsigned G = gridDim.x * gridDim.y * gridDim.z;
    unsigned sum, cnt, mine, sp = 0u;
    for (;;) {
        sum = 0u; cnt = 0u; mine = 0u;
#pragma unroll
        for (unsigned j = 0; j < 16; ++j) { const unsigned c = xb_ld(&bar[XB_XCNT(j)]); sum += c; cnt += (c > 0u) ? 1u : 0u; mine = (j == x) ? c : mine; }
        if (sum == G) break;
        __builtin_amdgcn_s_sleep(1);
        if ((++sp & 255u) == 0u) { if (xb_ld(&bar[XB_TMO])) break; if (sp > XB_SPIN_CAP) { atomicAdd(&bar[XB_TMO], 1u); break; } }
    }
    nloc = mine > 0u ? mine : 1u; nx = cnt > 0u ? cnt : 1u;
}
__device__ __forceinline__ void xcd_barrier(const XcdBarrier& b) {
    asm volatile("s_waitcnt vmcnt(0)" ::: "memory");
    __syncthreads();
    if (threadIdx.x == 0) {
        unsigned* bar = opaque_ptr(b.bar);
        __builtin_amdgcn_s_waitcnt(0);
        unsigned nloc = b.st[0], nx = b.st[1];
        if (nloc == 0u) { xcd_barrier_complete(bar, b.x, nloc, nx); b.st[0] = nloc; b.st[1] = nx; }
        const unsigned old = xb_add(&bar[XB_XSUB(b.x)], 1u);
        const unsigned gen = old / nloc;
        if (old + 1u == (gen + 1u) * nloc) {
            __builtin_amdgcn_fence(__ATOMIC_RELEASE, "agent");
            asm volatile("s_waitcnt vmcnt(0)" ::: "memory");
            const unsigned og = xb_add(&bar[XB_TOP], 1u);
            const unsigned tg = og / nx;
            if (og + 1u == (tg + 1u) * nx) xb_add(&bar[XB_TOPGEN], 1u);
            else XB_SPIN(xb_ld(&bar[XB_TOPGEN]) == tg, bar);
            __builtin_amdgcn_fence(__ATOMIC_ACQUIRE, "agent");
            xb_add(&bar[XB_XGEN(b.x)], 1u);
            asm volatile("s_waitcnt vmcnt(0)" ::: "memory");
        } else {
            XB_SPIN(xb_ld(&bar[XB_XGEN(b.x)]) == gen, bar);
            __builtin_amdgcn_fence(__ATOMIC_ACQUIRE, "agent");
            asm volatile("s_waitcnt vmcnt(0)" ::: "memory");
        }
    }
    __syncthreads();
}

struct Args { const float* in[32]; float* out; unsigned char* ws; int ph_lo, ph_hi; };
struct Frame {
    LAS unsigned char* lds;
    const Args* a;
    unsigned char* ws; float* out;
    int tid, lane, wave, G, vcu;
};
#define FIN(k) (F.a->in[k])
#define F_x FIN(0)
#define F_c FIN(1)
#define F_ctx FIN(2)
#define F_cctx FIN(3)
#define F_w_ada FIN(4)
#define F_b_ada FIN(5)
#define F_norm1_g FIN(6)
#define F_norm2_g FIN(7)
#define F_w_in FIN(8)
#define F_qn_a FIN(9)
#define F_kn_a FIN(10)
#define F_sink_a FIN(11)
#define F_qn_b FIN(12)
#define F_kn_b FIN(13)
#define F_lam_b FIN(14)
#define F_subln_b FIN(15)
#define F_conv_w FIN(16)
#define F_conv_b FIN(17)
#define F_w_rg FIN(18)
#define F_b_rg FIN(19)
#define F_w_ig FIN(20)
#define F_b_ig FIN(21)
#define F_lru_lambda FIN(22)
#define F_lb_d FIN(23)
#define F_onorm_d FIN(24)
#define F_w_branch FIN(25)
#define F_w_out FIN(26)
#define F_w_router FIN(27)
#define F_b_router FIN(28)
#define F_w_gate FIN(29)
#define F_w_up FIN(30)
#define F_w_down FIN(31)
#define F_ctl ((unsigned*)(F.ws + WS_CTL))
#define F_MOD ((float*)(F.ws + WS_MOD))
#define F_WIN ((bf16_t*)(F.ws + WS_WIN))
#define F_WBR ((bf16_t*)(F.ws + WS_WBR))
#define F_WOUT ((bf16_t*)(F.ws + WS_WOUT))
#define F_WGU ((bf16_t*)(F.ws + WS_WGU))
#define F_WD ((bf16_t*)(F.ws + WS_WD))
#define F_H ((bf16_t*)(F.ws + WS_H))
#define F_Y ((bf16_t*)(F.ws + WS_Y))
#define F_P1 ((bf16_t*)(F.ws + WS_P1))
#define F_O ((bf16_t*)(F.ws + WS_O))
#define F_HID ((bf16_t*)(F.ws + WS_HID))
#define F_XC ((float*)(F.ws + WS_XC))
#define F_LIST ((unsigned*)(F.ws + WS_LIST))
#define F_RW ((float*)(F.ws + WS_RW))
__device__ __forceinline__ Frame phase_frame(const Frame& F) {
    Frame P = F;
    P.ws = opaque_ptr(F.ws); P.out = opaque_ptr(F.out);
    P.wave = opaque_int(F.wave); P.G = opaque_int(F.G); P.vcu = opaque_int(F.vcu);
    unsigned ln; asm volatile("v_mbcnt_lo_u32_b32 %0, -1, 0\n\tv_mbcnt_hi_u32_b32 %0, -1, %0" : "=v"(ln));
    P.lane = (int)ln; P.tid = P.wave * 64 + (int)ln;
    return P;
}
__device__ __forceinline__ int mod_index(int row) { return row < NCTX ? 8 : ((row - NCTX) >> 11); }
__device__ __forceinline__ float* xrow_ptr(const Frame& F, int row) { return row < NCTX ? F_XC + (size_t)row * D : F.out + (size_t)(row - NCTX) * D; }
__device__ __forceinline__ const float* xin_ptr(const Frame& F, int row) { return row < NCTX ? F_ctx + (size_t)row * D : F_x + (size_t)(row - NCTX) * D; }

__device__ __forceinline__ void p0_mod(const Frame& F) {
    LAS float* sl = (LAS float*)F.lds;
    LAS float* part = (LAS float*)(F.lds + 9 * D * 4);
    for (int idx = F.tid; idx < 9 * D; idx += NTHR) { const int i = idx >> 11, k = idx & (D - 1); const float v = (i < 8) ? F_c[i * D + k] : F_cctx[k]; sl[idx] = v / (1.0f + __expf(-v)); }
    __syncthreads();
    for (int it = F.vcu; it < DEPTH * 96; it += F.G) {
        const int l = it / 96, jb = it % 96;
        const float* w = F_w_ada + ((size_t)l * D + F.wave * 256) * (6 * D) + jb * 128 + F.lane * 2;
        f32x2 acc[9];
#pragma unroll
        for (int i = 0; i < 9; ++i) acc[i] = (f32x2){0.f, 0.f};
#pragma unroll 8
        for (int k = 0; k < 256; ++k) {
            const f32x2 wv = *(const f32x2*)(w + (size_t)k * (6 * D));
#pragma unroll
            for (int i = 0; i < 9; ++i) acc[i] += sl[i * D + F.wave * 256 + k] * wv;
        }
#pragma unroll
        for (int i = 0; i < 9; ++i) *(LAS f32x2*)(part + (F.wave * 9 + i) * 128 + F.lane * 2) = acc[i];
        __syncthreads();
        for (int idx = F.tid; idx < 9 * 128; idx += NTHR) { const int i = idx >> 7, cidx = idx & 127; float sum = F_b_ada[(size_t)l * 6 * D + jb * 128 + cidx];
#pragma unroll
            for (int wv = 0; wv < 8; ++wv) sum += part[(wv * 9 + i) * 128 + cidx];
            F_MOD[((size_t)(l * 9 + i)) * (6 * D) + jb * 128 + cidx] = sum; }
        __syncthreads();
    }
    __syncthreads();
}
__device__ __forceinline__ void tr_item(const float* W, int ldw, int k0, int n0, bf16_t* dst, int ldd, LAS float* scr, int lane) {
    float tv[32];
#pragma unroll
    for (int i = 0; i < 32; ++i) { const int kk = 2 * i + (lane >> 5); tv[i] = W[(size_t)(k0 + kk) * ldw + n0 + (lane & 31)]; }
#pragma unroll
    for (int i = 0; i < 32; ++i) { const int kk = 2 * i + (lane >> 5); scr[kk * 33 + (lane & 31)] = tv[i]; }
    LDS_WAIT(); asm volatile("" ::: "memory");
    const int c = lane & 7;
#pragma unroll
    for (int j = 0; j < 4; ++j) { const int n = (lane >> 3) + 8 * j; const LAS float* s = scr + (8 * c) * 33 + n;
        u32x4 o; o.x = cvt_pk_bf16(s[0 * 33], s[1 * 33]); o.y = cvt_pk_bf16(s[2 * 33], s[3 * 33]); o.z = cvt_pk_bf16(s[4 * 33], s[5 * 33]); o.w = cvt_pk_bf16(s[6 * 33], s[7 * 33]);
        *(u32x4*)(dst + (size_t)n * ldd + k0 + 8 * c) = o; }
    LDS_WAIT(); asm volatile("" ::: "memory");
}
__device__ __forceinline__ void p0_weights(const Frame& F) {
    LAS float* scr = (LAS float*)(F.lds + F.wave * 8704);
    const int gw = F.vcu * NWAVES + F.wave, NGW = F.G * NWAVES;
    constexpr int I_IN = 32 * 624, I_BR = 16 * 64, I_OUT = 32 * 64, I_G = 32 * 16, I_D = 8 * 64;
    constexpr int S0 = DEPTH * I_IN, S1 = S0 + DEPTH * 4 * I_BR, S2 = S1 + DEPTH * I_OUT, S3 = S2 + DEPTH * NEXP * I_G, S4 = S3 + DEPTH * NEXP * I_G, S5 = S4 + DEPTH * NEXP * I_D;
    for (int it = gw; it < S5; it += NGW) {
        if (it < S0) { const int l = it / I_IN, r = it % I_IN, kb = r / 624, nb = r % 624;
            tr_item(F_w_in + (size_t)l * D * INW, INW, kb * 64, nb * 32, F_WIN + ((size_t)l * INW + nb * 32) * D, D, scr, F.lane); }
        else if (it < S1) { const int q = it - S0, m = q / I_BR, r = q % I_BR, kb = r / 64, nb = r % 64;
            tr_item(F_w_branch + (size_t)m * 1024 * D, D, kb * 64, nb * 32, F_WBR + ((size_t)m * D + nb * 32) * 1024, 1024, scr, F.lane); }
        else if (it < S2) { const int q = it - S1, l = q / I_OUT, r = q % I_OUT, kb = r / 64, nb = r % 64;
            tr_item(F_w_out + (size_t)l * D * D, D, kb * 64, nb * 32, F_WOUT + ((size_t)l * D + nb * 32) * D, D, scr, F.lane); }
        else if (it < S4) { const bool up = it >= S3; const int q = it - (up ? S3 : S2), m = q / I_G, r = q % I_G, kb = r / 16, nb = r % 16;
            const int n0 = nb * 32, drow = 256 * (n0 >> 7) + (n0 & 127) + (up ? 128 : 0);
            tr_item((up ? F_w_up : F_w_gate) + (size_t)m * D * DFF, DFF, kb * 64, n0, F_WGU + ((size_t)m * 1024 + drow) * D, D, scr, F.lane); }
        else { const int q = it - S4, m = q / I_D, r = q % I_D, kb = r / 64, nb = r % 64;
            tr_item(F_w_down + (size_t)m * DFF * D, D, kb * 64, nb * 32, F_WD + ((size_t)m * D + nb * 32) * DFF, DFF, scr, F.lane); }
    }
    __syncthreads();
}
__device__ __forceinline__ void p0_copy_x(const Frame& F) {
    const size_t gt = (size_t)F.vcu * NTHR + F.tid, NGT = (size_t)F.G * NTHR;
    for (size_t i = gt; i < (size_t)NTOK * D / 4; i += NGT) { const int row = (int)(i / (D / 4)); const int c4 = (int)(i % (D / 4));
        *((f32x4*)xrow_ptr(F, row) + c4) = *((const f32x4*)xin_ptr(F, row) + c4); }
}

template <int WHICH>
__device__ __forceinline__ void norm_phase(const Frame& F, int l) {
    const int gw = F.vcu * NWAVES + F.wave, NGW = F.G * NWAVES, lane = F.lane;
    LAS float* wrT = (LAS float*)F.lds;
    if (WHICH == 2) {
        for (int idx = F.tid; idx < D * NEXP; idx += NTHR) { const int e = idx >> 11, col = idx & (D - 1); wrT[idx] = F_w_router[col * NEXP + e]; }
        if (F.tid < 16) ((LAS unsigned*)(F.lds + 131072))[F.tid] = 0u;
        __syncthreads();
    }
    LAS unsigned* lcnt = (LAS unsigned*)(F.lds + 131072); LAS unsigned* lbase = lcnt + 16; LAS int* lrec = (LAS int*)(F.lds + 131072 + 256);
    int nrec = 0;
    const int row_lo = (WHICH == 3 || (WHICH == 2 && l == DEPTH - 1)) ? NCTX : 0;
    const bf16_t* Y2 = F_O;
    for (int row = row_lo + gw; row < NTOK; row += NGW) {
        const int mi = mod_index(row);
        f32x4 v[8];
        float* xr = xrow_ptr(F, row);
        if (WHICH == 1 && l == 0) { const float* xi = xin_ptr(F, row);
#pragma unroll
            for (int j = 0; j < 8; ++j) v[j] = *(const f32x4*)(xi + 4 * lane + 256 * j);
        } else {
#pragma unroll
            for (int j = 0; j < 8; ++j) v[j] = *(const f32x4*)(xr + 4 * lane + 256 * j);
        }
        if ((WHICH == 1 && l > 0) || WHICH == 3) {
            const int lp = (WHICH == 3) ? DEPTH - 1 : l - 1;
            const float* g2 = F_MOD + ((size_t)(lp * 9 + mi)) * (6 * D) + 5 * D;
            const f32x2 rw = *(const f32x2*)(F_RW + 2 * (size_t)row);
            const bf16_t* ya = Y2 + (size_t)(2 * row) * D; const bf16_t* yb = ya + D;
#pragma unroll
            for (int j = 0; j < 8; ++j) { const int col = 4 * lane + 256 * j; const f32x4 g = *(const f32x4*)(g2 + col);
                const u32x2 a = *(const u32x2*)(ya + col), b = *(const u32x2*)(yb + col);
                v[j].x += g.x * (rw.x * bf_lo(a.x) + rw.y * bf_lo(b.x)); v[j].y += g.y * (rw.x * bf_hi(a.x) + rw.y * bf_hi(b.x));
                v[j].z += g.z * (rw.x * bf_lo(a.y) + rw.y * bf_lo(b.y)); v[j].w += g.w * (rw.x * bf_hi(a.y) + rw.y * bf_hi(b.y));
                *(f32x4*)(xr + col) = v[j]; }
        }
        if (WHICH == 3) continue;
        float ss = 0.f;
#pragma unroll
        for (int j = 0; j < 8; ++j) ss += (v[j].x * v[j].x + v[j].y * v[j].y) + (v[j].z * v[j].z + v[j].w * v[j].w);
        const float rinv = rsqrtf(wave_sum(ss, lane) * (1.0f / D) + 1e-6f);
        const float* gn = (WHICH == 1 ? F_norm1_g : F_norm2_g) + (size_t)l * D;
        const float* md = F_MOD + ((size_t)(l * 9 + mi)) * (6 * D) + (WHICH == 1 ? 0 : 3) * D;
        bf16_t* hr = F_H + (size_t)row * D;
#pragma unroll
        for (int j = 0; j < 8; ++j) { const int col = 4 * lane + 256 * j; const f32x4 g = *(const f32x4*)(gn + col), sh = *(const f32x4*)(md + col), sc = *(const f32x4*)(md + D + col);
            v[j].x = v[j].x * rinv * g.x * (1.0f + sc.x) + sh.x; v[j].y = v[j].y * rinv * g.y * (1.0f + sc.y) + sh.y;
            v[j].z = v[j].z * rinv * g.z * (1.0f + sc.z) + sh.z; v[j].w = v[j].w * rinv * g.w * (1.0f + sc.w) + sh.w;
            u32x2 o; o.x = cvt_pk_bf16(v[j].x, v[j].y); o.y = cvt_pk_bf16(v[j].z, v[j].w); *(u32x2*)(hr + col) = o; }
        if (WHICH == 2) {
            float lg[NEXP];
#pragma unroll
            for (int e = 0; e < NEXP; ++e) { float a = 0.f;
#pragma unroll
                for (int j = 0; j < 8; ++j) { const f32x4 w = *(const LAS f32x4*)(wrT + e * D + 4 * lane + 256 * j); a += (v[j].x * w.x + v[j].y * w.y) + (v[j].z * w.z + v[j].w * w.w); }
                lg[e] = wave_sum(a, lane); }
            float aff[NEXP], sel[NEXP];
#pragma unroll
            for (int e = 0; e < NEXP; ++e) { aff[e] = 1.0f / (1.0f + expf(-lg[e])); sel[e] = aff[e] + F_b_router[e]; }
            int grp = 0; float best = -1e30f;
#pragma unroll
            for (int g = 0; g < 4; ++g) { float m1 = -1e30f, m2 = -1e30f;
#pragma unroll
                for (int q = 0; q < 4; ++q) { const float s = sel[4 * g + q]; if (s > m1) { m2 = m1; m1 = s; } else if (s > m2) m2 = s; }
                const float gs = m1 + m2; if (gs > best) { best = gs; grp = g; } }
            int i0 = 0, i1 = 0; float s0 = -1e30f, s1 = -1e30f, a0 = 0.f, a1 = 0.f;
#pragma unroll
            for (int g = 0; g < 4; ++g)
#pragma unroll
                for (int q = 0; q < 4; ++q) { const float s = sel[4 * g + q], a = aff[4 * g + q]; const bool in = (g == grp);
                    if (in && s > s0) { s1 = s0; i1 = i0; a1 = a0; s0 = s; i0 = 4 * g + q; a0 = a; } else if (in && s > s1) { s1 = s; i1 = 4 * g + q; a1 = a; } }
            if (lane == 0) {
                const float inv = 1.0f / (a0 + a1);
                *(f32x2*)(F_RW + 2 * (size_t)row) = (f32x2){a0 * inv, a1 * inv};
                LAS int* rec = lrec + (F.wave * 16 + nrec) * 4;
                rec[0] = i0; rec[1] = i1; rec[2] = (int)__hip_atomic_fetch_add(lcnt + i0, 1u, __ATOMIC_RELAXED, __HIP_MEMORY_SCOPE_WORKGROUP); rec[3] = (int)__hip_atomic_fetch_add(lcnt + i1, 1u, __ATOMIC_RELAXED, __HIP_MEMORY_SCOPE_WORKGROUP);
            }
            ++nrec;
        }
    }
    if (WHICH == 2) {
        __syncthreads();
        if (F.tid < 16) lbase[F.tid] = atomicAdd(F_ctl + CW_CNT + 64 * l + F.tid, lcnt[F.tid]);
        __syncthreads();
        if (lane < nrec) { const int row = row_lo + gw + lane * NGW; const LAS int* rec = lrec + (F.wave * 16 + lane) * 4; const int i0 = rec[0], i1 = rec[1];
            F_LIST[(size_t)i0 * NTOK + lbase[i0] + rec[2]] = 2u * row; F_LIST[(size_t)i1 * NTOK + lbase[i1] + rec[3]] = 2u * row + 1u; }
        __syncthreads();
    }
}

__device__ __forceinline__ constexpr int bitrev5(int v) { return ((v & 1) << 4) | ((v & 2) << 2) | (v & 4) | ((v & 8) >> 2) | ((v & 16) >> 4); }
__device__ __forceinline__ void norm2_phase(const Frame& F, int l) {
    const int gw = F.vcu * NWAVES + F.wave, NGW = F.G * NWAVES, lane = F.lane;
    LAS float* wrT = (LAS float*)F.lds;
    for (int idx = F.tid; idx < D * NEXP; idx += NTHR) { const int e = idx >> 11, col = idx & (D - 1); wrT[idx] = F_w_router[col * NEXP + e]; }
    LAS unsigned* lcnt = (LAS unsigned*)(F.lds + 131072); LAS unsigned* lbase = lcnt + 16; LAS int* lrec = (LAS int*)(F.lds + 131072 + 256);
    if (F.tid < 16) lcnt[F.tid] = 0u;
    int nrec = 0;
    __syncthreads();
    const int row_lo = (l == DEPTH - 1) ? NCTX : 0;
    float brt[NEXP];
#pragma unroll
    for (int e = 0; e < NEXP; ++e) brt[e] = F_b_router[e];
    for (int row0 = row_lo + 2 * gw; row0 < NTOK; row0 += 2 * NGW) {
        const int mi = mod_index(row0);
        f32x4 v[2][8];
#pragma unroll
        for (int r = 0; r < 2; ++r) { const float* xr = xrow_ptr(F, row0 + r);
#pragma unroll
            for (int j = 0; j < 8; ++j) v[r][j] = *(const f32x4*)(xr + 4 * lane + 256 * j); }
        float ss0 = 0.f, ss1 = 0.f;
#pragma unroll
        for (int j = 0; j < 8; ++j) { ss0 += (v[0][j].x * v[0][j].x + v[0][j].y * v[0][j].y) + (v[0][j].z * v[0][j].z + v[0][j].w * v[0][j].w); ss1 += (v[1][j].x * v[1][j].x + v[1][j].y * v[1][j].y) + (v[1][j].z * v[1][j].z + v[1][j].w * v[1][j].w); }
        const float rinv[2] = {rsqrtf(wave_sum(ss0, lane) * (1.0f / D) + 1e-6f), rsqrtf(wave_sum(ss1, lane) * (1.0f / D) + 1e-6f)};
        const float* gn = F_norm2_g + (size_t)l * D;
        const float* md = F_MOD + ((size_t)(l * 9 + mi)) * (6 * D) + 3 * D;
#pragma unroll
        for (int j = 0; j < 8; ++j) { const int col = 4 * lane + 256 * j; const f32x4 g = *(const f32x4*)(gn + col), sh = *(const f32x4*)(md + col), sc = *(const f32x4*)(md + D + col);
#pragma unroll
            for (int r = 0; r < 2; ++r) { f32x4& q = v[r][j];
                q.x = q.x * rinv[r] * g.x * (1.0f + sc.x) + sh.x; q.y = q.y * rinv[r] * g.y * (1.0f + sc.y) + sh.y; q.z = q.z * rinv[r] * g.z * (1.0f + sc.z) + sh.z; q.w = q.w * rinv[r] * g.w * (1.0f + sc.w) + sh.w;
                u32x2 o; o.x = cvt_pk_bf16(q.x, q.y); o.y = cvt_pk_bf16(q.z, q.w); *(u32x2*)(F_H + (size_t)(row0 + r) * D + col) = o; } }
        float x[32];
#pragma unroll
        for (int e = 0; e < NEXP; ++e) { float a0 = 0.f, a1 = 0.f;
#pragma unroll
            for (int j = 0; j < 8; ++j) { const f32x4 w = *(const LAS f32x4*)(wrT + e * D + 4 * lane + 256 * j);
                a0 += (v[0][j].x * w.x + v[0][j].y * w.y) + (v[0][j].z * w.z + v[0][j].w * w.w); a1 += (v[1][j].x * w.x + v[1][j].y * w.y) + (v[1][j].z * w.z + v[1][j].w * w.w); }
            x[e] = a0; x[16 + e] = a1; }
#pragma unroll
        for (int k = 0; k < 5; ++k) { const int half = 16 >> k; const bool bit = (lane >> k) & 1;
#pragma unroll
            for (int i = 0; i < half; ++i) { const float send = bit ? x[i] : x[i + half], keep = bit ? x[i + half] : x[i]; x[i] = keep + shx(send, 1 << k, lane); } }
        const float tot = x[0] + shx(x[0], 32, lane);
        const float affv = 1.0f / (1.0f + expf(-tot));
#pragma unroll
        for (int r = 0; r < 2; ++r) {
            float aff[NEXP], sel[NEXP];
#pragma unroll
            for (int e = 0; e < NEXP; ++e) { aff[e] = __builtin_bit_cast(float, __builtin_amdgcn_readlane(__builtin_bit_cast(int, affv), bitrev5(r * 16 + e))); sel[e] = aff[e] + brt[e]; }
            int grp = 0; float best = -1e30f;
#pragma unroll
            for (int g = 0; g < 4; ++g) { float m1 = -1e30f, m2 = -1e30f;
#pragma unroll
                for (int q = 0; q < 4; ++q) { const float s = sel[4 * g + q]; if (s > m1) { m2 = m1; m1 = s; } else if (s > m2) m2 = s; }
                const float gs = m1 + m2; if (gs > best) { best = gs; grp = g; } }
            int i0 = 0, i1 = 0; float s0 = -1e30f, s1 = -1e30f, a0 = 0.f, a1 = 0.f;
#pragma unroll
            for (int g = 0; g < 4; ++g)
#pragma unroll
                for (int q = 0; q < 4; ++q) { const float s = sel[4 * g + q], a = aff[4 * g + q]; const bool in = (g == grp);
                    if (in && s > s0) { s1 = s0; i1 = i0; a1 = a0; s0 = s; i0 = 4 * g + q; a0 = a; } else if (in && s > s1) { s1 = s; i1 = 4 * g + q; a1 = a; } }
            if (lane == 0) { const int row = row0 + r;
                const float inv = 1.0f / (a0 + a1);
                *(f32x2*)(F_RW + 2 * (size_t)row) = (f32x2){a0 * inv, a1 * inv};
                LAS int* rec = lrec + (F.wave * 16 + nrec) * 4;
                rec[0] = i0; rec[1] = i1; rec[2] = (int)__hip_atomic_fetch_add(lcnt + i0, 1u, __ATOMIC_RELAXED, __HIP_MEMORY_SCOPE_WORKGROUP); rec[3] = (int)__hip_atomic_fetch_add(lcnt + i1, 1u, __ATOMIC_RELAXED, __HIP_MEMORY_SCOPE_WORKGROUP); }
            ++nrec;
        }
    }
    __syncthreads();
    if (F.tid < 16) lbase[F.tid] = atomicAdd(F_ctl + CW_CNT + 64 * l + F.tid, lcnt[F.tid]);
    __syncthreads();
    if (lane < nrec) { const int row = row_lo + 2 * gw + (lane >> 1) * 2 * NGW + (lane & 1); const LAS int* rec = lrec + (F.wave * 16 + lane) * 4; const int i0 = rec[0], i1 = rec[1];
        F_LIST[(size_t)i0 * NTOK + lbase[i0] + rec[2]] = 2u * row; F_LIST[(size_t)i1 * NTOK + lbase[i1] + rec[3]] = 2u * row + 1u; }
    __syncthreads();
}

namespace g8 {
constexpr int BM = 256, BK = 64, HALF = 128, HTB = HALF * BK * 2, STAGE_BYTES = 8 * HTB;
__device__ __forceinline__ int lds_byte(int r, int c) { const int st = (r >> 4) * 2 + (c >> 5), rr = r & 15, cc = c & 31, ob = rr * 64 + cc * 2; return st * 1024 + (ob ^ (((ob >> 9) & 1) << 5)); }
__device__ __forceinline__ void stage_rc(int b, int& R, int& C) { const int st = b / 1024, sb = b % 1024, swz = sb ^ (((sb >> 9) & 1) << 5); R = (st >> 1) * 16 + swz / 64; C = (st & 1) * 32 + (swz % 64) / 2; }
__device__ __forceinline__ int perm32(int rho) { const int n = rho >> 4, i = rho & 15; return 8 * (i >> 2) + 4 * n + (i & 3); }
__device__ __forceinline__ void tile_order(int L, int nM, int nN, int& pm, int& pn) {
    const int nwg = nM * nN; int wgid = L;
    { const int q = nwg / 8, r = nwg % 8, xcd = wgid % 8, off = wgid / 8; wgid = (xcd < r ? xcd * (q + 1) : r * (q + 1) + (xcd - r) * q) + off; }
    const int nig = 8 * nN, gid = wgid / nig, fm = gid * 8, gsz = (nM - fm) < 8 ? (nM - fm) : 8;
    pm = fm + ((wgid % nig) % gsz); pn = (wgid % nig) / gsz;
}
struct GU { int pm, pn, aux, valid; const char* A; const char* B; };

template <class P>
__device__ __forceinline__ void gemm_phase(LAS unsigned char* lds, const P& S, const int tid) {
    const int wid = __builtin_amdgcn_readfirstlane(tid >> 6), lane = tid & 63, wr = wid >> 2, wc = wid & 3, fr = lane & 15, fq = lane >> 4;
    const int K = S.K, nt = K / BK;
    const unsigned lda = S.lda, ldb = S.ldb;
    int Rr[2], Cc[2]; unsigned voffB[2];
#pragma unroll
    for (int i = 0; i < 2; ++i) { stage_rc(tid * 16 + i * 8192, Rr[i], Cc[i]); const int Rb = P::PERM ? ((Rr[i] & ~31) + perm32(Rr[i] & 31)) : Rr[i]; voffB[i] = (unsigned)Rb * ldb + (unsigned)Cc[i] * 2u; }
    unsigned offA[2][2], offAn[2][2];
#pragma unroll
    for (int h = 0; h < 2; ++h)
#pragma unroll
        for (int i = 0; i < 2; ++i) { offA[h][i] = (unsigned)(h * HALF + Rr[i]) * lda + (unsigned)Cc[i] * 2u; offAn[h][i] = offA[h][i]; }
    const size_t kstep = (size_t)(BK * 2);
    const size_t hstepB = (size_t)HALF * ldb;
    const unsigned ldsw = (unsigned)wid * 1024u;
    const int aoff = lds_byte(wr * 64 + fr, fq * 8), boff = lds_byte(wc * 32 + fr, fq * 8);
#define G8_SA(b, h) (((b) * 2 + (h)) * HTB)
#define G8_SB(b, h) ((4 + (b) * 2 + (h)) * HTB)
#define G8_STAGE_A(bufoff, gbase, offs, h) do { _Pragma("unroll") for (int _i = 0; _i < 2; ++_i) \
        __builtin_amdgcn_global_load_lds((const unsigned*)((const char*)(gbase) + (offs)[h][_i]), (LAS unsigned*)(lds + (bufoff) + ldsw + _i * 8192), 16, 0, 0); } while (0)
#define G8_STAGE_B(bufoff, gbase) do { _Pragma("unroll") for (int _i = 0; _i < 2; ++_i) \
        __builtin_amdgcn_global_load_lds((const unsigned*)((const char*)(gbase) + voffB[_i]), (LAS unsigned*)(lds + (bufoff) + ldsw + _i * 8192), 16, 0, 0); } while (0)
#define G8_LDA(dst, b, h) do { _Pragma("unroll") for (int m = 0; m < 4; ++m) _Pragma("unroll") for (int k = 0; k < 2; ++k) dst[m][k] = *(const LAS bf16x8*)(lds + G8_SA(b, h) + aoff + m * 2048 + k * 1024); } while (0)
#define G8_LDB(dst, b, h) do { _Pragma("unroll") for (int n = 0; n < 2; ++n) _Pragma("unroll") for (int k = 0; k < 2; ++k) dst[n][k] = *(const LAS bf16x8*)(lds + G8_SB(b, h) + boff + n * 2048 + k * 1024); } while (0)
#define G8_MMA(ai, bj, At, Bt) do { __builtin_amdgcn_s_setprio(1); _Pragma("unroll") for (int m = 0; m < 4; ++m) _Pragma("unroll") for (int n = 0; n < 2; ++n) _Pragma("unroll") for (int k = 0; k < 2; ++k) \
        acc[ai][bj][m][n] = __builtin_amdgcn_mfma_f32_16x16x32_bf16(Bt[n][k], At[m][k], acc[ai][bj][m][n], 0, 0, 0); __builtin_amdgcn_s_setprio(0); } while (0)
#define G8_WAIT_V(n) asm volatile("s_waitcnt vmcnt(" #n ")" ::: "memory")
#define G8_WAIT_L(n) asm volatile("s_waitcnt lgkmcnt(" #n ")" ::: "memory")
#define G8_BAR __builtin_amdgcn_s_barrier()
#define G8_SCHED __builtin_amdgcn_sched_barrier(0)
    GU cur, nxt; int ui = 0;
    if (!S.next(0, cur)) return;
    if constexpr (P::GATHER) { S.rows(cur, offA); asm volatile("" : "+v"(offA[0][0]), "+v"(offA[0][1]), "+v"(offA[1][0]), "+v"(offA[1][1])); }
    f32x4 acc[2][2][4][2];
#pragma unroll
    for (int a = 0; a < 2; ++a)
#pragma unroll
        for (int b = 0; b < 2; ++b)
#pragma unroll
            for (int m = 0; m < 4; ++m)
#pragma unroll
                for (int n = 0; n < 2; ++n) acc[a][b][m][n] = (f32x4){0.f, 0.f, 0.f, 0.f};
    bf16x8 At[4][2], B0[2][2], B1[2][2];
    const char* cA = cur.A; const char* cB = cur.B;
    G8_STAGE_B(G8_SB(0, 0), cB); G8_STAGE_A(G8_SA(0, 0), cA, offA, 0); G8_STAGE_B(G8_SB(0, 1), cB + hstepB); G8_STAGE_A(G8_SA(0, 1), cA, offA, 1);
    if (wr == 1) G8_BAR;
    G8_WAIT_V(4); G8_BAR;
    G8_STAGE_B(G8_SB(1, 0), cB + kstep); G8_STAGE_A(G8_SA(1, 0), cA + kstep, offA, 0); G8_STAGE_B(G8_SB(1, 1), cB + hstepB + kstep);
    G8_WAIT_V(6); G8_BAR;
    for (;;) {
        const bool has_next = S.next(ui + 1, nxt);
        const char* nA = has_next ? nxt.A : cA; const char* nB = has_next ? nxt.B : cB;
        if constexpr (P::GATHER) {
            if (has_next) S.rows(nxt, offAn);
            else {
#pragma unroll
                for (int h = 0; h < 2; ++h)
#pragma unroll
                    for (int i = 0; i < 2; ++i) offAn[h][i] = offA[h][i]; }
            asm volatile("" : "+v"(offAn[0][0]), "+v"(offAn[0][1]), "+v"(offAn[1][0]), "+v"(offAn[1][1]));
        }
        for (int t = 0; t < nt; t += 2) {
            const bool last = (t == nt - 2);
            const char* a1 = cA + (size_t)(t + 1) * kstep;
            const char* a2 = last ? nA : cA + (size_t)(t + 2) * kstep; const char* b2 = last ? nB : cB + (size_t)(t + 2) * kstep;
            const char* a3 = a2 + kstep; const char* b3 = b2 + kstep;
            unsigned o2[2][2];
#pragma unroll
            for (int h = 0; h < 2; ++h)
#pragma unroll
                for (int i = 0; i < 2; ++i) o2[h][i] = (P::GATHER && last) ? offAn[h][i] : offA[h][i];
            G8_LDB(B0, 0, 0); G8_SCHED; G8_LDA(At, 0, 0); G8_STAGE_A(G8_SA(1, 1), a1, offA, 1);
            G8_WAIT_L(8); G8_BAR; G8_WAIT_L(0); G8_MMA(0, 0, At, B0); G8_BAR; G8_SCHED;
            G8_LDB(B1, 0, 1); G8_STAGE_B(G8_SB(0, 0), b2);
            G8_BAR; G8_WAIT_L(0); G8_MMA(0, 1, At, B1); G8_BAR;
            G8_LDA(At, 0, 1); G8_STAGE_A(G8_SA(0, 0), a2, o2, 0);
            G8_BAR; G8_WAIT_L(0); G8_MMA(1, 0, At, B0); G8_BAR; G8_SCHED;
            G8_STAGE_B(G8_SB(0, 1), b2 + hstepB);
            G8_WAIT_V(6); G8_BAR; G8_MMA(1, 1, At, B1); G8_BAR;
            G8_LDB(B0, 1, 0); G8_SCHED; G8_LDA(At, 1, 0); G8_STAGE_A(G8_SA(0, 1), a2, o2, 1);
            G8_WAIT_L(8); G8_BAR; G8_WAIT_L(0); G8_MMA(0, 0, At, B0); G8_BAR; G8_SCHED;
            G8_LDB(B1, 1, 1); G8_STAGE_B(G8_SB(1, 0), b3);
            G8_BAR; G8_WAIT_L(0); G8_MMA(0, 1, At, B1); G8_BAR;
            G8_LDA(At, 1, 1); G8_STAGE_A(G8_SA(1, 0), a3, o2, 0);
            G8_BAR; G8_WAIT_L(0); G8_MMA(1, 0, At, B0); G8_BAR; G8_SCHED;
            G8_STAGE_B(G8_SB(1, 1), b3 + hstepB);
            G8_WAIT_V(6); G8_BAR; G8_MMA(1, 1, At, B1); G8_BAR;
        }
        S.epi(acc, cur, wr, wc, fr, fq);
        if (!has_next) break;
#pragma unroll
        for (int a = 0; a < 2; ++a)
#pragma unroll
            for (int b = 0; b < 2; ++b)
#pragma unroll
                for (int m = 0; m < 4; ++m)
#pragma unroll
                    for (int n = 0; n < 2; ++n) acc[a][b][m][n] = (f32x4){0.f, 0.f, 0.f, 0.f};
        cur = nxt; cA = nA; cB = nB; ++ui;
        if constexpr (P::GATHER) {
#pragma unroll
            for (int h = 0; h < 2; ++h)
#pragma unroll
                for (int i = 0; i < 2; ++i) offA[h][i] = offAn[h][i]; }
    }
    G8_WAIT_V(0);
    if (wr == 0) G8_BAR;
    G8_BAR;
#undef G8_SA
#undef G8_SB
#undef G8_STAGE_A
#undef G8_STAGE_B
#undef G8_LDA
#undef G8_LDB
#undef G8_MMA
#undef G8_WAIT_V
#undef G8_WAIT_L
#undef G8_BAR
#undef G8_SCHED
}
}

struct PolDenseBf16 {
    static constexpr bool PERM = true, GATHER = false;
    int K; unsigned lda, ldb;
    const char* A; const char* B; bf16_t* C; int ldc; int nM, nN, pm0, G, c;
    __device__ __forceinline__ bool next(int i, g8::GU& u) const {
        const int L = i * G + c; if (L >= nM * nN) return false;
        g8::tile_order(L, nM, nN, u.pm, u.pn); u.pm += pm0; u.aux = 0; u.valid = 256;
        u.A = A + (size_t)u.pm * 256 * lda; u.B = B + (size_t)u.pn * 256 * ldb; return true;
    }
    __device__ __forceinline__ void epi(const f32x4 (&acc)[2][2][4][2], const g8::GU& u, int wr, int wc, int fr, int fq) const {
        const int row0 = u.pm * 256 + wr * 64 + fr, col0 = u.pn * 256 + wc * 32 + 8 * fq;
#pragma unroll
        for (int ai = 0; ai < 2; ++ai)
#pragma unroll
            for (int m = 0; m < 4; ++m) { bf16_t* rowp = C + (size_t)(row0 + ai * 128 + m * 16) * ldc + col0;
#pragma unroll
                for (int bj = 0; bj < 2; ++bj) { const f32x4 v0 = acc[ai][bj][m][0], v1 = acc[ai][bj][m][1];
                    u32x4 w; w.x = cvt_pk_bf16(v0[0], v0[1]); w.y = cvt_pk_bf16(v0[2], v0[3]); w.z = cvt_pk_bf16(v1[0], v1[1]); w.w = cvt_pk_bf16(v1[2], v1[3]);
                    *(u32x4*)(rowp + bj * 128) = w; } }
    }
};
template <int WHICH>
struct PolMoe {
    static constexpr bool PERM = true, GATHER = (WHICH == 1);
    int K; unsigned lda, ldb;
    const char* A; const char* Bw; bf16_t* C; const unsigned* list; int nN, G, c;
    int tid; LAS int* tab;
    __device__ __forceinline__ void init(const unsigned* cntw) {
        if (tid == 0) { int nt = 0;
            for (int e = 0; e < NEXP; ++e) { const int ce = (int)cntw[e];
                for (int t = 0; t * 256 < ce; ++t) { tab[4 + 4 * nt] = e; tab[5 + 4 * nt] = e * NTOK + t * 256; tab[6 + 4 * nt] = (ce - t * 256) < 256 ? (ce - t * 256) : 256; ++nt; } }
            tab[0] = nt; }
        __syncthreads();
    }
    __device__ __forceinline__ bool next(int i, g8::GU& u) const {
        const int L = i * G + c; if (L >= __builtin_amdgcn_readfirstlane(tab[0]) * nN) return false;
        const int mt = L / nN; u.pn = L % nN;
        const int e = __builtin_amdgcn_readfirstlane(tab[4 + 4 * mt]); u.pm = __builtin_amdgcn_readfirstlane(tab[5 + 4 * mt]); u.valid = __builtin_amdgcn_readfirstlane(tab[6 + 4 * mt]); u.aux = mt;
        u.A = (WHICH == 1) ? A : A + (size_t)mt * 256 * lda; u.B = Bw + ((size_t)e * (WHICH == 1 ? 1024 : D) + (size_t)u.pn * 256) * ldb; return true;
    }
    __device__ __forceinline__ unsigned slot_of(const g8::GU& u, int r) const { const int rr = r < u.valid ? r : 0; return list[u.pm + rr]; }
    __device__ __forceinline__ void rows(const g8::GU& u, unsigned (&off)[2][2]) const {
#pragma unroll
        for (int i = 0; i < 2; ++i) { int R, C; g8::stage_rc(tid * 16 + i * 8192, R, C);
#pragma unroll
            for (int h = 0; h < 2; ++h) { const unsigned s = slot_of(u, h * 128 + R); off[h][i] = (s >> 1) * lda + (unsigned)C * 2u; } }
    }
    __device__ __forceinline__ void epi(const f32x4 (&acc)[2][2][4][2], const g8::GU& u, int wr, int wc, int fr, int fq) const {
        if (WHICH == 1) {
#pragma unroll
            for (int ai = 0; ai < 2; ++ai)
#pragma unroll
                for (int m = 0; m < 4; ++m) { const int r = ai * 128 + wr * 64 + m * 16 + fr;
                    const f32x4 g0 = acc[ai][0][m][0], g1 = acc[ai][0][m][1], u0 = acc[ai][1][m][0], u1 = acc[ai][1][m][1];
                    float h[8];
#pragma unroll
                    for (int q = 0; q < 4; ++q) { h[q] = g0[q] * sigmoidf_(g0[q]) * u0[q]; h[4 + q] = g1[q] * sigmoidf_(g1[q]) * u1[q]; }
                    u32x4 w; w.x = cvt_pk_bf16(h[0], h[1]); w.y = cvt_pk_bf16(h[2], h[3]); w.z = cvt_pk_bf16(h[4], h[5]); w.w = cvt_pk_bf16(h[6], h[7]);
                    *(u32x4*)(C + ((size_t)u.aux * 256 + r) * DFF + u.pn * 128 + wc * 32 + 8 * fq) = w; }
        } else {
            unsigned sl[2][4];
#pragma unroll
            for (int ai = 0; ai < 2; ++ai)
#pragma unroll
                for (int m = 0; m < 4; ++m) sl[ai][m] = slot_of(u, ai * 128 + wr * 64 + m * 16 + fr);
#pragma unroll
            for (int ai = 0; ai < 2; ++ai)
#pragma unroll
                for (int m = 0; m < 4; ++m) { const int r = ai * 128 + wr * 64 + m * 16 + fr; const bool ok = r < u.valid;
#pragma unroll
                    for (int bj = 0; bj < 2; ++bj) { const f32x4 v0 = acc[ai][bj][m][0], v1 = acc[ai][bj][m][1];
                        u32x4 w; w.x = cvt_pk_bf16(v0[0], v0[1]); w.y = cvt_pk_bf16(v0[2], v0[3]); w.z = cvt_pk_bf16(v1[0], v1[1]); w.w = cvt_pk_bf16(v1[2], v1[3]);
                        if (ok) *(u32x4*)(C + (size_t)sl[ai][m] * D + u.pn * 256 + bj * 128 + wc * 32 + 8 * fq) = w; } }
        }
    }
};

struct PolMerge {
    static constexpr bool PERM = true, GATHER = false;
    int K; unsigned lda, ldb;
    const char* A; const char* B; bf16_t* Gt; bf16_t* Yo; int nM, pm0, G, c;
    __device__ __forceinline__ bool next(int i, g8::GU& u) const {
        const int L = (i >> 2) * G + c; if (L >= nM * 8) return false;
        g8::tile_order(L, nM, 8, u.pm, u.pn); u.pm += pm0; u.aux = i & 3; u.valid = 256;
        u.A = A + (size_t)u.pm * 256 * lda + (size_t)u.aux * 2048; u.B = B + ((size_t)u.aux * D + (size_t)u.pn * 256) * ldb; return true;
    }
    __device__ __forceinline__ void epi(const f32x4 (&acc)[2][2][4][2], const g8::GU& u, int wr, int wc, int fr, int fq) const {
        const int row0 = u.pm * 256 + wr * 64 + fr, col0 = u.pn * 256 + wc * 32 + 8 * fq, n = u.aux;
#pragma unroll
        for (int ai = 0; ai < 2; ++ai) {
            u32x4 gv[4][2]; unsigned long long pq[4][2][2];
#pragma unroll
            for (int m = 0; m < 4; ++m)
#pragma unroll
                for (int bj = 0; bj < 2; ++bj) { const bf16_t* gp = Gt + (size_t)(row0 + ai * 128 + m * 16) * NG + n * D + col0 + bj * 128;
                    gv[m][bj] = *(const u32x4*)gp;
                    if (n > 0) { const u32x4 pv = *(const u32x4*)(gp - D); pq[m][bj][0] = (unsigned long long)pv.x | ((unsigned long long)pv.y << 32); pq[m][bj][1] = (unsigned long long)pv.z | ((unsigned long long)pv.w << 32); }
                    else { pq[m][bj][0] = 0ull; pq[m][bj][1] = 0ull; } }
#pragma unroll
            for (int m = 0; m < 4; ++m) { bf16_t* grow = Gt + (size_t)(row0 + ai * 128 + m * 16) * NG + n * D + col0;
#pragma unroll
                for (int bj = 0; bj < 2; ++bj) { const f32x4 v0 = acc[ai][bj][m][0], v1 = acc[ai][bj][m][1]; const u32x4 g = gv[m][bj];
                    const unsigned p0 = (unsigned)pq[m][bj][0], p1 = (unsigned)(pq[m][bj][0] >> 32), p2 = (unsigned)pq[m][bj][1], p3 = (unsigned)(pq[m][bj][1] >> 32);
                    float r[8];
                    r[0] = v0[0] * sigmoidf_(bf_lo(g.x)) + bf_lo(p0); r[1] = v0[1] * sigmoidf_(bf_hi(g.x)) + bf_hi(p0); r[2] = v0[2] * sigmoidf_(bf_lo(g.y)) + bf_lo(p1); r[3] = v0[3] * sigmoidf_(bf_hi(g.y)) + bf_hi(p1);
                    r[4] = v1[0] * sigmoidf_(bf_lo(g.z)) + bf_lo(p2); r[5] = v1[1] * sigmoidf_(bf_hi(g.z)) + bf_hi(p2); r[6] = v1[2] * sigmoidf_(bf_lo(g.w)) + bf_lo(p3); r[7] = v1[3] * sigmoidf_(bf_hi(g.w)) + bf_hi(p3);
                    u32x4 w; w.x = cvt_pk_bf16(r[0], r[1]); w.y = cvt_pk_bf16(r[2], r[3]); w.z = cvt_pk_bf16(r[4], r[5]); w.w = cvt_pk_bf16(r[6], r[7]);
                    if (n < 3) *(u32x4*)(grow + bj * 128) = w;
                    else *(u32x4*)(Yo + (size_t)(row0 + ai * 128 + m * 16) * D + col0 + bj * 128) = w; } }
            asm volatile("" ::: "memory");
        }
    }
};
struct PolOut {
    static constexpr bool PERM = false, GATHER = false;
    int K; unsigned lda, ldb;
    const char* A; const char* B; const float* xin_c; const float* xin_l; float* xout_c; float* xout_l; const float* mod_l; int nM, pm0, G, c;
    __device__ __forceinline__ bool next(int i, g8::GU& u) const {
        const int L = i * G + c; if (L >= nM * 8) return false;
        g8::tile_order(L, nM, 8, u.pm, u.pn); u.pm += pm0; u.aux = 0; u.valid = 256;
        u.A = A + (size_t)u.pm * 256 * lda; u.B = B + (size_t)u.pn * 256 * ldb; return true;
    }
    __device__ __forceinline__ void epi(const f32x4 (&acc)[2][2][4][2], const g8::GU& u, int wr, int wc, int fr, int fq) const {
        const bool isc = u.pm < 8;
        const int mi = isc ? 8 : ((u.pm - 8) >> 3);
        const int lrow0 = (isc ? u.pm * 256 : (u.pm - 8) * 256) + wr * 64 + fr, col0 = u.pn * 256 + wc * 32 + 4 * fq;
        const float* xi = isc ? xin_c : xin_l; float* xo = isc ? xout_c : xout_l;
        const float* g1 = mod_l + (size_t)mi * (6 * D) + 2 * D + col0;
        f32x4 gv[2][2];
#pragma unroll
        for (int bj = 0; bj < 2; ++bj)
#pragma unroll
            for (int n = 0; n < 2; ++n) gv[bj][n] = *(const f32x4*)(g1 + bj * 128 + n * 16);
#pragma unroll
        for (int ai = 0; ai < 2; ++ai) {
            f32x4 xv[4][2][2];
#pragma unroll
            for (int m = 0; m < 4; ++m) { const size_t off = (size_t)(lrow0 + ai * 128 + m * 16) * D + col0;
#pragma unroll
                for (int bj = 0; bj < 2; ++bj)
#pragma unroll
                    for (int n = 0; n < 2; ++n) xv[m][bj][n] = *(const f32x4*)(xi + off + bj * 128 + n * 16); }
#pragma unroll
            for (int m = 0; m < 4; ++m) { const size_t off = (size_t)(lrow0 + ai * 128 + m * 16) * D + col0;
#pragma unroll
                for (int bj = 0; bj < 2; ++bj)
#pragma unroll
                    for (int n = 0; n < 2; ++n) *(f32x4*)(xo + off + bj * 128 + n * 16) = xv[m][bj][n] + gv[bj][n] * acc[ai][bj][m][n]; }
            asm volatile("" ::: "memory");
        }
    }
};

constexpr float LOG2E = 1.4426950408889634f;
constexpr int NKEY = CTXL + SEQ;
#define F_KB ((bf16_t*)(F.ws + WS_Y))
#define F_VTB ((bf16_t*)(F.ws + WS_Y + 36 * MiB))
#define F_KA ((bf16_t*)(F.ws + WS_HID))
#define F_VTA ((bf16_t*)(F.ws + WS_HID + 9 * MiB))
__device__ __forceinline__ void prep_phase(const Frame& F, int l) {
    const int gw = F.vcu * NWAVES + F.wave, NGW = F.G * NWAVES, lane = F.lane;
    bf16_t* P1 = F_P1;
    const f32x2 gqa = *(const f32x2*)(F_qn_a + l * 128 + 2 * lane), gka = *(const f32x2*)(F_kn_a + l * 128 + 2 * lane);
    const f32x2 gqb = *(const f32x2*)(F_qn_b + l * 64 + ((2 * lane) & 63)), gkb = *(const f32x2*)(F_kn_b + l * 64 + ((2 * lane) & 63));
    const float invA0 = exp2f(-(float)((2 * lane) & 31) * (13.287712379549449f / 32.0f)), invA1 = exp2f(-(float)((2 * lane + 1) & 31) * (13.287712379549449f / 32.0f));
    const float invB0 = exp2f(-(float)((2 * lane) & 15) * (13.287712379549449f / 16.0f)), invB1 = exp2f(-(float)((2 * lane + 1) & 15) * (13.287712379549449f / 16.0f));
    const float sgnA = (lane & 16) ? 1.f : -1.f, sgnB = (lane & 8) ? 1.f : -1.f;
    for (int row = gw; row < NTOK; row += NGW) {
        const bool isc = row < NCTX; const int b = isc ? (row >> 8) : ((row - NCTX) >> 11), t = isc ? (row & 255) : ((row - NCTX) & 2047);
        const int key = isc ? t : CTXL + t;
        const float prow = (float)(t >> 6), pcol = (float)(t & 63);
        bf16_t* pr = P1 + (size_t)row * N1;
        unsigned raw[26];
#pragma unroll
        for (int hh = 0; hh < 10; ++hh) raw[hh] = *(const unsigned*)(pr + (hh < 8 ? C_AQ + hh * 128 : C_AK + (hh - 8) * 128) + 2 * lane);
#pragma unroll
        for (int hh = 0; hh < 16; ++hh) raw[10 + hh] = *(const unsigned*)(pr + (hh < 8 ? C_BQ : C_BK) + (hh & 7) * 128 + 2 * lane);
        float cA0 = 1.f, sA0 = 0.f, cA1 = 1.f, sA1 = 0.f, cB0 = 1.f, sB0 = 0.f, cB1 = 1.f, sB1 = 0.f;
        if (!isc) { const float pa = (lane & 32) ? pcol : prow, pb = (lane & 16) ? pcol : prow;
            sincosf(pa * invA0, &sA0, &cA0); sincosf(pa * invA1, &sA1, &cA1); sincosf(pb * invB0, &sB0, &cB0); sincosf(pb * invB1, &sB1, &cB1); }
#pragma unroll
        for (int hh = 0; hh < 10; ++hh) {
            const bool isq = hh < 8;
            float a0 = bf_lo(raw[hh]), a1 = bf_hi(raw[hh]);
            const float rinv = rsqrtf(wave_sum(a0 * a0 + a1 * a1, lane) * (1.0f / 128.0f) + 1e-6f);
            a0 *= rinv * (isq ? gqa.x : gka.x); a1 *= rinv * (isq ? gqa.y : gka.y);
            const float p0 = shx(a0, 16, lane), p1 = shx(a1, 16, lane);
            float o0 = a0 * cA0 + sgnA * p0 * sA0, o1 = a1 * cA1 + sgnA * p1 * sA1;
            if (isq) { const float sc = 0.08838834764831845f * LOG2E; o0 *= sc; o1 *= sc; }
            bf16_t* dst = isq ? pr + C_AQ + hh * 128 : F_KA + (((size_t)(b * 2 + (hh - 8)) * NKEY + key) * 128);
            *(unsigned*)(dst + 2 * lane) = cvt_pk_bf16(o0, o1);
        }
#pragma unroll
        for (int hh = 0; hh < 16; ++hh) {
            const bool isq = hh < 8; const int h = hh & 7;
            float a0 = bf_lo(raw[10 + hh]), a1 = bf_hi(raw[10 + hh]);
            float ss = a0 * a0 + a1 * a1;
#pragma unroll
            for (int o = 1; o < 32; o <<= 1) ss += shx(ss, o, lane);
            const float rinv = rsqrtf(ss * (1.0f / 64.0f) + 1e-6f);
            a0 *= rinv * (isq ? gqb.x : gkb.x); a1 *= rinv * (isq ? gqb.y : gkb.y);
            const float p0 = shx(a0, 8, lane), p1 = shx(a1, 8, lane);
            float o0 = a0 * cB0 + sgnB * p0 * sB0, o1 = a1 * cB1 + sgnB * p1 * sB1;
            if (isq) { const float sc = 0.125f * LOG2E; o0 *= sc; o1 *= sc; }
            bf16_t* dst = isq ? pr + C_BQ + h * 128 : F_KB + (((size_t)(b * 8 + h) * NKEY + key) * 128);
            *(unsigned*)(dst + 2 * lane) = cvt_pk_bf16(o0, o1);
        }
    }
    for (int it = gw; it < 288 * 40; it += NGW) {
        const int tile = it / 40, q = it % 40; const bool isA = q < 8; const int head = isA ? (q >> 2) : ((q - 8) >> 2), slab = q & 3;
        const bool isc = tile < 32; const int b = isc ? (tile >> 2) : ((tile - 32) >> 5), t0 = isc ? ((tile & 3) * 64) : (((tile - 32) & 31) * 64);
        const int row = (isc ? b * CTXL : NCTX + b * SEQ) + t0 + lane, key = (isc ? 0 : CTXL) + t0 + lane;
        const bf16_t* src = P1 + (size_t)row * N1 + (isA ? C_AV : C_BV) + head * 128 + slab * 32;
        u32x4 v[4];
#pragma unroll
        for (int j = 0; j < 4; ++j) v[j] = *(const u32x4*)(src + 8 * j);
        const int keyp = (key & ~12) | ((key & 8) >> 1) | ((key & 4) << 1);
        bf16_t* dst = (isA ? F_VTA + ((size_t)(b * 2 + head) * 128 + slab * 32) * NKEY : F_VTB + ((size_t)(b * 8 + head) * 128 + slab * 32) * NKEY) + keyp;
#pragma unroll
        for (int j = 0; j < 4; ++j) { const unsigned w[4] = {v[j].x, v[j].y, v[j].z, v[j].w};
#pragma unroll
            for (int e = 0; e < 4; ++e) { dst[(size_t)(8 * j + 2 * e) * NKEY] = (bf16_t)(w[e] & 0xffffu); dst[(size_t)(8 * j + 2 * e + 1) * NKEY] = (bf16_t)(w[e] >> 16); } }
    }
}

constexpr int AT_KBYTES = 64 * 256, AT_VBYTES = 128 * 128, AT_BUF = AT_KBYTES + AT_VBYTES, AT_XCH = 2 * AT_BUF;
struct AttnUnit { bool isA, isc; int b, h, qt; };
template <bool IS_A>
__device__ __forceinline__ void attn_unit(const Frame& F, int l, const AttnUnit u) {
    constexpr int NS = IS_A ? 8 : 4;
    const int tid = F.tid, lane = F.lane, w = F.wave, r = lane & 31, h5 = lane >> 5;
    LAS unsigned char* lds = F.lds;
    int t, head, dofs, qcol0;
    if (IS_A) { const int g = w >> 1, qb = w & 1; t = u.qt * 64 + 32 * qb + r; head = u.h * 4 + g; dofs = 0; qcol0 = C_AQ + head * 128; }
    else { const int comp = w >> 2, qb = w & 3; t = u.qt * 128 + 32 * qb + r; head = u.h; dofs = comp * 64; qcol0 = C_BQ + head * 128 + comp * 64; }
    const int qrow = (u.isc ? u.b * CTXL : NCTX + u.b * SEQ) + t;
    const int nhk = IS_A ? 2 : 8;
    const bf16_t* Kb = (IS_A ? F_KA : F_KB) + (size_t)(u.b * nhk + u.h) * NKEY * 128;
    const bf16_t* Vt = (IS_A ? F_VTA : F_VTB) + (size_t)(u.b * nhk + u.h) * 128 * NKEY;
    int lt_lo = 0, ntile;
    if (u.isc) ntile = 4;
    else if (IS_A) { lt_lo = u.qt - 2 < 0 ? 0 : u.qt - 2; const int lt_hi = u.qt + 2 > 31 ? 31 : u.qt + 2; ntile = 4 + lt_hi - lt_lo + 1; }
    else ntile = 36;
    const int wu = __builtin_amdgcn_readfirstlane(w);
    auto tile_of = [&](int j) -> int { return (IS_A && !u.isc && j >= 4) ? 4 + lt_lo + (j - 4) : j; };
    auto dma = [&](int kt, int buf) {
#pragma unroll
        for (int i = 0; i < 2; ++i) { const int blk = 2 * wu + i; const int row = 4 * blk + (lane >> 4); const int c = (lane & 15) ^ (row & 15);
            __builtin_amdgcn_global_load_lds((const unsigned*)((const unsigned char*)Kb + ((size_t)(kt * 64 + row)) * 256 + c * 16), (LAS unsigned*)(lds + buf * AT_BUF + blk * 1024), 16, 0, 0); }
#pragma unroll
        for (int i = 0; i < 2; ++i) { const int blk = 2 * wu + i; const int row = 8 * blk + (lane >> 3); const int c = (lane & 7) ^ ((row >> 1) & 7);
            __builtin_amdgcn_global_load_lds((const unsigned*)((const unsigned char*)Vt + (size_t)row * (NKEY * 2) + kt * 128 + c * 16), (LAS unsigned*)(lds + buf * AT_BUF + AT_KBYTES + blk * 1024), 16, 0, 0); }
    };
    dma(tile_of(0), 0);
    float bound2, sinkp = 0.f;
    if (IS_A) { const float gq = wave_max(fmaxf(fabsf(F_qn_a[l * 128 + lane]), fabsf(F_qn_a[l * 128 + 64 + lane])), lane), gk = wave_max(fmaxf(fabsf(F_kn_a[l * 128 + lane]), fabsf(F_kn_a[l * 128 + 64 + lane])), lane);
        bound2 = LOG2E * 11.313708498984761f * gq * gk; sinkp = exp2f(F_sink_a[l * 8 + head] * LOG2E - bound2); }
    else { const float gq = wave_max(fabsf(F_qn_b[l * 64 + lane]), lane), gk = wave_max(fabsf(F_kn_b[l * 64 + lane]), lane); bound2 = LOG2E * 8.0f * gq * gk; }
    bf16x8 qf[NS];
    { const bf16_t* qp = F_P1 + (size_t)qrow * N1 + qcol0 + 8 * h5;
#pragma unroll
        for (int s = 0; s < NS; ++s) qf[s] = *(const bf16x8*)(qp + 16 * s); }
    f32x16 oacc[4];
#pragma unroll
    for (int i = 0; i < 4; ++i)
#pragma unroll
        for (int j = 0; j < 16; ++j) oacc[i][j] = 0.f;
    float lsum = 0.f;
    const int koff0 = r * 256 + (((dofs >> 3) + h5) ^ (r & 15)) * 16;
    const int voff0 = r * 128 + (h5 ^ ((r >> 1) & 7)) * 16;
    asm volatile("s_waitcnt vmcnt(0)" ::: "memory");
    __syncthreads();
    for (int j = 0; j < ntile; ++j) {
        const int kt = tile_of(j);
        if (j + 1 < ntile) dma(tile_of(j + 1), (j + 1) & 1);
        const LAS unsigned char* kb = lds + (j & 1) * AT_BUF; const LAS unsigned char* vb = kb + AT_KBYTES;
        const bool band = IS_A && !u.isc && kt >= 4;
        const int kpos0 = (kt - 4) * 64;
        bf16x8 kf[NS]; u32x4 vf[8];
        auto kread = [&](int sub) {
#pragma unroll
            for (int s = 0; s < NS; ++s) kf[s] = *(const LAS bf16x8*)(kb + 8192 * sub + (koff0 ^ (32 * s))); };
        auto vread = [&](int sub) {
#pragma unroll
            for (int dvt = 0; dvt < 4; ++dvt)
#pragma unroll
                for (int s2 = 0; s2 < 2; ++s2) vf[2 * dvt + s2] = *(const LAS u32x4*)(vb + 4096 * dvt + (voff0 ^ (64 * sub + 32 * s2))); };
        kread(0);
        vread(0);
        __builtin_amdgcn_sched_barrier(0);
#pragma unroll
        for (int sub = 0; sub < 2; ++sub) {
            f32x16 sacc;
#pragma unroll
            for (int i = 0; i < 16; ++i) sacc[i] = -bound2;
#pragma unroll
            for (int s = 0; s < NS; ++s) sacc = __builtin_amdgcn_mfma_f32_32x32x16_bf16(kf[s], qf[s], sacc, 0, 0, 0);
            float p[16];
#pragma unroll
            for (int i = 0; i < 16; ++i) { float e = __builtin_amdgcn_exp2f(sacc[i]);
                if (band) { const int kpos = kpos0 + 32 * sub + (i & 3) + 8 * (i >> 2) + 4 * h5; const int dlt = kpos - t; e = (dlt <= 128 && dlt >= -128) ? e : 0.f; }
                p[i] = e; lsum += e; }
            bf16x8 pb[2];
#pragma unroll
            for (int s2 = 0; s2 < 2; ++s2) { u32x4 pk; pk.x = cvt_pk_bf16(p[8 * s2 + 0], p[8 * s2 + 1]); pk.y = cvt_pk_bf16(p[8 * s2 + 2], p[8 * s2 + 3]); pk.z = cvt_pk_bf16(p[8 * s2 + 4], p[8 * s2 + 5]); pk.w = cvt_pk_bf16(p[8 * s2 + 6], p[8 * s2 + 7]);
                pb[s2] = __builtin_bit_cast(bf16x8, pk); }
            __builtin_amdgcn_sched_barrier(0);
            if (sub == 0) { kread(1); __builtin_amdgcn_sched_barrier(0); }
#pragma unroll
            for (int dvt = 0; dvt < 4; ++dvt)
#pragma unroll
                for (int s2 = 0; s2 < 2; ++s2) oacc[dvt] = __builtin_amdgcn_mfma_f32_32x32x16_bf16(__builtin_bit_cast(bf16x8, vf[2 * dvt + s2]), pb[s2], oacc[dvt], 0, 0, 0);
            __builtin_amdgcn_sched_barrier(0);
            if (sub == 0) { vread(1); __builtin_amdgcn_sched_barrier(0); }
        }
        asm volatile("s_waitcnt vmcnt(0)" ::: "memory");
        __syncthreads();
    }
    float ltot = lsum + shx(lsum, 32, lane) + sinkp;
    const float linv = 1.0f / ltot;
    bf16_t* orow = F_O + (size_t)qrow * 4096;
    if (IS_A) {
#pragma unroll
        for (int dvt = 0; dvt < 4; ++dvt)
#pragma unroll
            for (int g = 0; g < 4; ++g) { u32x2 o; o.x = cvt_pk_bf16(oacc[dvt][4 * g] * linv, oacc[dvt][4 * g + 1] * linv); o.y = cvt_pk_bf16(oacc[dvt][4 * g + 2] * linv, oacc[dvt][4 * g + 3] * linv);
                *(u32x2*)(orow + head * 128 + 32 * dvt + 8 * g + 4 * h5) = o; }
    } else {
        LAS float* xch = (LAS float*)(lds + AT_XCH) + (w & 3) * 4096;
        if (w >= 4) {
#pragma unroll
            for (int dvt = 0; dvt < 4; ++dvt)
#pragma unroll
                for (int i = 0; i < 16; ++i) xch[(dvt * 16 + i) * 64 + lane] = oacc[dvt][i] * linv;
        }
        __syncthreads();
        if (w < 4) {
            const float* lb = F_lam_b + l * 256;
            const float d1 = wave_sum(lb[lane] * lb[64 + lane], lane), d2 = wave_sum(lb[128 + lane] * lb[192 + lane], lane);
            const float lam_init = 0.8f - 0.6f * expf(-0.3f * (float)l), lam = expf(d1) - expf(d2) + lam_init;
            float ss = 0.f;
#pragma unroll
            for (int dvt = 0; dvt < 4; ++dvt)
#pragma unroll
                for (int i = 0; i < 16; ++i) { const float d = oacc[dvt][i] * linv - lam * xch[(dvt * 16 + i) * 64 + lane]; oacc[dvt][i] = d; ss += d * d; }
            ss += shx(ss, 32, lane);
            const float rn = rsqrtf(ss * (1.0f / 128.0f) + 1e-6f) * (1.0f - lam_init);
            const float* sg = F_subln_b + l * 128;
#pragma unroll
            for (int dvt = 0; dvt < 4; ++dvt)
#pragma unroll
                for (int g = 0; g < 4; ++g) { const int dv = 32 * dvt + 8 * g + 4 * h5; const f32x4 gg = *(const f32x4*)(sg + dv);
                    u32x2 o; o.x = cvt_pk_bf16(oacc[dvt][4 * g] * rn * gg.x, oacc[dvt][4 * g + 1] * rn * gg.y); o.y = cvt_pk_bf16(oacc[dvt][4 * g + 2] * rn * gg.z, oacc[dvt][4 * g + 3] * rn * gg.w);
                    *(u32x2*)(orow + 1024 + head * 128 + dv) = o; }
        }
    }
}
__device__ __forceinline__ float gelu_tanh(float x) { const float z = 0.7978845608028654f * (x + 0.044715f * x * x * x); const float e = __expf(2.0f * z); return 0.5f * x * (2.0f - 2.0f / (1.0f + e)); }
#define F_HB ((bf16_t*)(F.ws + WS_HB))
__device__ __forceinline__ void lru_unit(const Frame& F, int l, int b, int blk, int d) {
    const int tid = F.tid, lane = F.lane, w = F.wave, ch = tid & 127, tq = tid >> 7, fr = lane & 15, fq = lane >> 4;
    LAS float* U = (LAS float*)F.lds;
    LAS bf16_t* Ub = (LAS bf16_t*)(F.lds + 32768);
    LAS f32x2* AV = (LAS f32x2*)(F.lds + 32768 + 17408);
    LAS f32x2* SEG = (LAS f32x2*)(F.lds + 32768 + 17408 + 65536);
    LAS float* HC = (LAS float*)(F.lds + 32768 + 17408 + 65536 + 4096);
    const bf16_t* P1 = F_P1;
    const int cg = blk * 128 + ch;
    const float cw0 = F_conv_w[(l * 4 + 0) * 1024 + cg], cw1 = F_conv_w[(l * 4 + 1) * 1024 + cg], cw2 = F_conv_w[(l * 4 + 2) * 1024 + cg], cw3 = F_conv_w[(l * 4 + 3) * 1024 + cg], cb = F_conv_b[l * 1024 + cg];
    const bool ctx_out = l < DEPTH - 1;
    bf16_t* hout = (d == 0) ? F_O + 2048 + cg : F_HB + cg; const size_t hstride = (d == 0) ? 4096 : 1024;
    bf16x8 wr[4], wi[4];
    { const float* wrp = F_w_rg + ((size_t)((l * 2 + d) * 8 + blk) * 128) * 128 + 16 * w + fr; const float* wip = F_w_ig + ((size_t)((l * 2 + d) * 8 + blk) * 128) * 128 + 16 * w + fr;
#pragma unroll
        for (int ks = 0; ks < 4; ++ks) { u32x4 a, c2; const int c0 = 32 * ks + 8 * fq;
            a.x = cvt_pk_bf16(wrp[(c0 + 0) * 128], wrp[(c0 + 1) * 128]); a.y = cvt_pk_bf16(wrp[(c0 + 2) * 128], wrp[(c0 + 3) * 128]); a.z = cvt_pk_bf16(wrp[(c0 + 4) * 128], wrp[(c0 + 5) * 128]); a.w = cvt_pk_bf16(wrp[(c0 + 6) * 128], wrp[(c0 + 7) * 128]);
            c2.x = cvt_pk_bf16(wip[(c0 + 0) * 128], wip[(c0 + 1) * 128]); c2.y = cvt_pk_bf16(wip[(c0 + 2) * 128], wip[(c0 + 3) * 128]); c2.z = cvt_pk_bf16(wip[(c0 + 4) * 128], wip[(c0 + 5) * 128]); c2.w = cvt_pk_bf16(wip[(c0 + 6) * 128], wip[(c0 + 7) * 128]);
            wr[ks] = __builtin_bit_cast(bf16x8, a); wi[ks] = __builtin_bit_cast(bf16x8, c2); } }
    const int cj = blk * 128 + 16 * w + fr;
    const float br = F_b_rg[(l * 2 + d) * 1024 + cj], bi = F_b_ig[(l * 2 + d) * 1024 + cj];
    const float sp8 = 8.0f * log1pf(expf(-F_lru_lambda[(l * 2 + d) * 1024 + cj]));
    if (tid < 128) HC[tid] = 0.f;
    auto geom = [&](int step, int& rowbase, int& t0, int& seglen) { const bool isc = step < 4; const int idx = isc ? step : step - 4, nch = isc ? 4 : 32, ci = (d == 0) ? idx : nch - 1 - idx; t0 = ci * 64; seglen = isc ? CTXL : SEQ; rowbase = isc ? b * CTXL : NCTX + b * SEQ; };
    unsigned short xr[19];
    auto ldraw = [&](int step) { int rowbase, t0, seglen; geom(step, rowbase, t0, seglen); const int ts = t0 + tq * 16;
#pragma unroll
        for (int i = 0; i < 19; ++i) { const int t = ts - 2 + i; xr[i] = (t >= 0 && t < seglen) ? P1[(size_t)(rowbase + t) * N1 + C_CX + cg] : (unsigned short)0; } };
    ldraw(0);
    for (int step = 0; step < 36; ++step) {
        int rowbase, t0, seglen; geom(step, rowbase, t0, seglen);
        const bool isc = step < 4;
#pragma unroll
        for (int tt = 0; tt < 16; ++tt) { const float u = cb + cw0 * bf2f(xr[tt]) + cw1 * bf2f(xr[tt + 1]) + cw2 * bf2f(xr[tt + 2]) + cw3 * bf2f(xr[tt + 3]);
            U[(tq * 16 + tt) * 128 + ch] = u; Ub[(tq * 16 + tt) * 136 + ch] = (bf16_t)(cvt_pk_bf16(u, 0.f) & 0xffffu); }
        __syncthreads();
        if (step + 1 < 36) ldraw(step + 1);
#pragma unroll
        for (int mt = 0; mt < 4; ++mt) { f32x4 ar = (f32x4){0.f, 0.f, 0.f, 0.f}, ai = ar;
#pragma unroll
            for (int ks = 0; ks < 4; ++ks) { const bf16x8 a = *(const LAS bf16x8*)(Ub + (16 * mt + fr) * 136 + 32 * ks + 8 * fq);
                ar = __builtin_amdgcn_mfma_f32_16x16x32_bf16(a, wr[ks], ar, 0, 0, 0); ai = __builtin_amdgcn_mfma_f32_16x16x32_bf16(a, wi[ks], ai, 0, 0, 0); }
#pragma unroll
            for (int rg = 0; rg < 4; ++rg) { const int tok = 16 * mt + 4 * fq + rg, cl = 16 * w + fr;
                const float r = sigmoidf_(ar[rg] + br), ig = sigmoidf_(ai[rg] + bi); const float a_ = __expf(-sp8 * r);
                const float v = __builtin_amdgcn_sqrtf(fmaxf(1.0f - a_ * a_, 0.f)) * ig * U[tok * 128 + cl]; AV[tok * 128 + cl] = (f32x2){a_, v}; } }
        __syncthreads();
        float hl[16], cp[16];
        { float h = 0.f, pr = 1.f;
#pragma unroll
            for (int i = 0; i < 16; ++i) { const int p = 16 * tq + i, tok = (d == 0) ? p : 63 - p; const f32x2 av = AV[tok * 128 + ch]; h = av.x * h + av.y; pr *= av.x; hl[i] = h; cp[i] = pr; }
            SEG[tq * 128 + ch] = (f32x2){pr, h}; }
        __syncthreads();
        { float carry = HC[ch];
#pragma unroll
            for (int sg = 0; sg < 3; ++sg) { const f32x2 ps = SEG[sg * 128 + ch]; carry = (sg < tq) ? ps.x * carry + ps.y : carry; }
            const bool wr_out = !isc || ctx_out;
#pragma unroll
            for (int i = 0; i < 16; ++i) { const float h = hl[i] + cp[i] * carry; hl[i] = h;
                if (wr_out) { const int p = 16 * tq + i, tok = (d == 0) ? p : 63 - p; hout[(size_t)(rowbase + t0 + tok) * hstride] = (bf16_t)(cvt_pk_bf16(h, 0.f) & 0xffffu); } }
            __syncthreads();
            if (tq == 3) HC[ch] = hl[15]; }
    }
    __syncthreads();
}
__device__ __forceinline__ void lru_finish(const Frame& F, int l) {
    const size_t gt = (size_t)F.vcu * NTHR + F.tid, NGT = (size_t)F.G * NTHR;
    const size_t row_lo = (l == DEPTH - 1) ? NCTX : 0;
    for (size_t i = row_lo * 128 + gt; i < (size_t)NTOK * 128; i += NGT) { const size_t row = i >> 7; const int c8 = (int)(i & 127) * 8;
        bf16_t* op = F_O + row * 4096 + 2048 + c8;
        const u32x4 hf = *(const u32x4*)op, hb = *(const u32x4*)(F_HB + row * 1024 + c8), yv = *(const u32x4*)(F_P1 + row * N1 + C_CY + c8);
        u32x4 o;
        o.x = cvt_pk_bf16((bf_lo(hf.x) + bf_lo(hb.x)) * gelu_tanh(bf_lo(yv.x)), (bf_hi(hf.x) + bf_hi(hb.x)) * gelu_tanh(bf_hi(yv.x)));
        o.y = cvt_pk_bf16((bf_lo(hf.y) + bf_lo(hb.y)) * gelu_tanh(bf_lo(yv.y)), (bf_hi(hf.y) + bf_hi(hb.y)) * gelu_tanh(bf_hi(yv.y)));
        o.z = cvt_pk_bf16((bf_lo(hf.z) + bf_lo(hb.z)) * gelu_tanh(bf_lo(yv.z)), (bf_hi(hf.z) + bf_hi(hb.z)) * gelu_tanh(bf_hi(yv.z)));
        o.w = cvt_pk_bf16((bf_lo(hf.w) + bf_lo(hb.w)) * gelu_tanh(bf_lo(yv.w)), (bf_hi(hf.w) + bf_hi(hb.w)) * gelu_tanh(bf_hi(yv.w)));
        *(u32x4*)op = o; }
}

#define F_DSCR ((bf16_t*)(F.ws + WS_DSCR))
__device__ __forceinline__ void gla_unit(const Frame& F, int l, int b, int h, int d) {
    const int tid = F.tid, lane = F.lane, w = F.wave, kk_ = tid & 127, sc_ = tid >> 7, fr = lane & 15, fq = lane >> 4;
    LAS bf16_t* Qt = (LAS bf16_t*)F.lds;
    LAS bf16_t* Kh = (LAS bf16_t*)(F.lds + 17408);
    LAS bf16_t* KtT = (LAS bf16_t*)(F.lds + 34816);
    LAS bf16_t* Vt = (LAS bf16_t*)(F.lds + 34816 + 18432);
    LAS float* Dc = (LAS float*)(F.lds + 34816 + 36864);
    const bf16_t* P1 = F_P1;
    float lbv = 0.f;
    if (l > 0) { const float x0 = F_lb_d[(0 * 2 + d) * 1024 + h * 128 + kk_], x1 = F_lb_d[(1 * 2 + d) * 1024 + h * 128 + kk_]; lbv = 1.0f / (1.0f + expf(x0 - x1)); }
    const int zcol = (d == 0 ? C_DFF : C_DFB) + h * 128 + kk_, qcol = C_DQ + h * 128 + kk_, vcol = C_DI + h * 128 + kk_;
    f32x4 S[8];
#pragma unroll
    for (int i = 0; i < 8; ++i) S[i] = (f32x4){0.f, 0.f, 0.f, 0.f};
    bf16_t* dscr = (d == 0) ? F_O + 3072 : F_DSCR; const size_t dstride = (d == 0) ? 4096 : 1024;
    const bool ctx_out = l < DEPTH - 1;
    unsigned short zr[16], qr[16], vr[16];
    auto geom = [&](int step, int& rowbase, int& t0) { const bool isc = step < 4; const int idx = isc ? step : step - 4, nch = isc ? 4 : 32, ci = (d == 0) ? idx : nch - 1 - idx; t0 = ci * 64; rowbase = isc ? b * CTXL : NCTX + b * SEQ; };
    auto ldraw = [&](int step) { int rowbase, t0; geom(step, rowbase, t0);
#pragma unroll
        for (int tt = 0; tt < 16; ++tt) { const int p = 16 * sc_ + tt; const size_t row = (size_t)(rowbase + t0 + (d == 0 ? p : 63 - p)); zr[tt] = P1[row * N1 + zcol]; qr[tt] = P1[row * N1 + qcol]; vr[tt] = P1[row * N1 + vcol]; } };
    ldraw(0);
    for (int step = 0; step < 36; ++step) {
        const bool isc = step < 4; int rowbase, t0; geom(step, rowbase, t0);
        { float kh[16]; float eb = 1.0f;
#pragma unroll
            for (int tt = 0; tt < 16; ++tt) { const int p = 16 * sc_ + tt;
                const float z = bf2f(zr[tt]), q = bf2f(qr[tt]);
                const float sg = sigmoidf_(z); const float f = lbv + (1.0f - lbv) * sg; eb = fmaxf(eb * f, 1e-35f);
                const float ebi = __builtin_amdgcn_rcpf(eb);
                kh[tt] = (1.0f - lbv) * (1.0f - sg) * ebi;
                Qt[p * 136 + kk_] = (bf16_t)(cvt_pk_bf16(q * eb, 0.f) & 0xffffu);
                Kh[p * 136 + kk_] = (bf16_t)(cvt_pk_bf16(kh[tt], 0.f) & 0xffffu); }
            const float ebl = eb;
            u32x4 k0, k1, v0, v1;
            k0.x = cvt_pk_bf16(kh[0] * ebl, kh[1] * ebl); k0.y = cvt_pk_bf16(kh[2] * ebl, kh[3] * ebl); k0.z = cvt_pk_bf16(kh[4] * ebl, kh[5] * ebl); k0.w = cvt_pk_bf16(kh[6] * ebl, kh[7] * ebl);
            k1.x = cvt_pk_bf16(kh[8] * ebl, kh[9] * ebl); k1.y = cvt_pk_bf16(kh[10] * ebl, kh[11] * ebl); k1.z = cvt_pk_bf16(kh[12] * ebl, kh[13] * ebl); k1.w = cvt_pk_bf16(kh[14] * ebl, kh[15] * ebl);
            v0.x = (unsigned)vr[0] | ((unsigned)vr[1] << 16); v0.y = (unsigned)vr[2] | ((unsigned)vr[3] << 16); v0.z = (unsigned)vr[4] | ((unsigned)vr[5] << 16); v0.w = (unsigned)vr[6] | ((unsigned)vr[7] << 16);
            v1.x = (unsigned)vr[8] | ((unsigned)vr[9] << 16); v1.y = (unsigned)vr[10] | ((unsigned)vr[11] << 16); v1.z = (unsigned)vr[12] | ((unsigned)vr[13] << 16); v1.w = (unsigned)vr[14] | ((unsigned)vr[15] << 16);
            *(LAS u32x4*)(KtT + kk_ * 72 + 16 * sc_) = k0; *(LAS u32x4*)(KtT + kk_ * 72 + 16 * sc_ + 8) = k1;
            *(LAS u32x4*)(Vt + kk_ * 72 + 16 * sc_) = v0; *(LAS u32x4*)(Vt + kk_ * 72 + 16 * sc_ + 8) = v1;
            Dc[sc_ * 128 + kk_] = ebl; }
        __syncthreads();
        if (step + 1 < 36) ldraw(step + 1);
        u32x2 attb2[4];
#pragma unroll
        for (int sc = 0; sc < 4; ++sc) { f32x4 att = (f32x4){0.f, 0.f, 0.f, 0.f};
#pragma unroll
            for (int ks = 0; ks < 4; ++ks) { const bf16x8 a = *(const LAS bf16x8*)(Kh + (16 * sc + fr) * 136 + 32 * ks + 8 * fq), bq = *(const LAS bf16x8*)(Qt + (16 * sc + fr) * 136 + 32 * ks + 8 * fq);
                att = __builtin_amdgcn_mfma_f32_16x16x32_bf16(a, bq, att, 0, 0, 0); }
#pragma unroll
            for (int rg = 0; rg < 4; ++rg) att[rg] = (4 * fq + rg <= fr) ? att[rg] : 0.f;
            attb2[sc] = (u32x2){cvt_pk_bf16(att[0], att[1]), cvt_pk_bf16(att[2], att[3])}; }
#pragma unroll
        for (int sc = 0; sc < 4; ++sc) {
            const u32x4 attb = (u32x4){attb2[sc].x, attb2[sc].y, 0u, 0u};
            f32x4 o = (f32x4){0.f, 0.f, 0.f, 0.f};
#pragma unroll
            for (int ks = 0; ks < 4; ++ks) { u32x4 sa; sa.x = cvt_pk_bf16(S[2 * ks][0], S[2 * ks][1]); sa.y = cvt_pk_bf16(S[2 * ks][2], S[2 * ks][3]); sa.z = cvt_pk_bf16(S[2 * ks + 1][0], S[2 * ks + 1][1]); sa.w = cvt_pk_bf16(S[2 * ks + 1][2], S[2 * ks + 1][3]);
                const u32x2 q0 = *(const LAS u32x2*)(Qt + (16 * sc + fr) * 136 + 32 * ks + 4 * fq), q1 = *(const LAS u32x2*)(Qt + (16 * sc + fr) * 136 + 32 * ks + 16 + 4 * fq);
                const u32x4 qb = (u32x4){q0.x, q0.y, q1.x, q1.y};
                o = __builtin_amdgcn_mfma_f32_16x16x32_bf16(__builtin_bit_cast(bf16x8, sa), __builtin_bit_cast(bf16x8, qb), o, 0, 0, 0); }
            { const u32x2 v0 = *(const LAS u32x2*)(Vt + (16 * w + fr) * 72 + 16 * sc + 4 * fq); const u32x4 va = (u32x4){v0.x, v0.y, 0u, 0u};
                o = __builtin_amdgcn_mfma_f32_16x16x32_bf16(__builtin_bit_cast(bf16x8, va), __builtin_bit_cast(bf16x8, attb), o, 0, 0, 0); }
            if (!isc || ctx_out) { const int p = 16 * sc + fr; const size_t row = (size_t)(rowbase + t0 + (d == 0 ? p : 63 - p));
                u32x2 ov; ov.x = cvt_pk_bf16(o[0], o[1]); ov.y = cvt_pk_bf16(o[2], o[3]); *(u32x2*)(dscr + row * dstride + h * 128 + 16 * w + 4 * fq) = ov; }
            u32x4 vb = (u32x4){0u, 0u, 0u, 0u};
            if (fq < 2) vb = *(const LAS u32x4*)(Vt + (16 * w + fr) * 72 + 16 * sc + 8 * fq);
#pragma unroll
            for (int kt = 0; kt < 8; ++kt) { const f32x4 dc = *(const LAS f32x4*)(Dc + sc * 128 + 16 * kt + 4 * fq); S[kt] *= dc;
                u32x4 ka = (u32x4){0u, 0u, 0u, 0u};
                if (fq < 2) ka = *(const LAS u32x4*)(KtT + (16 * kt + fr) * 72 + 16 * sc + 8 * fq);
                S[kt] = __builtin_amdgcn_mfma_f32_16x16x32_bf16(__builtin_bit_cast(bf16x8, ka), __builtin_bit_cast(bf16x8, vb), S[kt], 0, 0, 0); }
        }
        __syncthreads();
    }
}
__device__ __forceinline__ void gla_finish(const Frame& F, int l) {
    const int gw = F.vcu * NWAVES + F.wave, NGW = F.G * NWAVES, lane = F.lane;
    const int row_lo = (l == DEPTH - 1) ? NCTX : 0;
    const int c0 = 16 * lane, hc = c0 & 127;
    float gn[16];
#pragma unroll
    for (int q = 0; q < 4; ++q) { const f32x4 g4 = *(const f32x4*)(F_onorm_d + l * 128 + hc + 4 * q); gn[4 * q] = g4.x; gn[4 * q + 1] = g4.y; gn[4 * q + 2] = g4.z; gn[4 * q + 3] = g4.w; }
    for (int row = row_lo + gw; row < NTOK; row += NGW) {
        bf16_t* op = F_O + (size_t)row * 4096 + 3072 + c0;
        const u32x4 a0 = *(const u32x4*)op, a1 = *(const u32x4*)(op + 8);
        const u32x4 b0 = *(const u32x4*)(F_DSCR + (size_t)row * 1024 + c0), b1 = *(const u32x4*)(F_DSCR + (size_t)row * 1024 + c0 + 8);
        const u32x4 g0 = *(const u32x4*)(F_P1 + (size_t)row * N1 + C_DG + c0), g1 = *(const u32x4*)(F_P1 + (size_t)row * N1 + C_DG + c0 + 8);
        const unsigned aw[8] = {a0.x, a0.y, a0.z, a0.w, a1.x, a1.y, a1.z, a1.w}, bw[8] = {b0.x, b0.y, b0.z, b0.w, b1.x, b1.y, b1.z, b1.w}, gw_[8] = {g0.x, g0.y, g0.z, g0.w, g1.x, g1.y, g1.z, g1.w};
        float o[16]; float ss = 0.f;
#pragma unroll
        for (int q = 0; q < 8; ++q) { o[2 * q] = bf_lo(aw[q]) + bf_lo(bw[q]); o[2 * q + 1] = bf_hi(aw[q]) + bf_hi(bw[q]); ss += o[2 * q] * o[2 * q] + o[2 * q + 1] * o[2 * q + 1]; }
        ss += shx(ss, 1, lane); ss += shx(ss, 2, lane); ss += shx(ss, 4, lane);
        const float rn = rsqrtf(ss * (1.0f / 128.0f) + 1e-6f);
        unsigned ow[8];
#pragma unroll
        for (int q = 0; q < 8; ++q) { const float ga = bf_lo(gw_[q]), gb = bf_hi(gw_[q]);
            ow[q] = cvt_pk_bf16(o[2 * q] * rn * gn[2 * q] * ga * sigmoidf_(ga), o[2 * q + 1] * rn * gn[2 * q + 1] * gb * sigmoidf_(gb)); }
        *(u32x4*)op = (u32x4){ow[0], ow[1], ow[2], ow[3]}; *(u32x4*)(op + 8) = (u32x4){ow[4], ow[5], ow[6], ow[7]};
    }
}
__device__ __forceinline__ void mix_phase(const Frame& F0, int l) {
    const Frame& F = F0;
    const bool ctx_out = l < DEPTH - 1;
    const int nC = ENABLE_C ? 16 : 0, nD = ENABLE_D ? 16 : 0, nBl = 128, nBc = ctx_out ? 16 : 0, nAl = 64, nAc = ctx_out ? 8 : 0;
    const int total = nC + nD + nBl + nBc + nAl + nAc;
    volatile LAS int* slot = (volatile LAS int*)(F.lds + MISC_OFF + 64);
    unsigned* heads = F_ctl + CW_QX + 64 * (l * 8);
    int cur = (F.G % 8 == 0) ? F.vcu / (F.G / 8) : (F.vcu & 7);
    for (;;) {
        __syncthreads();
        if (F.tid == 0) {
            int q = (int)atomicAdd(heads + 64 * cur, 1u), xx = cur;
            if (q >= total) {
                unsigned hv[8];
#pragma unroll
                for (int k = 0; k < 8; ++k) hv[k] = __hip_atomic_load(heads + 64 * k, __ATOMIC_RELAXED, __HIP_MEMORY_SCOPE_AGENT);
                q = total;
#pragma unroll
                for (int k = 1; k < 8; ++k) { const int y = (cur + k) & 7; unsigned hy = 0u;
#pragma unroll
                    for (int m = 0; m < 8; ++m) hy = (m == y) ? hv[m] : hy;
                    if (q >= total && hy < (unsigned)total) { const int t = (int)atomicAdd(heads + 64 * y, 1u); if (t < total) { q = t; xx = y; } } }
            }
            slot[0] = q; slot[1] = xx; }
        __syncthreads();
        int q = slot[0]; q = __builtin_amdgcn_readfirstlane(q);
        int x = slot[1]; x = __builtin_amdgcn_readfirstlane(x);
        if (q >= total) break;
        cur = x;
        Frame U = F0;
        U.ws = opaque_ptr(F0.ws); U.out = opaque_ptr(F0.out); asm volatile("" : "+v"(U.tid)); U.lane = U.tid & 63;
        const Frame& F = U;
        AttnUnit u;
        if (q < nC) { const int g = x * 16 + q; lru_unit(F, l, g >> 4, (g >> 1) & 7, g & 1); continue; }
        q -= nC;
        if (q < nD) { const int g = x * 16 + q; gla_unit(F, l, g >> 4, (g >> 1) & 7, g & 1); continue; }
        q -= nD;
        if (q < nBl) { const int p = 8 * (q >> 4) + x; u.isA = false; u.isc = false; u.b = p >> 3; u.h = p & 7; u.qt = q & 15; attn_unit<false>(F, l, u); continue; }
        q -= nBl;
        if (q < nBc) { const int p = 8 * (q >> 1) + x; u.isA = false; u.isc = true; u.b = p >> 3; u.h = p & 7; u.qt = q & 1; attn_unit<false>(F, l, u); continue; }
        q -= nBc;
        if (q < nAl) { const int p = 8 * (q >> 5) + x; u.isA = true; u.isc = false; u.b = p >> 1; u.h = p & 1; u.qt = q & 31; attn_unit<true>(F, l, u); continue; }
        q -= nAl;
        { const int p = 8 * (q >> 2) + x; u.isA = true; u.isc = true; u.b = p >> 1; u.h = p & 1; u.qt = q & 3; attn_unit<true>(F, l, u); }
    }
}
__device__ __forceinline__ void zero_o_cols(const Frame& F, int c0, int c1) {
    const int w8 = (c1 - c0) / 8; const size_t gt = (size_t)F.vcu * NTHR + F.tid, NGT = (size_t)F.G * NTHR;
    unsigned z = 0u; asm volatile("" : "+v"(z));
    for (size_t i = gt; i < (size_t)NTOK * w8; i += NGT) { const size_t row = i / w8, c = i % w8; *(u32x4*)(F_O + row * 4096 + c0 + c * 8) = (u32x4){z, z, z, z}; }
}

constexpr int PH_P0 = 0, PH_PER_LAYER = 10, PH_FINAL = 1 + DEPTH * PH_PER_LAYER, N_PHASES = PH_FINAL + 1;
enum { L_NORM1 = 0, L_INPROJ, L_PREP, L_MIX, L_GATE, L_MERGE, L_OUT, L_NORM2, L_MOE1, L_MOE2 };
__global__ void __launch_bounds__(NTHR, 2) trunk_fwd(Args args) {
    extern __shared__ __attribute__((aligned(16))) unsigned char lds_raw[];
    Frame F;
    F.lds = (LAS unsigned char*)lds_raw;
    F.tid = threadIdx.x; F.lane = F.tid & 63; F.wave = __builtin_amdgcn_readfirstlane(F.tid >> 6);
    F.G = gridDim.x; { const int bx = blockIdx.x; F.vcu = (F.G % 8 == 0) ? (bx % 8) * (F.G / 8) + bx / 8 : bx; }
    F.a = &args; F.ws = args.ws; F.out = args.out;
    volatile LAS unsigned* MISC = (volatile LAS unsigned*)(F.lds + MISC_OFF);
    if (F.tid < 32) MISC[F.tid] = 0u;
    __syncthreads();
    const int lo = args.ph_lo, hi = args.ph_hi;
    XcdBarrier bar; bar.bar = F_ctl + CW_BAR; bar.x = 0; bar.st = nullptr;
    if (hi - lo > 1) bar = xcd_barrier_post(F_ctl + CW_BAR, MISC + 8);
#define IN(k) (lo <= (k) && (k) < hi)
#define SEAM(k) do { if (IN(k) && IN((k) + 1)) xcd_barrier(bar); } while (0)

    if (IN(PH_P0)) { { const Frame P = phase_frame(F); p0_mod(P); } { const Frame P = phase_frame(F); p0_weights(P); }
#if !ENABLE_MIX
        { const Frame P = phase_frame(F); p0_copy_x(P); }
#endif
    }
    SEAM(PH_P0);
    for (int l = 0; l < DEPTH; ++l) {
        const int base = 1 + l * PH_PER_LAYER;
        const int pm0 = (l == DEPTH - 1) ? 8 : 0;
        if (IN(base + L_NORM1)) { const Frame P = phase_frame(F); norm_phase<1>(P, l); }
        SEAM(base + L_NORM1);
#if ENABLE_MIX
        if (IN(base + L_INPROJ)) { const Frame Fo = F; const Frame F = phase_frame(Fo);
            PolDenseBf16 S; S.K = D; S.lda = D * 2; S.ldb = D * 2; S.A = (const char*)F_H; S.B = (const char*)(F_WIN + (size_t)l * INW * D); S.C = F_P1; S.ldc = N1; S.nM = 72; S.nN = 46; S.pm0 = 0; S.G = F.G; S.c = (int)blockIdx.x;
            g8::gemm_phase(F.lds, S, F.tid);
        }
        SEAM(base + L_INPROJ);
        if (IN(base + L_PREP)) { const Frame P = phase_frame(F); prep_phase(P, l); if (!ENABLE_C) zero_o_cols(P, 2048, 3072); if (!ENABLE_D) zero_o_cols(P, 3072, 4096); }
        SEAM(base + L_PREP);
        if (IN(base + L_MIX)) { const Frame P = phase_frame(F); mix_phase(P, l); }
        SEAM(base + L_MIX);
        if (IN(base + L_GATE)) { const Frame Fo = F; const Frame F = phase_frame(Fo);
            if (ENABLE_D) gla_finish(F, l);
            if (ENABLE_C) lru_finish(F, l);
            if (hi - lo > 1) xcd_barrier(bar);
            PolDenseBf16 S; S.K = D; S.lda = D * 2; S.ldb = D * 2; S.A = (const char*)F_H; S.B = (const char*)(F_WIN + ((size_t)l * INW + N1) * D); S.C = F_P1; S.ldc = NG; S.nM = 72 - pm0; S.nN = 32; S.pm0 = pm0; S.G = F.G; S.c = (int)blockIdx.x;
            g8::gemm_phase(F.lds, S, F.tid);
        }
        SEAM(base + L_GATE);
        if (IN(base + L_MERGE)) { const Frame Fo = F; const Frame F = phase_frame(Fo);
            PolMerge S; S.K = 1024; S.lda = 4096 * 2; S.ldb = 1024 * 2; S.A = (const char*)F_O; S.B = (const char*)(F_WBR + (size_t)l * 4 * D * 1024); S.Gt = F_P1; S.Yo = F_Y; S.nM = 64; S.pm0 = 8; S.G = F.G; S.c = (int)blockIdx.x;
            g8::gemm_phase(F.lds, S, F.tid);
        }
        SEAM(base + L_MERGE);
        if (IN(base + L_OUT)) {
            const bool split = (l < DEPTH - 1) && (F.G > 64);
            if (split && (int)blockIdx.x < 64) { const Frame Fo = F; const Frame F = phase_frame(Fo);
                PolMerge S; S.K = 1024; S.lda = 4096 * 2; S.ldb = 1024 * 2; S.A = (const char*)F_O; S.B = (const char*)(F_WBR + (size_t)l * 4 * D * 1024); S.Gt = F_P1; S.Yo = F_Y; S.nM = 8; S.pm0 = 0; S.G = 64; S.c = (int)blockIdx.x;
                g8::gemm_phase(F.lds, S, F.tid);
            } else { const Frame Fo = F; const Frame F = phase_frame(Fo);
                PolOut S; S.K = D; S.lda = D * 2; S.ldb = D * 2; S.A = (const char*)F_Y; S.B = (const char*)(F_WOUT + (size_t)l * D * D);
                S.xin_c = (l == 0) ? F_ctx : F_XC; S.xin_l = (l == 0) ? F_x : F.out; S.xout_c = F_XC; S.xout_l = F.out; S.mod_l = F_MOD + (size_t)l * 9 * 6 * D; S.nM = 64; S.pm0 = 8;
                S.G = split ? F.G - 64 : F.G; S.c = split ? (int)blockIdx.x - 64 : (int)blockIdx.x;
                g8::gemm_phase(F.lds, S, F.tid);
            }
            if (split) {
                if (hi - lo > 1) xcd_barrier(bar);
                const Frame Fo = F; const Frame F = phase_frame(Fo);
                PolOut S; S.K = D; S.lda = D * 2; S.ldb = D * 2; S.A = (const char*)F_Y; S.B = (const char*)(F_WOUT + (size_t)l * D * D);
                S.xin_c = (l == 0) ? F_ctx : F_XC; S.xin_l = (l == 0) ? F_x : F.out; S.xout_c = F_XC; S.xout_l = F.out; S.mod_l = F_MOD + (size_t)l * 9 * 6 * D; S.nM = 8; S.pm0 = 0; S.G = F.G; S.c = (int)blockIdx.x;
                g8::gemm_phase(F.lds, S, F.tid);
            }
        }
        SEAM(base + L_OUT);
#endif
        if (IN(base + L_NORM2)) { const Frame P = phase_frame(F); norm2_phase(P, l); }
        SEAM(base + L_NORM2);
        if (IN(base + L_MOE1)) { const Frame Fo = F; const Frame F = phase_frame(Fo);
            PolMoe<1> S; S.K = D; S.lda = D * 2; S.ldb = D * 2; S.A = (const char*)F_H; S.Bw = (const char*)(F_WGU + (size_t)l * NEXP * 1024 * D); S.C = (bf16_t*)(F.ws + WS_DSCR); S.list = F_LIST; S.nN = 4; S.G = F.G; S.c = (int)blockIdx.x; S.tab = (LAS int*)(F.lds + 131072); S.tid = F.tid;
            S.init(F_ctl + CW_CNT + 64 * l);
            g8::gemm_phase(F.lds, S, F.tid);
        }
        SEAM(base + L_MOE1);
        if (IN(base + L_MOE2)) { const Frame Fo = F; const Frame F = phase_frame(Fo);
            PolMoe<2> S; S.K = DFF; S.lda = DFF * 2; S.ldb = DFF * 2; S.A = (const char*)(F.ws + WS_DSCR); S.Bw = (const char*)(F_WD + (size_t)l * NEXP * D * DFF); S.C = F_O; S.list = F_LIST; S.nN = 8; S.G = F.G; S.c = (int)blockIdx.x; S.tab = (LAS int*)(F.lds + 131072); S.tid = F.tid;
            S.init(F_ctl + CW_CNT + 64 * l);
            g8::gemm_phase(F.lds, S, F.tid);
        }
        SEAM(base + L_MOE2);
        (void)pm0;
    }
    if (IN(PH_FINAL)) { const Frame P = phase_frame(F); norm_phase<3>(P, 0); }
#undef IN
#undef SEAM
}

extern "C" void kernel_launch(void* const* d_in, const int* in_sizes, int n_in, void* d_out, int out_size, void* d_ws, size_t ws_size, hipStream_t stream) {
    static int grid = 0;
    if (grid == 0) {
        if (n_in != 32 || out_size != NLAT * D || ws_size < WS_END) { fprintf(stderr, "kernel_launch: unexpected shapes (n_in %d, out %d, ws %zu)\n", n_in, out_size, ws_size); grid = -1; return; }
        int dev = 0, cus = 0, per_cu = 0;
        if (hipGetDevice(&dev) != hipSuccess || hipDeviceGetAttribute(&cus, hipDeviceAttributeMultiprocessorCount, dev) != hipSuccess) { grid = -1; return; }
        if (hipFuncSetAttribute((const void*)trunk_fwd, hipFuncAttributeMaxDynamicSharedMemorySize, LDS_BYTES) != hipSuccess) { fprintf(stderr, "kernel_launch: hipFuncSetAttribute failed\n"); grid = -1; return; }
        if (hipOccupancyMaxActiveBlocksPerMultiprocessor(&per_cu, (const void*)trunk_fwd, NTHR, LDS_BYTES) != hipSuccess || per_cu < 1) fprintf(stderr, "kernel_launch: occupancy query says %d\n", per_cu);
        (void)hipGetLastError();
        grid = cus;
    }
    if (grid < 0) return;
    if (hipMemsetAsync((char*)d_ws + WS_CTL, 0, CTL_ZERO_BYTES, stream) != hipSuccess) return;
    Args a{};
    for (int i = 0; i < 32; ++i) a.in[i] = (const float*)d_in[i];
    a.out = (float*)d_out; a.ws = (unsigned char*)d_ws;
#if N_LAUNCH_MODE == 1
    a.ph_lo = 0; a.ph_hi = N_PHASES;
    hipLaunchKernelGGL(trunk_fwd, dim3(grid), dim3(NTHR), LDS_BYTES, stream, a);
#else
    for (int p = 0; p < N_PHASES; ++p) {
        const int pl = (p - 1) % PH_PER_LAYER;
#if !ENABLE_MIX
        if (p >= 1 && p < PH_FINAL && pl >= L_INPROJ && pl <= L_OUT) continue;
#endif
        a.ph_lo = p; a.ph_hi = p + 1;
        hipLaunchKernelGGL(trunk_fwd, dim3(grid), dim3(NTHR), LDS_BYTES, stream, a);
    }
#endif
}
```

```cpp
#include <hip/hip_runtime.h>
#include <cstdio>
#include <cstdint>

#ifndef N_LAUNCH_MODE
#define N_LAUNCH_MODE 1
#endif
#ifndef ENABLE_C
#define ENABLE_C 1
#endif
#ifndef ENABLE_D
#define ENABLE_D 1
#endif
#ifndef ENABLE_MIX
#define ENABLE_MIX 1
#endif

#define LAS __attribute__((address_space(3)))
#define GAS __attribute__((address_space(1)))
typedef unsigned short bf16_t;
typedef short bf16x8 __attribute__((ext_vector_type(8)));
typedef short bf16x4 __attribute__((ext_vector_type(4)));
typedef float f32x2 __attribute__((ext_vector_type(2)));
typedef float f32x4 __attribute__((ext_vector_type(4)));
typedef float f32x16 __attribute__((ext_vector_type(16)));
typedef unsigned u32x2 __attribute__((ext_vector_type(2)));
typedef unsigned u32x4 __attribute__((ext_vector_type(4)));

constexpr int D = 2048, NB = 8, SEQ = 2048, CTXL = 256, DEPTH = 2;
constexpr int NCTX = NB * CTXL, NLAT = NB * SEQ, NTOK = NCTX + NLAT;
constexpr int N1 = 11776, NG = 8192, INW = N1 + NG;
constexpr int NEXP = 16, DFF = 512;
constexpr int NWAVES = 8, NTHR = 512;
constexpr int C_AQ = 0, C_AK = 1024, C_AV = 1280, C_BQ = 1536, C_BK = 2560, C_BV = 3584, C_CX = 4608, C_CY = 5632, C_DQ = 6656, C_DFF = 7680, C_DFB = 8704, C_DI = 9728, C_DG = 10752;

constexpr size_t MiB = 1u << 20;
constexpr size_t WS_CTL = 0, CTL_ZERO_BYTES = 2 * MiB;
constexpr size_t WS_MOD = 1 * MiB;
constexpr size_t WS_WIN = 2 * MiB;
constexpr size_t WS_WBR = 158 * MiB;
constexpr size_t WS_WOUT = 190 * MiB;
constexpr size_t WS_WGU = 206 * MiB;
constexpr size_t WS_WD = 334 * MiB;
constexpr size_t WS_H = 398 * MiB;
constexpr size_t WS_Y = 470 * MiB;
constexpr size_t WS_P1 = 542 * MiB;
constexpr size_t WS_O = 956 * MiB;
constexpr size_t WS_XC = 1100 * MiB;
constexpr size_t WS_HID = 1116 * MiB;
constexpr size_t WS_LIST = 1152 * MiB;
constexpr size_t WS_RW = 1154 * MiB;
constexpr size_t WS_DSCR = 1156 * MiB;
constexpr size_t WS_HB = 1192 * MiB;
constexpr size_t WS_END = 1228 * MiB;
constexpr int CW_BAR = 4096;
constexpr int CW_CNT = 8192;
constexpr int CW_QUEUE = 8448;

constexpr int LDS_BYTES = 147456;
constexpr int MISC_OFF = 131072 + 8192;

typedef __bf16 bf16x2_t __attribute__((ext_vector_type(2)));
__device__ __forceinline__ unsigned cvt_pk_bf16(float lo, float hi) { const bf16x2_t r = __builtin_convertvector((f32x2){lo, hi}, bf16x2_t); return __builtin_bit_cast(unsigned, r); }
__device__ __forceinline__ float bf_lo(unsigned u) { return __uint_as_float(u << 16); }
__device__ __forceinline__ float bf_hi(unsigned u) { return __uint_as_float(u & 0xffff0000u); }
__device__ __forceinline__ float bf2f(bf16_t b) { return __uint_as_float(((unsigned)b) << 16); }
__device__ __forceinline__ float shx(float v, int mask, int lane) { return __builtin_bit_cast(float, __builtin_amdgcn_ds_bpermute((lane ^ mask) << 2, __builtin_bit_cast(int, v))); }
__device__ __forceinline__ float wave_sum(float v, int lane) {
#pragma unroll
    for (int o = 1; o < 64; o <<= 1) v += shx(v, o, lane);
    return v;
}
__device__ __forceinline__ float wave_max(float v, int lane) {
#pragma unroll
    for (int o = 1; o < 64; o <<= 1) v = fmaxf(v, shx(v, o, lane));
    return v;
}
__device__ __forceinline__ float sigmoidf_(float x) { return __builtin_amdgcn_rcpf(1.0f + __expf(-x)); }
#define LDS_WAIT() asm volatile("s_waitcnt lgkmcnt(0)" ::: "memory")
#define VM_WAIT() asm volatile("s_waitcnt vmcnt(0)" ::: "memory")

__device__ __forceinline__ int opaque_int(int x);
template <class T> __device__ __forceinline__ T* opaque_ptr(T* p) { return (T*)((unsigned char*)p + opaque_int(0)); }
__device__ __forceinline__ int opaque_int(int x) { asm volatile("" : "+v"(x)); return __builtin_amdgcn_readfirstlane(x); }
#define XB_TMO      128
#define XB_XCNT(j)  (256  + 64 * (j))
#define XB_XSUB(j)  (1280 + 64 * (j))
#define XB_XGEN(j)  (2304 + 64 * (j))
#define XB_TOP      3328
#define XB_TOPGEN   3392
#define XCD_BAR_WORDS 3456
#define XB_SPIN_CAP (1u << 22)
__device__ __forceinline__ unsigned xb_ld(unsigned* p)              { return __hip_atomic_load(p, __ATOMIC_RELAXED, __HIP_MEMORY_SCOPE_AGENT); }
__device__ __forceinline__ unsigned xb_add(unsigned* p, unsigned v) { return __hip_atomic_fetch_add(p, v, __ATOMIC_RELAXED, __HIP_MEMORY_SCOPE_AGENT); }
__device__ __forceinline__ unsigned xb_xcc_id() { return (unsigned)__builtin_amdgcn_s_getreg((3 << 11) | 20) & 0xFu; }
#define XB_SPIN(cond, bar) do { unsigned _sp = 0; while (cond) { __builtin_amdgcn_s_sleep(1); \
    if ((++_sp & 255u) == 0u) { if (xb_ld(&(bar)[XB_TMO])) break; if (_sp > XB_SPIN_CAP) { atomicAdd(&(bar)[XB_TMO], 1u); break; } } } } while (0)
struct XcdBarrier { unsigned* bar; unsigned x; volatile LAS unsigned* st; };
__device__ __forceinline__ XcdBarrier xcd_barrier_post(unsigned* bar, volatile LAS unsigned* st) {
    XcdBarrier b; b.bar = bar; b.x = xb_xcc_id(); b.st = st;
    if (threadIdx.x == 0) (void)xb_add(&bar[XB_XCNT(b.x)], 1u);
    return b;
}
__device__ __forceinline__ void xcd_barrier_complete(unsigned* bar, unsigned x, unsigned& nloc, unsigned& nx) {
    const unsigned G = gridDim.x * gridDim.y * gridDim.z;
    unsigned sum, cnt, mine, sp = 0u;
    for (;;) {
        sum = 0u; cnt = 0u; mine = 0u;
#pragma unroll
        for (unsigned j = 0; j < 16; ++j) { const unsigned c = xb_ld(&bar[XB_XCNT(j)]); sum += c; cnt += (c > 0u) ? 1u : 0u; mine = (j == x) ? c : mine; }
        if (sum == G) break;
        __builtin_amdgcn_s_sleep(1);
        if ((++sp & 255u) == 0u) { if (xb_ld(&bar[XB_TMO])) break; if (sp > XB_SPIN_CAP) { atomicAdd(&bar[XB_TMO], 1u); break; } }
    }
    nloc = mine > 0u ? mine : 1u; nx = cnt > 0u ? cnt : 1u;
}
__device__ __forceinline__ void xcd_barrier(const XcdBarrier& b) {
    asm volatile("s_waitcnt vmcnt(0)" ::: "memory");
    __syncthreads();
    if (threadIdx.x == 0) {
        unsigned* bar = opaque_ptr(b.bar);
        __builtin_amdgcn_s_waitcnt(0);
        unsigned nloc = b.st[0], nx = b.st[1];
        if (nloc == 0u) { xcd_barrier_complete(bar, b.x, nloc, nx); b.st[0] = nloc; b.st[1] = nx; }
        const unsigned old = xb_add(&bar[XB_XSUB(b.x)], 1u);
        const unsigned gen = old / nloc;
        if (old + 1u == (gen + 1u) * nloc) {
            __builtin_amdgcn_fence(__ATOMIC_RELEASE, "agent");
            asm volatile("s_waitcnt vmcnt(0)" ::: "memory");
            const unsigned og = xb_add(&bar[XB_TOP], 1u);
            const unsigned tg = og / nx;
            if (og + 1u == (tg + 1u) * nx) xb_add(&bar[XB_TOPGEN], 1u);
            else XB_SPIN(xb_ld(&bar[XB_TOPGEN]) == tg, bar);
            __builtin_amdgcn_fence(__ATOMIC_ACQUIRE, "agent");
            xb_add(&bar[XB_XGEN(b.x)], 1u);
            asm volatile("s_waitcnt vmcnt(0)" ::: "memory");
        } else {
            XB_SPIN(xb_ld(&bar[XB_XGEN(b.x)]) == gen, bar);
            __builtin_amdgcn_fence(__ATOMIC_ACQUIRE, "agent");
            asm volatile("s_waitcnt vmcnt(0)" ::: "memory");
        }
    }
    __syncthreads();
}

struct Args { const float* in[32]; float* out; unsigned char* ws; int ph_lo, ph_hi; };
struct Frame {
    LAS unsigned char* lds;
    const Args* a;
    unsigned char* ws; float* out;
    int tid, lane, wave, G, vcu;
};
#define FIN(k) (F.a->in[k])
#define F_x FIN(0)
#define F_c FIN(1)
#define F_ctx FIN(2)
#define F_cctx FIN(3)
#define F_w_ada FIN(4)
#define F_b_ada FIN(5)
#define F_norm1_g FIN(6)
#define F_norm2_g FIN(7)
#define F_w_in FIN(8)
#define F_qn_a FIN(9)
#define F_kn_a FIN(10)
#define F_sink_a FIN(11)
#define F_qn_b FIN(12)
#define F_kn_b FIN(13)
#define F_lam_b FIN(14)
#define F_subln_b FIN(15)
#define F_conv_w FIN(16)
#define F_conv_b FIN(17)
#define F_w_rg FIN(18)
#define F_b_rg FIN(19)
#define F_w_ig FIN(20)
#define F_b_ig FIN(21)
#define F_lru_lambda FIN(22)
#define F_lb_d FIN(23)
#define F_onorm_d FIN(24)
#define F_w_branch FIN(25)
#define F_w_out FIN(26)
#define F_w_router FIN(27)
#define F_b_router FIN(28)
#define F_w_gate FIN(29)
#define F_w_up FIN(30)
#define F_w_down FIN(31)
#define F_ctl ((unsigned*)(F.ws + WS_CTL))
#define F_MOD ((float*)(F.ws + WS_MOD))
#define F_WIN ((bf16_t*)(F.ws + WS_WIN))
#define F_WBR ((bf16_t*)(F.ws + WS_WBR))
#define F_WOUT ((bf16_t*)(F.ws + WS_WOUT))
#define F_WGU ((bf16_t*)(F.ws + WS_WGU))
#define F_WD ((bf16_t*)(F.ws + WS_WD))
#define F_H ((bf16_t*)(F.ws + WS_H))
#define F_Y ((bf16_t*)(F.ws + WS_Y))
#define F_P1 ((bf16_t*)(F.ws + WS_P1))
#define F_O ((bf16_t*)(F.ws + WS_O))
#define F_HID ((bf16_t*)(F.ws + WS_HID))
#define F_XC ((float*)(F.ws + WS_XC))
#define F_LIST ((unsigned*)(F.ws + WS_LIST))
#define F_RW ((float*)(F.ws + WS_RW))
__device__ __forceinline__ Frame phase_frame(const Frame& F) {
    Frame P = F;
    P.ws = opaque_ptr(F.ws); P.out = opaque_ptr(F.out);
    P.wave = opaque_int(F.wave); P.G = opaque_int(F.G); P.vcu = opaque_int(F.vcu);
    unsigned ln; asm volatile("v_mbcnt_lo_u32_b32 %0, -1, 0\n\tv_mbcnt_hi_u32_b32 %0, -1, %0" : "=v"(ln));
    P.lane = (int)ln; P.tid = P.wave * 64 + (int)ln;
    return P;
}
__device__ __forceinline__ int mod_index(int row) { return row < NCTX ? 8 : ((row - NCTX) >> 11); }
__device__ __forceinline__ float* xrow_ptr(const Frame& F, int row) { return row < NCTX ? F_XC + (size_t)row * D : F.out + (size_t)(row - NCTX) * D; }
__device__ __forceinline__ const float* xin_ptr(const Frame& F, int row) { return row < NCTX ? F_ctx + (size_t)row * D : F_x + (size_t)(row - NCTX) * D; }

__device__ __forceinline__ void p0_mod(const Frame& F) {
    LAS float* sl = (LAS float*)F.lds;
    LAS float* part = (LAS float*)(F.lds + 9 * D * 4);
    for (int idx = F.tid; idx < 9 * D; idx += NTHR) { const int i = idx >> 11, k = idx & (D - 1); const float v = (i < 8) ? F_c[i * D + k] : F_cctx[k]; sl[idx] = v / (1.0f + __expf(-v)); }
    __syncthreads();
    for (int it = F.vcu; it < DEPTH * 96; it += F.G) {
        const int l = it / 96, jb = it % 96;
        const float* w = F_w_ada + ((size_t)l * D + F.wave * 256) * (6 * D) + jb * 128 + F.lane * 2;
        f32x2 acc[9];
#pragma unroll
        for (int i = 0; i < 9; ++i) acc[i] = (f32x2){0.f, 0.f};
#pragma unroll 8
        for (int k = 0; k < 256; ++k) {
            const f32x2 wv = *(const f32x2*)(w + (size_t)k * (6 * D));
#pragma unroll
            for (int i = 0; i < 9; ++i) acc[i] += sl[i * D + F.wave * 256 + k] * wv;
        }
#pragma unroll
        for (int i = 0; i < 9; ++i) *(LAS f32x2*)(part + (F.wave * 9 + i) * 128 + F.lane * 2) = acc[i];
        __syncthreads();
        for (int idx = F.tid; idx < 9 * 128; idx += NTHR) { const int i = idx >> 7, cidx = idx & 127; float sum = F_b_ada[(size_t)l * 6 * D + jb * 128 + cidx];
#pragma unroll
            for (int wv = 0; wv < 8; ++wv) sum += part[(wv * 9 + i) * 128 + cidx];
            F_MOD[((size_t)(l * 9 + i)) * (6 * D) + jb * 128 + cidx] = sum; }
        __syncthreads();
    }
    __syncthreads();
}
__device__ __forceinline__ void tr_item(const float* W, int ldw, int k0, int n0, bf16_t* dst, int ldd, LAS float* scr, int lane) {
    float tv[32];
#pragma unroll
    for (int i = 0; i < 32; ++i) { const int kk = 2 * i + (lane >> 5); tv[i] = W[(size_t)(k0 + kk) * ldw + n0 + (lane & 31)]; }
#pragma unroll
    for (int i = 0; i < 32; ++i) { const int kk = 2 * i + (lane >> 5); scr[kk * 33 + (lane & 31)] = tv[i]; }
    LDS_WAIT(); asm volatile("" ::: "memory");
    const int c = lane & 7;
#pragma unroll
    for (int j = 0; j < 4; ++j) { const int n = (lane >> 3) + 8 * j; const LAS float* s = scr + (8 * c) * 33 + n;
        u32x4 o; o.x = cvt_pk_bf16(s[0 * 33], s[1 * 33]); o.y = cvt_pk_bf16(s[2 * 33], s[3 * 33]); o.z = cvt_pk_bf16(s[4 * 33], s[5 * 33]); o.w = cvt_pk_bf16(s[6 * 33], s[7 * 33]);
        *(u32x4*)(dst + (size_t)n * ldd + k0 + 8 * c) = o; }
    LDS_WAIT(); asm volatile("" ::: "memory");
}
__device__ __forceinline__ void p0_weights(const Frame& F) {
    LAS float* scr = (LAS float*)(F.lds + F.wave * 8704);
    const int gw = F.vcu * NWAVES + F.wave, NGW = F.G * NWAVES;
    constexpr int I_IN = 32 * 624, I_BR = 16 * 64, I_OUT = 32 * 64, I_G = 32 * 16, I_D = 8 * 64;
    constexpr int S0 = DEPTH * I_IN, S1 = S0 + DEPTH * 4 * I_BR, S2 = S1 + DEPTH * I_OUT, S3 = S2 + DEPTH * NEXP * I_G, S4 = S3 + DEPTH * NEXP * I_G, S5 = S4 + DEPTH * NEXP * I_D;
    for (int it = gw; it < S5; it += NGW) {
        if (it < S0) { const int l = it / I_IN, r = it % I_IN, kb = r / 624, nb = r % 624;
            tr_item(F_w_in + (size_t)l * D * INW, INW, kb * 64, nb * 32, F_WIN + ((size_t)l * INW + nb * 32) * D, D, scr, F.lane); }
        else if (it < S1) { const int q = it - S0, m = q / I_BR, r = q % I_BR, kb = r / 64, nb = r % 64;
            tr_item(F_w_branch + (size_t)m * 1024 * D, D, kb * 64, nb * 32, F_WBR + ((size_t)m * D + nb * 32) * 1024, 1024, scr, F.lane); }
        else if (it < S2) { const int q = it - S1, l = q / I_OUT, r = q % I_OUT, kb = r / 64, nb = r % 64;
            tr_item(F_w_out + (size_t)l * D * D, D, kb * 64, nb * 32, F_WOUT + ((size_t)l * D + nb * 32) * D, D, scr, F.lane); }
        else if (it < S4) { const bool up = it >= S3; const int q = it - (up ? S3 : S2), m = q / I_G, r = q % I_G, kb = r / 16, nb = r % 16;
            const int n0 = nb * 32, drow = 256 * (n0 >> 7) + (n0 & 127) + (up ? 128 : 0);
            tr_item((up ? F_w_up : F_w_gate) + (size_t)m * D * DFF, DFF, kb * 64, n0, F_WGU + ((size_t)m * 1024 + drow) * D, D, scr, F.lane); }
        else { const int q = it - S4, m = q / I_D, r = q % I_D, kb = r / 64, nb = r % 64;
            tr_item(F_w_down + (size_t)m * DFF * D, D, kb * 64, nb * 32, F_WD + ((size_t)m * D + nb * 32) * DFF, DFF, scr, F.lane); }
    }
    __syncthreads();
}
__device__ __forceinline__ void p0_copy_x(const Frame& F) {
    const size_t gt = (size_t)F.vcu * NTHR + F.tid, NGT = (size_t)F.G * NTHR;
    for (size_t i = gt; i < (size_t)NTOK * D / 4; i += NGT) { const int row = (int)(i / (D / 4)); const int c4 = (int)(i % (D / 4));
        *((f32x4*)xrow_ptr(F, row) + c4) = *((const f32x4*)xin_ptr(F, row) + c4); }
}

template <int WHICH>
__device__ __forceinline__ void norm_phase(const Frame& F, int l) {
    const int gw = F.vcu * NWAVES + F.wave, NGW = F.G * NWAVES, lane = F.lane;
    LAS float* wrT = (LAS float*)F.lds;
    if (WHICH == 2) {
        for (int idx = F.tid; idx < D * NEXP; idx += NTHR) { const int e = idx >> 11, col = idx & (D - 1); wrT[idx] = F_w_router[col * NEXP + e]; }
        if (F.tid < 16) ((LAS unsigned*)(F.lds + 131072))[F.tid] = 0u;
        __syncthreads();
    }
    LAS unsigned* lcnt = (LAS unsigned*)(F.lds + 131072); LAS unsigned* lbase = lcnt + 16; LAS int* lrec = (LAS int*)(F.lds + 131072 + 256);
    int nrec = 0;
    const int row_lo = (WHICH == 3 || (WHICH == 2 && l == DEPTH - 1)) ? NCTX : 0;
    const bf16_t* Y2 = F_O;
    for (int row = row_lo + gw; row < NTOK; row += NGW) {
        const int mi = mod_index(row);
        f32x4 v[8];
        float* xr = xrow_ptr(F, row);
        if (WHICH == 1 && l == 0) { const float* xi = xin_ptr(F, row);
#pragma unroll
            for (int j = 0; j < 8; ++j) v[j] = *(const f32x4*)(xi + 4 * lane + 256 * j);
        } else {
#pragma unroll
            for (int j = 0; j < 8; ++j) v[j] = *(const f32x4*)(xr + 4 * lane + 256 * j);
        }
        if ((WHICH == 1 && l > 0) || WHICH == 3) {
            const int lp = (WHICH == 3) ? DEPTH - 1 : l - 1;
            const float* g2 = F_MOD + ((size_t)(lp * 9 + mi)) * (6 * D) + 5 * D;
            const f32x2 rw = *(const f32x2*)(F_RW + 2 * (size_t)row);
            const bf16_t* ya = Y2 + (size_t)(2 * row) * D; const bf16_t* yb = ya + D;
#pragma unroll
            for (int j = 0; j < 8; ++j) { const int col = 4 * lane + 256 * j; const f32x4 g = *(const f32x4*)(g2 + col);
                const u32x2 a = *(const u32x2*)(ya + col), b = *(const u32x2*)(yb + col);
                v[j].x += g.x * (rw.x * bf_lo(a.x) + rw.y * bf_lo(b.x)); v[j].y += g.y * (rw.x * bf_hi(a.x) + rw.y * bf_hi(b.x));
                v[j].z += g.z * (rw.x * bf_lo(a.y) + rw.y * bf_lo(b.y)); v[j].w += g.w * (rw.x * bf_hi(a.y) + rw.y * bf_hi(b.y));
                *(f32x4*)(xr + col) = v[j]; }
        }
        if (WHICH == 3) continue;
        float ss = 0.f;
#pragma unroll
        for (int j = 0; j < 8; ++j) ss += (v[j].x * v[j].x + v[j].y * v[j].y) + (v[j].z * v[j].z + v[j].w * v[j].w);
        const float rinv = rsqrtf(wave_sum(ss, lane) * (1.0f / D) + 1e-6f);
        const float* gn = (WHICH == 1 ? F_norm1_g : F_norm2_g) + (size_t)l * D;
        const float* md = F_MOD + ((size_t)(l * 9 + mi)) * (6 * D) + (WHICH == 1 ? 0 : 3) * D;
        bf16_t* hr = F_H + (size_t)row * D;
#pragma unroll
        for (int j = 0; j < 8; ++j) { const int col = 4 * lane + 256 * j; const f32x4 g = *(const f32x4*)(gn + col), sh = *(const f32x4*)(md + col), sc = *(const f32x4*)(md + D + col);
            v[j].x = v[j].x * rinv * g.x * (1.0f + sc.x) + sh.x; v[j].y = v[j].y * rinv * g.y * (1.0f + sc.y) + sh.y;
            v[j].z = v[j].z * rinv * g.z * (1.0f + sc.z) + sh.z; v[j].w = v[j].w * rinv * g.w * (1.0f + sc.w) + sh.w;
            u32x2 o; o.x = cvt_pk_bf16(v[j].x, v[j].y); o.y = cvt_pk_bf16(v[j].z, v[j].w); *(u32x2*)(hr + col) = o; }
        if (WHICH == 2) {
            float lg[NEXP];
#pragma unroll
            for (int e = 0; e < NEXP; ++e) { float a = 0.f;
#pragma unroll
                for (int j = 0; j < 8; ++j) { const f32x4 w = *(const LAS f32x4*)(wrT + e * D + 4 * lane + 256 * j); a += (v[j].x * w.x + v[j].y * w.y) + (v[j].z * w.z + v[j].w * w.w); }
                lg[e] = wave_sum(a, lane); }
            float aff[NEXP], sel[NEXP];
#pragma unroll
            for (int e = 0; e < NEXP; ++e) { aff[e] = 1.0f / (1.0f + expf(-lg[e])); sel[e] = aff[e] + F_b_router[e]; }
            int grp = 0; float best = -1e30f;
#pragma unroll
            for (int g = 0; g < 4; ++g) { float m1 = -1e30f, m2 = -1e30f;
#pragma unroll
                for (int q = 0; q < 4; ++q) { const float s = sel[4 * g + q]; if (s > m1) { m2 = m1; m1 = s; } else if (s > m2) m2 = s; }
                const float gs = m1 + m2; if (gs > best) { best = gs; grp = g; } }
            int i0 = 0, i1 = 0; float s0 = -1e30f, s1 = -1e30f, a0 = 0.f, a1 = 0.f;
#pragma unroll
            for (int g = 0; g < 4; ++g)
#pragma unroll
                for (int q = 0; q < 4; ++q) { const float s = sel[4 * g + q], a = aff[4 * g + q]; const bool in = (g == grp);
                    if (in && s > s0) { s1 = s0; i1 = i0; a1 = a0; s0 = s; i0 = 4 * g + q; a0 = a; } else if (in && s > s1) { s1 = s; i1 = 4 * g + q; a1 = a; } }
            if (lane == 0) {
                const float inv = 1.0f / (a0 + a1);
                *(f32x2*)(F_RW + 2 * (size_t)row) = (f32x2){a0 * inv, a1 * inv};
                LAS int* rec = lrec + (F.wave * 16 + nrec) * 4;
                rec[0] = i0; rec[1] = i1; rec[2] = (int)__hip_atomic_fetch_add(lcnt + i0, 1u, __ATOMIC_RELAXED, __HIP_MEMORY_SCOPE_WORKGROUP); rec[3] = (int)__hip_atomic_fetch_add(lcnt + i1, 1u, __ATOMIC_RELAXED, __HIP_MEMORY_SCOPE_WORKGROUP);
            }
            ++nrec;
        }
    }
    if (WHICH == 2) {
        __syncthreads();
        if (F.tid < 16) lbase[F.tid] = atomicAdd(F_ctl + CW_CNT + 64 * l + F.tid, lcnt[F.tid]);
        __syncthreads();
        if (lane < nrec) { const int row = row_lo + gw + lane * NGW; const LAS int* rec = lrec + (F.wave * 16 + lane) * 4; const int i0 = rec[0], i1 = rec[1];
            F_LIST[(size_t)i0 * NTOK + lbase[i0] + rec[2]] = 2u * row; F_LIST[(size_t)i1 * NTOK + lbase[i1] + rec[3]] = 2u * row + 1u; }
        __syncthreads();
    }
}

__device__ __forceinline__ constexpr int bitrev5(int v) { return ((v & 1) << 4) | ((v & 2) << 2) | (v & 4) | ((v & 8) >> 2) | ((v & 16) >> 4); }
__device__ __forceinline__ void norm2_phase(const Frame& F, int l) {
    const int gw = F.vcu * NWAVES + F.wave, NGW = F.G * NWAVES, lane = F.lane;
    LAS float* wrT = (LAS float*)F.lds;
    for (int idx = F.tid; idx < D * NEXP; idx += NTHR) { const int e = idx >> 11, col = idx & (D - 1); wrT[idx] = F_w_router[col * NEXP + e]; }
    LAS unsigned* lcnt = (LAS unsigned*)(F.lds + 131072); LAS unsigned* lbase = lcnt + 16; LAS int* lrec = (LAS int*)(F.lds + 131072 + 256);
    if (F.tid < 16) lcnt[F.tid] = 0u;
    int nrec = 0;
    __syncthreads();
    const int row_lo = (l == DEPTH - 1) ? NCTX : 0;
    float brt[NEXP];
#pragma unroll
    for (int e = 0; e < NEXP; ++e) brt[e] = F_b_router[e];
    for (int row0 = row_lo + 2 * gw; row0 < NTOK; row0 += 2 * NGW) {
        const int mi = mod_index(row0);
        f32x4 v[2][8];
#pragma unroll
        for (int r = 0; r < 2; ++r) { const float* xr = xrow_ptr(F, row0 + r);
#pragma unroll
            for (int j = 0; j < 8; ++j) v[r][j] = *(const f32x4*)(xr + 4 * lane + 256 * j); }
        float ss0 = 0.f, ss1 = 0.f;
#pragma unroll
        for (int j = 0; j < 8; ++j) { ss0 += (v[0][j].x * v[0][j].x + v[0][j].y * v[0][j].y) + (v[0][j].z * v[0][j].z + v[0][j].w * v[0][j].w); ss1 += (v[1][j].x * v[1][j].x + v[1][j].y * v[1][j].y) + (v[1][j].z * v[1][j].z + v[1][j].w * v[1][j].w); }
        const float rinv[2] = {rsqrtf(wave_sum(ss0, lane) * (1.0f / D) + 1e-6f), rsqrtf(wave_sum(ss1, lane) * (1.0f / D) + 1e-6f)};
        const float* gn = F_norm2_g + (size_t)l * D;
        const float* md = F_MOD + ((size_t)(l * 9 + mi)) * (6 * D) + 3 * D;
#pragma unroll
        for (int j = 0; j < 8; ++j) { const int col = 4 * lane + 256 * j; const f32x4 g = *(const f32x4*)(gn + col), sh = *(const f32x4*)(md + col), sc = *(const f32x4*)(md + D + col);
#pragma unroll
            for (int r = 0; r < 2; ++r) { f32x4& q = v[r][j];
                q.x = q.x * rinv[r] * g.x * (1.0f + sc.x) + sh.x; q.y = q.y * rinv[r] * g.y * (1.0f + sc.y) + sh.y; q.z = q.z * rinv[r] * g.z * (1.0f + sc.z) + sh.z; q.w = q.w * rinv[r] * g.w * (1.0f + sc.w) + sh.w;
                u32x2 o; o.x = cvt_pk_bf16(q.x, q.y); o.y = cvt_pk_bf16(q.z, q.w); *(u32x2*)(F_H + (size_t)(row0 + r) * D + col) = o; } }
        float x[32];
#pragma unroll
        for (int e = 0; e < NEXP; ++e) { float a0 = 0.f, a1 = 0.f;
#pragma unroll
            for (int j = 0; j < 8; ++j) { const f32x4 w = *(const LAS f32x4*)(wrT + e * D + 4 * lane + 256 * j);
                a0 += (v[0][j].x * w.x + v[0][j].y * w.y) + (v[0][j].z * w.z + v[0][j].w * w.w); a1 += (v[1][j].x * w.x + v[1][j].y * w.y) + (v[1][j].z * w.z + v[1][j].w * w.w); }
            x[e] = a0; x[16 + e] = a1; }
#pragma unroll
        for (int k = 0; k < 5; ++k) { const int half = 16 >> k; const bool bit = (lane >> k) & 1;
#pragma unroll
            for (int i = 0; i < half; ++i) { const float send = bit ? x[i] : x[i + half], keep = bit ? x[i + half] : x[i]; x[i] = keep + shx(send, 1 << k, lane); } }
        const float tot = x[0] + shx(x[0], 32, lane);
        const float affv = 1.0f / (1.0f + expf(-tot));
#pragma unroll
        for (int r = 0; r < 2; ++r) {
            float aff[NEXP], sel[NEXP];
#pragma unroll
            for (int e = 0; e < NEXP; ++e) { aff[e] = __builtin_bit_cast(float, __builtin_amdgcn_readlane(__builtin_bit_cast(int, affv), bitrev5(r * 16 + e))); sel[e] = aff[e] + brt[e]; }
            int grp = 0; float best = -1e30f;
#pragma unroll
            for (int g = 0; g < 4; ++g) { float m1 = -1e30f, m2 = -1e30f;
#pragma unroll
                for (int q = 0; q < 4; ++q) { const float s = sel[4 * g + q]; if (s > m1) { m2 = m1; m1 = s; } else if (s > m2) m2 = s; }
                const float gs = m1 + m2; if (gs > best) { best = gs; grp = g; } }
            int i0 = 0, i1 = 0; float s0 = -1e30f, s1 = -1e30f, a0 = 0.f, a1 = 0.f;
#pragma unroll
            for (int g = 0; g < 4; ++g)
#pragma unroll
                for (int q = 0; q < 4; ++q) { const float s = sel[4 * g + q], a = aff[4 * g + q]; const bool in = (g == grp);
                    if (in && s > s0) { s1 = s0; i1 = i0; a1 = a0; s0 = s; i0 = 4 * g + q; a0 = a; } else if (in && s > s1) { s1 = s; i1 = 4 * g + q; a1 = a; } }
            if (lane == 0) { const int row = row0 + r;
                const float inv = 1.0f / (a0 + a1);
                *(f32x2*)(F_RW + 2 * (size_t)row) = (f32x2){a0 * inv, a1 * inv};
                LAS int* rec = lrec + (F.wave * 16 + nrec) * 4;
                rec[0] = i0; rec[1] = i1; rec[2] = (int)__hip_atomic_fetch_add(lcnt + i0, 1u, __ATOMIC_RELAXED, __HIP_MEMORY_SCOPE_WORKGROUP); rec[3] = (int)__hip_atomic_fetch_add(lcnt + i1, 1u, __ATOMIC_RELAXED, __HIP_MEMORY_SCOPE_WORKGROUP); }
            ++nrec;
        }
    }
    __syncthreads();
    if (F.tid < 16) lbase[F.tid] = atomicAdd(F_ctl + CW_CNT + 64 * l + F.tid, lcnt[F.tid]);
    __syncthreads();
    if (lane < nrec) { const int row = row_lo + 2 * gw + (lane >> 1) * 2 * NGW + (lane & 1); const LAS int* rec = lrec + (F.wave * 16 + lane) * 4; const int i0 = rec[0], i1 = rec[1];
        F_LIST[(size_t)i0 * NTOK + lbase[i0] + rec[2]] = 2u * row; F_LIST[(size_t)i1 * NTOK + lbase[i1] + rec[3]] = 2u * row + 1u; }
    __syncthreads();
}

namespace g8 {
constexpr int BM = 256, BK = 64, HALF = 128, HTB = HALF * BK * 2, STAGE_BYTES = 8 * HTB;
__device__ __forceinline__ int lds_byte(int r, int c) { const int st = (r >> 4) * 2 + (c >> 5), rr = r & 15, cc = c & 31, ob = rr * 64 + cc * 2; return st * 1024 + (ob ^ (((ob >> 9) & 1) << 5)); }
__device__ __forceinline__ void stage_rc(int b, int& R, int& C) { const int st = b / 1024, sb = b % 1024, swz = sb ^ (((sb >> 9) & 1) << 5); R = (st >> 1) * 16 + swz / 64; C = (st & 1) * 32 + (swz % 64) / 2; }
__device__ __forceinline__ int perm32(int rho) { const int n = rho >> 4, i = rho & 15; return 8 * (i >> 2) + 4 * n + (i & 3); }
__device__ __forceinline__ void tile_order(int L, int nM, int nN, int& pm, int& pn) {
    const int nwg = nM * nN; int wgid = L;
    { const int q = nwg / 8, r = nwg % 8, xcd = wgid % 8, off = wgid / 8; wgid = (xcd < r ? xcd * (q + 1) : r * (q + 1) + (xcd - r) * q) + off; }
    const int nig = 8 * nN, gid = wgid / nig, fm = gid * 8, gsz = (nM - fm) < 8 ? (nM - fm) : 8;
    pm = fm + ((wgid % nig) % gsz); pn = (wgid % nig) / gsz;
}
struct GU { int pm, pn, aux, valid; const char* A; const char* B; };

template <class P>
__device__ __forceinline__ void gemm_phase(LAS unsigned char* lds, const P& S, const int tid) {
    const int wid = __builtin_amdgcn_readfirstlane(tid >> 6), lane = tid & 63, wr = wid >> 2, wc = wid & 3, fr = lane & 15, fq = lane >> 4;
    const int K = S.K, nt = K / BK;
    const unsigned lda = S.lda, ldb = S.ldb;
    int Rr[2], Cc[2]; unsigned voffB[2];
#pragma unroll
    for (int i = 0; i < 2; ++i) { stage_rc(tid * 16 + i * 8192, Rr[i], Cc[i]); const int Rb = P::PERM ? ((Rr[i] & ~31) + perm32(Rr[i] & 31)) : Rr[i]; voffB[i] = (unsigned)Rb * ldb + (unsigned)Cc[i] * 2u; }
    unsigned offA[2][2], offAn[2][2];
#pragma unroll
    for (int h = 0; h < 2; ++h)
#pragma unroll
        for (int i = 0; i < 2; ++i) { offA[h][i] = (unsigned)(h * HALF + Rr[i]) * lda + (unsigned)Cc[i] * 2u; offAn[h][i] = offA[h][i]; }
    const size_t kstep = (size_t)(BK * 2);
    const size_t hstepB = (size_t)HALF * ldb;
    const unsigned ldsw = (unsigned)wid * 1024u;
    const int aoff = lds_byte(wr * 64 + fr, fq * 8), boff = lds_byte(wc * 32 + fr, fq * 8);
#define G8_SA(b, h) (((b) * 2 + (h)) * HTB)
#define G8_SB(b, h) ((4 + (b) * 2 + (h)) * HTB)
#define G8_STAGE_A(bufoff, gbase, offs, h) do { _Pragma("unroll") for (int _i = 0; _i < 2; ++_i) \
        __builtin_amdgcn_global_load_lds((const unsigned*)((const char*)(gbase) + (offs)[h][_i]), (LAS unsigned*)(lds + (bufoff) + ldsw + _i * 8192), 16, 0, 0); } while (0)
#define G8_STAGE_B(bufoff, gbase) do { _Pragma("unroll") for (int _i = 0; _i < 2; ++_i) \
        __builtin_amdgcn_global_load_lds((const unsigned*)((const char*)(gbase) + voffB[_i]), (LAS unsigned*)(lds + (bufoff) + ldsw + _i * 8192), 16, 0, 0); } while (0)
#define G8_LDA(dst, b, h) do { _Pragma("unroll") for (int m = 0; m < 4; ++m) _Pragma("unroll") for (int k = 0; k < 2; ++k) dst[m][k] = *(const LAS bf16x8*)(lds + G8_SA(b, h) + aoff + m * 2048 + k * 1024); } while (0)
#define G8_LDB(dst, b, h) do { _Pragma("unroll") for (int n = 0; n < 2; ++n) _Pragma("unroll") for (int k = 0; k < 2; ++k) dst[n][k] = *(const LAS bf16x8*)(lds + G8_SB(b, h) + boff + n * 2048 + k * 1024); } while (0)
#define G8_MMA(ai, bj, At, Bt) do { __builtin_amdgcn_s_setprio(1); _Pragma("unroll") for (int m = 0; m < 4; ++m) _Pragma("unroll") for (int n = 0; n < 2; ++n) _Pragma("unroll") for (int k = 0; k < 2; ++k) \
        acc[ai][bj][m][n] = __builtin_amdgcn_mfma_f32_16x16x32_bf16(Bt[n][k], At[m][k], acc[ai][bj][m][n], 0, 0, 0); __builtin_amdgcn_s_setprio(0); } while (0)
#define G8_WAIT_V(n) asm volatile("s_waitcnt vmcnt(" #n ")" ::: "memory")
#define G8_WAIT_L(n) asm volatile("s_waitcnt lgkmcnt(" #n ")" ::: "memory")
#define G8_BAR __builtin_amdgcn_s_barrier()
#define G8_SCHED __builtin_amdgcn_sched_barrier(0)
    GU cur, nxt; int ui = 0;
    if (!S.next(0, cur)) return;
    if constexpr (P::GATHER) { S.rows(cur, offA); asm volatile("" : "+v"(offA[0][0]), "+v"(offA[0][1]), "+v"(offA[1][0]), "+v"(offA[1][1])); }
    f32x4 acc[2][2][4][2];
#pragma unroll
    for (int a = 0; a < 2; ++a)
#pragma unroll
        for (int b = 0; b < 2; ++b)
#pragma unroll
            for (int m = 0; m < 4; ++m)
#pragma unroll
                for (int n = 0; n < 2; ++n) acc[a][b][m][n] = (f32x4){0.f, 0.f, 0.f, 0.f};
    bf16x8 At[4][2], B0[2][2], B1[2][2];
    const char* cA = cur.A; const char* cB = cur.B;
    G8_STAGE_B(G8_SB(0, 0), cB); G8_STAGE_A(G8_SA(0, 0), cA, offA, 0); G8_STAGE_B(G8_SB(0, 1), cB + hstepB); G8_STAGE_A(G8_SA(0, 1), cA, offA, 1);
    if (wr == 1) G8_BAR;
    G8_WAIT_V(4); G8_BAR;
    G8_STAGE_B(G8_SB(1, 0), cB + kstep); G8_STAGE_A(G8_SA(1, 0), cA + kstep, offA, 0); G8_STAGE_B(G8_SB(1, 1), cB + hstepB + kstep);
    G8_WAIT_V(6); G8_BAR;
    for (;;) {
        const bool has_next = S.next(ui + 1, nxt);
        const char* nA = has_next ? nxt.A : cA; const char* nB = has_next ? nxt.B : cB;
        if constexpr (P::GATHER) {
            if (has_next) S.rows(nxt, offAn);
            else {
#pragma unroll
                for (int h = 0; h < 2; ++h)
#pragma unroll
                    for (int i = 0; i < 2; ++i) offAn[h][i] = offA[h][i]; }
            asm volatile("" : "+v"(offAn[0][0]), "+v"(offAn[0][1]), "+v"(offAn[1][0]), "+v"(offAn[1][1]));
        }
        for (int t = 0; t < nt; t += 2) {
            const bool last = (t == nt - 2);
            const char* a1 = cA + (size_t)(t + 1) * kstep;
            const char* a2 = last ? nA : cA + (size_t)(t + 2) * kstep; const char* b2 = last ? nB : cB + (size_t)(t + 2) * kstep;
            const char* a3 = a2 + kstep; const char* b3 = b2 + kstep;
            unsigned o2[2][2];
#pragma unroll
            for (int h = 0; h < 2; ++h)
#pragma unroll
                for (int i = 0; i < 2; ++i) o2[h][i] = (P::GATHER && last) ? offAn[h][i] : offA[h][i];
            G8_LDB(B0, 0, 0); G8_SCHED; G8_LDA(At, 0, 0); G8_STAGE_A(G8_SA(1, 1), a1, offA, 1);
            G8_WAIT_L(8); G8_BAR; G8_WAIT_L(0); G8_MMA(0, 0, At, B0); G8_BAR; G8_SCHED;
            G8_LDB(B1, 0, 1); G8_STAGE_B(G8_SB(0, 0), b2);
            G8_BAR; G8_WAIT_L(0); G8_MMA(0, 1, At, B1); G8_BAR;
            G8_LDA(At, 0, 1); G8_STAGE_A(G8_SA(0, 0), a2, o2, 0);
            G8_BAR; G8_WAIT_L(0); G8_MMA(1, 0, At, B0); G8_BAR; G8_SCHED;
            G8_STAGE_B(G8_SB(0, 1), b2 + hstepB);
            G8_WAIT_V(6); G8_BAR; G8_MMA(1, 1, At, B1); G8_BAR;
            G8_LDB(B0, 1, 0); G8_SCHED; G8_LDA(At, 1, 0); G8_STAGE_A(G8_SA(0, 1), a2, o2, 1);
            G8_WAIT_L(8); G8_BAR; G8_WAIT_L(0); G8_MMA(0, 0, At, B0); G8_BAR; G8_SCHED;
            G8_LDB(B1, 1, 1); G8_STAGE_B(G8_SB(1, 0), b3);
            G8_BAR; G8_WAIT_L(0); G8_MMA(0, 1, At, B1); G8_BAR;
            G8_LDA(At, 1, 1); G8_STAGE_A(G8_SA(1, 0), a3, o2, 0);
            G8_BAR; G8_WAIT_L(0); G8_MMA(1, 0, At, B0); G8_BAR; G8_SCHED;
            G8_STAGE_B(G8_SB(1, 1), b3 + hstepB);
            G8_WAIT_V(6); G8_BAR; G8_MMA(1, 1, At, B1); G8_BAR;
        }
        S.epi(acc, cur, wr, wc, fr, fq);
        if (!has_next) break;
#pragma unroll
        for (int a = 0; a < 2; ++a)
#pragma unroll
            for (int b = 0; b < 2; ++b)
#pragma unroll
                for (int m = 0; m < 4; ++m)
#pragma unroll
                    for (int n = 0; n < 2; ++n) acc[a][b][m][n] = (f32x4){0.f, 0.f, 0.f, 0.f};
        cur = nxt; cA = nA; cB = nB; ++ui;
        if constexpr (P::GATHER) {
#pragma unroll
            for (int h = 0; h < 2; ++h)
#pragma unroll
                for (int i = 0; i < 2; ++i) offA[h][i] = offAn[h][i]; }
    }
    G8_WAIT_V(0);
    if (wr == 0) G8_BAR;
    G8_BAR;
#undef G8_SA
#undef G8_SB
#undef G8_STAGE_A
#undef G8_STAGE_B
#undef G8_LDA
#undef G8_LDB
#undef G8_MMA
#undef G8_WAIT_V
#undef G8_WAIT_L
#undef G8_BAR
#undef G8_SCHED
}
}

struct PolDenseBf16 {
    static constexpr bool PERM = true, GATHER = false;
    int K; unsigned lda, ldb;
    const char* A; const char* B; bf16_t* C; int ldc; int nM, nN, pm0, G, c;
    __device__ __forceinline__ bool next(int i, g8::GU& u) const {
        const int L = i * G + c; if (L >= nM * nN) return false;
        g8::tile_order(L, nM, nN, u.pm, u.pn); u.pm += pm0; u.aux = 0; u.valid = 256;
        u.A = A + (size_t)u.pm * 256 * lda; u.B = B + (size_t)u.pn * 256 * ldb; return true;
    }
    __device__ __forceinline__ void epi(const f32x4 (&acc)[2][2][4][2], const g8::GU& u, int wr, int wc, int fr, int fq) const {
        const int row0 = u.pm * 256 + wr * 64 + fr, col0 = u.pn * 256 + wc * 32 + 8 * fq;
#pragma unroll
        for (int ai = 0; ai < 2; ++ai)
#pragma unroll
            for (int m = 0; m < 4; ++m) { bf16_t* rowp = C + (size_t)(row0 + ai * 128 + m * 16) * ldc + col0;
#pragma unroll
                for (int bj = 0; bj < 2; ++bj) { const f32x4 v0 = acc[ai][bj][m][0], v1 = acc[ai][bj][m][1];
                    u32x4 w; w.x = cvt_pk_bf16(v0[0], v0[1]); w.y = cvt_pk_bf16(v0[2], v0[3]); w.z = cvt_pk_bf16(v1[0], v1[1]); w.w = cvt_pk_bf16(v1[2], v1[3]);
                    *(u32x4*)(rowp + bj * 128) = w; } }
    }
};
template <int WHICH>
struct PolMoe {
    static constexpr bool PERM = true, GATHER = (WHICH == 1);
    int K; unsigned lda, ldb;
    const char* A; const char* Bw; bf16_t* C; const unsigned* list; int nN, G, c;
    int tid; LAS int* tab;
    __device__ __forceinline__ void init(const unsigned* cntw) {
        if (tid == 0) { int nt = 0;
            for (int e = 0; e < NEXP; ++e) { const int ce = (int)cntw[e];
                for (int t = 0; t * 256 < ce; ++t) { tab[4 + 4 * nt] = e; tab[5 + 4 * nt] = e * NTOK + t * 256; tab[6 + 4 * nt] = (ce - t * 256) < 256 ? (ce - t * 256) : 256; ++nt; } }
            tab[0] = nt; }
        __syncthreads();
    }
    __device__ __forceinline__ bool next(int i, g8::GU& u) const {
        const int L = i * G + c; if (L >= __builtin_amdgcn_readfirstlane(tab[0]) * nN) return false;
        const int mt = L / nN; u.pn = L % nN;
        const int e = __builtin_amdgcn_readfirstlane(tab[4 + 4 * mt]); u.pm = __builtin_amdgcn_readfirstlane(tab[5 + 4 * mt]); u.valid = __builtin_amdgcn_readfirstlane(tab[6 + 4 * mt]); u.aux = mt;
        u.A = (WHICH == 1) ? A : A + (size_t)mt * 256 * lda; u.B = Bw + ((size_t)e * (WHICH == 1 ? 1024 : D) + (size_t)u.pn * 256) * ldb; return true;
    }
    __device__ __forceinline__ unsigned slot_of(const g8::GU& u, int r) const { const int rr = r < u.valid ? r : 0; return list[u.pm + rr]; }
    __device__ __forceinline__ void rows(const g8::GU& u, unsigned (&off)[2][2]) const {
#pragma unroll
        for (int i = 0; i < 2; ++i) { int R, C; g8::stage_rc(tid * 16 + i * 8192, R, C);
#pragma unroll
            for (int h = 0; h < 2; ++h) { const unsigned s = slot_of(u, h * 128 + R); off[h][i] = (s >> 1) * lda + (unsigned)C * 2u; } }
    }
    __device__ __forceinline__ void epi(const f32x4 (&acc)[2][2][4][2], const g8::GU& u, int wr, int wc, int fr, int fq) const {
        if (WHICH == 1) {
#pragma unroll
            for (int ai = 0; ai < 2; ++ai)
#pragma unroll
                for (int m = 0; m < 4; ++m) { const int r = ai * 128 + wr * 64 + m * 16 + fr;
                    const f32x4 g0 = acc[ai][0][m][0], g1 = acc[ai][0][m][1], u0 = acc[ai][1][m][0], u1 = acc[ai][1][m][1];
                    float h[8];
#pragma unroll
                    for (int q = 0; q < 4; ++q) { h[q] = g0[q] * sigmoidf_(g0[q]) * u0[q]; h[4 + q] = g1[q] * sigmoidf_(g1[q]) * u1[q]; }
                    u32x4 w; w.x = cvt_pk_bf16(h[0], h[1]); w.y = cvt_pk_bf16(h[2], h[3]); w.z = cvt_pk_bf16(h[4], h[5]); w.w = cvt_pk_bf16(h[6], h[7]);
                    *(u32x4*)(C + ((size_t)u.aux * 256 + r) * DFF + u.pn * 128 + wc * 32 + 8 * fq) = w; }
        } else {
            unsigned sl[2][4];
#pragma unroll
            for (int ai = 0; ai < 2; ++ai)
#pragma unroll
                for (int m = 0; m < 4; ++m) sl[ai][m] = slot_of(u, ai * 128 + wr * 64 + m * 16 + fr);
#pragma unroll
            for (int ai = 0; ai < 2; ++ai)
#pragma unroll
                for (int m = 0; m < 4; ++m) { const int r = ai * 128 + wr * 64 + m * 16 + fr; const bool ok = r < u.valid;
#pragma unroll
                    for (int bj = 0; bj < 2; ++bj) { const f32x4 v0 = acc[ai][bj][m][0], v1 = acc[ai][bj][m][1];
                        u32x4 w; w.x = cvt_pk_bf16(v0[0], v0[1]); w.y = cvt_pk_bf16(v0[2], v0[3]); w.z = cvt_pk_bf16(v1[0], v1[1]); w.w = cvt_pk_bf16(v1[2], v1[3]);
                        if (ok) *(u32x4*)(C + (size_t)sl[ai][m] * D + u.pn * 256 + bj * 128 + wc * 32 + 8 * fq) = w; } }
        }
    }
};

struct PolMerge {
    static constexpr bool PERM = true, GATHER = false;
    int K; unsigned lda, ldb;
    const char* A; const char* B; bf16_t* Gt; bf16_t* Yo; int nM, pm0, G, c;
    __device__ __forceinline__ bool next(int i, g8::GU& u) const {
        const int L = (i >> 2) * G + c; if (L >= nM * 8) return false;
        g8::tile_order(L, nM, 8, u.pm, u.pn); u.pm += pm0; u.aux = i & 3; u.valid = 256;
        u.A = A + (size_t)u.pm * 256 * lda + (size_t)u.aux * 2048; u.B = B + ((size_t)u.aux * D + (size_t)u.pn * 256) * ldb; return true;
    }
    __device__ __forceinline__ void epi(const f32x4 (&acc)[2][2][4][2], const g8::GU& u, int wr, int wc, int fr, int fq) const {
        const int row0 = u.pm * 256 + wr * 64 + fr, col0 = u.pn * 256 + wc * 32 + 8 * fq, n = u.aux;
#pragma unroll
        for (int ai = 0; ai < 2; ++ai) {
            u32x4 gv[4][2]; unsigned long long pq[4][2][2];
#pragma unroll
            for (int m = 0; m < 4; ++m)
#pragma unroll
                for (int bj = 0; bj < 2; ++bj) { const bf16_t* gp = Gt + (size_t)(row0 + ai * 128 + m * 16) * NG + n * D + col0 + bj * 128;
                    gv[m][bj] = *(const u32x4*)gp;
                    if (n > 0) { const u32x4 pv = *(const u32x4*)(gp - D); pq[m][bj][0] = (unsigned long long)pv.x | ((unsigned long long)pv.y << 32); pq[m][bj][1] = (unsigned long long)pv.z | ((unsigned long long)pv.w << 32); }
                    else { pq[m][bj][0] = 0ull; pq[m][bj][1] = 0ull; } }
#pragma unroll
            for (int m = 0; m < 4; ++m) { bf16_t* grow = Gt + (size_t)(row0 + ai * 128 + m * 16) * NG + n * D + col0;
#pragma unroll
                for (int bj = 0; bj < 2; ++bj) { const f32x4 v0 = acc[ai][bj][m][0], v1 = acc[ai][bj][m][1]; const u32x4 g = gv[m][bj];
                    const unsigned p0 = (unsigned)pq[m][bj][0], p1 = (unsigned)(pq[m][bj][0] >> 32), p2 = (unsigned)pq[m][bj][1], p3 = (unsigned)(pq[m][bj][1] >> 32);
                    float r[8];
                    r[0] = v0[0] * sigmoidf_(bf_lo(g.x)) + bf_lo(p0); r[1] = v0[1] * sigmoidf_(bf_hi(g.x)) + bf_hi(p0); r[2] = v0[2] * sigmoidf_(bf_lo(g.y)) + bf_lo(p1); r[3] = v0[3] * sigmoidf_(bf_hi(g.y)) + bf_hi(p1);
                    r[4] = v1[0] * sigmoidf_(bf_lo(g.z)) + bf_lo(p2); r[5] = v1[1] * sigmoidf_(bf_hi(g.z)) + bf_hi(p2); r[6] = v1[2] * sigmoidf_(bf_lo(g.w)) + bf_lo(p3); r[7] = v1[3] * sigmoidf_(bf_hi(g.w)) + bf_hi(p3);
                    u32x4 w; w.x = cvt_pk_bf16(r[0], r[1]); w.y = cvt_pk_bf16(r[2], r[3]); w.z = cvt_pk_bf16(r[4], r[5]); w.w = cvt_pk_bf16(r[6], r[7]);
                    if (n < 3) *(u32x4*)(grow + bj * 128) = w;
                    else *(u32x4*)(Yo + (size_t)(row0 + ai * 128 + m * 16) * D + col0 + bj * 128) = w; } }
            asm volatile("" ::: "memory");
        }
    }
};
struct PolOut {
    static constexpr bool PERM = false, GATHER = false;
    int K; unsigned lda, ldb;
    const char* A; const char* B; const float* xin_c; const float* xin_l; float* xout_c; float* xout_l; const float* mod_l; int nM, pm0, G, c;
    __device__ __forceinline__ bool next(int i, g8::GU& u) const {
        const int L = i * G + c; if (L >= nM * 8) return false;
        g8::tile_order(L, nM, 8, u.pm, u.pn); u.pm += pm0; u.aux = 0; u.valid = 256;
        u.A = A + (size_t)u.pm * 256 * lda; u.B = B + (size_t)u.pn * 256 * ldb; return true;
    }
    __device__ __forceinline__ void epi(const f32x4 (&acc)[2][2][4][2], const g8::GU& u, int wr, int wc, int fr, int fq) const {
        const bool isc = u.pm < 8;
        const int mi = isc ? 8 : ((u.pm - 8) >> 3);
        const int lrow0 = (isc ? u.pm * 256 : (u.pm - 8) * 256) + wr * 64 + fr, col0 = u.pn * 256 + wc * 32 + 4 * fq;
        const float* xi = isc ? xin_c : xin_l; float* xo = isc ? xout_c : xout_l;
        const float* g1 = mod_l + (size_t)mi * (6 * D) + 2 * D + col0;
        f32x4 gv[2][2];
#pragma unroll
        for (int bj = 0; bj < 2; ++bj)
#pragma unroll
            for (int n = 0; n < 2; ++n) gv[bj][n] = *(const f32x4*)(g1 + bj * 128 + n * 16);
#pragma unroll
        for (int ai = 0; ai < 2; ++ai) {
            f32x4 xv[4][2][2];
#pragma unroll
            for (int m = 0; m < 4; ++m) { const size_t off = (size_t)(lrow0 + ai * 128 + m * 16) * D + col0;
#pragma unroll
                for (int bj = 0; bj < 2; ++bj)
#pragma unroll
                    for (int n = 0; n < 2; ++n) xv[m][bj][n] = *(const f32x4*)(xi + off + bj * 128 + n * 16); }
#pragma unroll
            for (int m = 0; m < 4; ++m) { const size_t off = (size_t)(lrow0 + ai * 128 + m * 16) * D + col0;
#pragma unroll
                for (int bj = 0; bj < 2; ++bj)
#pragma unroll
                    for (int n = 0; n < 2; ++n) *(f32x4*)(xo + off + bj * 128 + n * 16) = xv[m][bj][n] + gv[bj][n] * acc[ai][bj][m][n]; }
            asm volatile("" ::: "memory");
        }
    }
};

constexpr float LOG2E = 1.4426950408889634f;
constexpr int NKEY = CTXL + SEQ;
#define F_KB ((bf16_t*)(F.ws + WS_Y))
#define F_VTB ((bf16_t*)(F.ws + WS_Y + 36 * MiB))
#define F_KA ((bf16_t*)(F.ws + WS_HID))
#define F_VTA ((bf16_t*)(F.ws + WS_HID + 9 * MiB))
__device__ __forceinline__ void prep_phase(const Frame& F, int l) {
    const int gw = F.vcu * NWAVES + F.wave, NGW = F.G * NWAVES, lane = F.lane;
    bf16_t* P1 = F_P1;
    const f32x2 gqa = *(const f32x2*)(F_qn_a + l * 128 + 2 * lane), gka = *(const f32x2*)(F_kn_a + l * 128 + 2 * lane);
    const f32x2 gqb = *(const f32x2*)(F_qn_b + l * 64 + ((2 * lane) & 63)), gkb = *(const f32x2*)(F_kn_b + l * 64 + ((2 * lane) & 63));
    const float invA0 = exp2f(-(float)((2 * lane) & 31) * (13.287712379549449f / 32.0f)), invA1 = exp2f(-(float)((2 * lane + 1) & 31) * (13.287712379549449f / 32.0f));
    const float invB0 = exp2f(-(float)((2 * lane) & 15) * (13.287712379549449f / 16.0f)), invB1 = exp2f(-(float)((2 * lane + 1) & 15) * (13.287712379549449f / 16.0f));
    const float sgnA = (lane & 16) ? 1.f : -1.f, sgnB = (lane & 8) ? 1.f : -1.f;
    for (int row = gw; row < NTOK; row += NGW) {
        const bool isc = row < NCTX; const int b = isc ? (row >> 8) : ((row - NCTX) >> 11), t = isc ? (row & 255) : ((row - NCTX) & 2047);
        const int key = isc ? t : CTXL + t;
        const float prow = (float)(t >> 6), pcol = (float)(t & 63);
        bf16_t* pr = P1 + (size_t)row * N1;
        unsigned raw[26];
#pragma unroll
        for (int hh = 0; hh < 10; ++hh) raw[hh] = *(const unsigned*)(pr + (hh < 8 ? C_AQ + hh * 128 : C_AK + (hh - 8) * 128) + 2 * lane);
#pragma unroll
        for (int hh = 0; hh < 16; ++hh) raw[10 + hh] = *(const unsigned*)(pr + (hh < 8 ? C_BQ : C_BK) + (hh & 7) * 128 + 2 * lane);
        float cA0 = 1.f, sA0 = 0.f, cA1 = 1.f, sA1 = 0.f, cB0 = 1.f, sB0 = 0.f, cB1 = 1.f, sB1 = 0.f;
        if (!isc) { const float pa = (lane & 32) ? pcol : prow, pb = (lane & 16) ? pcol : prow;
            sincosf(pa * invA0, &sA0, &cA0); sincosf(pa * invA1, &sA1, &cA1); sincosf(pb * invB0, &sB0, &cB0); sincosf(pb * invB1, &sB1, &cB1); }
#pragma unroll
        for (int hh = 0; hh < 10; ++hh) {
            const bool isq = hh < 8;
            float a0 = bf_lo(raw[hh]), a1 = bf_hi(raw[hh]);
            const float rinv = rsqrtf(wave_sum(a0 * a0 + a1 * a1, lane) * (1.0f / 128.0f) + 1e-6f);
            a0 *= rinv * (isq ? gqa.x : gka.x); a1 *= rinv * (isq ? gqa.y : gka.y);
            const float p0 = shx(a0, 16, lane), p1 = shx(a1, 16, lane);
            float o0 = a0 * cA0 + sgnA * p0 * sA0, o1 = a1 * cA1 + sgnA * p1 * sA1;
            if (isq) { const float sc = 0.08838834764831845f * LOG2E; o0 *= sc; o1 *= sc; }
            bf16_t* dst = isq ? pr + C_AQ + hh * 128 : F_KA + (((size_t)(b * 2 + (hh - 8)) * NKEY + key) * 128);
            *(unsigned*)(dst + 2 * lane) = cvt_pk_bf16(o0, o1);
        }
#pragma unroll
        for (int hh = 0; hh < 16; ++hh) {
            const bool isq = hh < 8; const int h = hh & 7;
            float a0 = bf_lo(raw[10 + hh]), a1 = bf_hi(raw[10 + hh]);
            float ss = a0 * a0 + a1 * a1;
#pragma unroll
            for (int o = 1; o < 32; o <<= 1) ss += shx(ss, o, lane);
            const float rinv = rsqrtf(ss * (1.0f / 64.0f) + 1e-6f);
            a0 *= rinv * (isq ? gqb.x : gkb.x); a1 *= rinv * (isq ? gqb.y : gkb.y);
            const float p0 = shx(a0, 8, lane), p1 = shx(a1, 8, lane);
            float o0 = a0 * cB0 + sgnB * p0 * sB0, o1 = a1 * cB1 + sgnB * p1 * sB1;
            if (isq) { const float sc = 0.125f * LOG2E; o0 *= sc; o1 *= sc; }
            bf16_t* dst = isq ? pr + C_BQ + h * 128 : F_KB + (((size_t)(b * 8 + h) * NKEY + key) * 128);
            *(unsigned*)(dst + 2 * lane) = cvt_pk_bf16(o0, o1);
        }
    }
    for (int it = gw; it < 288 * 40; it += NGW) {
        const int tile = it / 40, q = it % 40; const bool isA = q < 8; const int head = isA ? (q >> 2) : ((q - 8) >> 2), slab = q & 3;
        const bool isc = tile < 32; const int b = isc ? (tile >> 2) : ((tile - 32) >> 5), t0 = isc ? ((tile & 3) * 64) : (((tile - 32) & 31) * 64);
        const int row = (isc ? b * CTXL : NCTX + b * SEQ) + t0 + lane, key = (isc ? 0 : CTXL) + t0 + lane;
        const bf16_t* src = P1 + (size_t)row * N1 + (isA ? C_AV : C_BV) + head * 128 + slab * 32;
        u32x4 v[4];
#pragma unroll
        for (int j = 0; j < 4; ++j) v[j] = *(const u32x4*)(src + 8 * j);
        const int keyp = (key & ~12) | ((key & 8) >> 1) | ((key & 4) << 1);
        bf16_t* dst = (isA ? F_VTA + ((size_t)(b * 2 + head) * 128 + slab * 32) * NKEY : F_VTB + ((size_t)(b * 8 + head) * 128 + slab * 32) * NKEY) + keyp;
#pragma unroll
        for (int j = 0; j < 4; ++j) { const unsigned w[4] = {v[j].x, v[j].y, v[j].z, v[j].w};
#pragma unroll
            for (int e = 0; e < 4; ++e) { dst[(size_t)(8 * j + 2 * e) * NKEY] = (bf16_t)(w[e] & 0xffffu); dst[(size_t)(8 * j + 2 * e + 1) * NKEY] = (bf16_t)(w[e] >> 16); } }
    }
}

constexpr int AT_KBYTES = 64 * 256, AT_VBYTES = 128 * 128, AT_BUF = AT_KBYTES + AT_VBYTES, AT_XCH = 2 * AT_BUF;
struct AttnUnit { bool isA, isc; int b, h, qt; };
template <bool IS_A>
__device__ __forceinline__ void attn_unit(const Frame& F, int l, const AttnUnit u) {
    constexpr int NS = IS_A ? 8 : 4;
    const int tid = F.tid, lane = F.lane, w = F.wave, r = lane & 31, h5 = lane >> 5;
    LAS unsigned char* lds = F.lds;
    int t, head, dofs, qcol0;
    if (IS_A) { const int g = w >> 1, qb = w & 1; t = u.qt * 64 + 32 * qb + r; head = u.h * 4 + g; dofs = 0; qcol0 = C_AQ + head * 128; }
    else { const int comp = w >> 2, qb = w & 3; t = u.qt * 128 + 32 * qb + r; head = u.h; dofs = comp * 64; qcol0 = C_BQ + head * 128 + comp * 64; }
    const int qrow = (u.isc ? u.b * CTXL : NCTX + u.b * SEQ) + t;
    const int nhk = IS_A ? 2 : 8;
    const bf16_t* Kb = (IS_A ? F_KA : F_KB) + (size_t)(u.b * nhk + u.h) * NKEY * 128;
    const bf16_t* Vt = (IS_A ? F_VTA : F_VTB) + (size_t)(u.b * nhk + u.h) * 128 * NKEY;
    int lt_lo = 0, ntile;
    if (u.isc) ntile = 4;
    else if (IS_A) { lt_lo = u.qt - 2 < 0 ? 0 : u.qt - 2; const int lt_hi = u.qt + 2 > 31 ? 31 : u.qt + 2; ntile = 4 + lt_hi - lt_lo + 1; }
    else ntile = 36;
    const int wu = __builtin_amdgcn_readfirstlane(w);
    auto tile_of = [&](int j) -> int { return (IS_A && !u.isc && j >= 4) ? 4 + lt_lo + (j - 4) : j; };
    auto dma = [&](int kt, int buf) {
#pragma unroll
        for (int i = 0; i < 2; ++i) { const int blk = 2 * wu + i; const int row = 4 * blk + (lane >> 4); const int c = (lane & 15) ^ (row & 15);
            __builtin_amdgcn_global_load_lds((const unsigned*)((const unsigned char*)Kb + ((size_t)(kt * 64 + row)) * 256 + c * 16), (LAS unsigned*)(lds + buf * AT_BUF + blk * 1024), 16, 0, 0); }
#pragma unroll
        for (int i = 0; i < 2; ++i) { const int blk = 2 * wu + i; const int row = 8 * blk + (lane >> 3); const int c = (lane & 7) ^ ((row >> 1) & 7);
            __builtin_amdgcn_global_load_lds((const unsigned*)((const unsigned char*)Vt + (size_t)row * (NKEY * 2) + kt * 128 + c * 16), (LAS unsigned*)(lds + buf * AT_BUF + AT_KBYTES + blk * 1024), 16, 0, 0); }
    };
    dma(tile_of(0), 0);
    float bound2, sinkp = 0.f;
    if (IS_A) { const float gq = wave_max(fmaxf(fabsf(F_qn_a[l * 128 + lane]), fabsf(F_qn_a[l * 128 + 64 + lane])), lane), gk = wave_max(fmaxf(fabsf(F_kn_a[l * 128 + lane]), fabsf(F_kn_a[l * 128 + 64 + lane])), lane);
        bound2 = LOG2E * 11.313708498984761f * gq * gk; sinkp = exp2f(F_sink_a[l * 8 + head] * LOG2E - bound2); }
    else { const float gq = wave_max(fabsf(F_qn_b[l * 64 + lane]), lane), gk = wave_max(fabsf(F_kn_b[l * 64 + lane]), lane); bound2 = LOG2E * 8.0f * gq * gk; }
    bf16x8 qf[NS];
    { const bf16_t* qp = F_P1 + (size_t)qrow * N1 + qcol0 + 8 * h5;
#pragma unroll
        for (int s = 0; s < NS; ++s) qf[s] = *(const bf16x8*)(qp + 16 * s); }
    f32x16 oacc[4];
#pragma unroll
    for (int i = 0; i < 4; ++i)
#pragma unroll
        for (int j = 0; j < 16; ++j) oacc[i][j] = 0.f;
    float lsum = 0.f;
    const int koff0 = r * 256 + (((dofs >> 3) + h5) ^ (r & 15)) * 16;
    const int voff0 = r * 128 + (h5 ^ ((r >> 1) & 7)) * 16;
    asm volatile("s_waitcnt vmcnt(0)" ::: "memory");
    __syncthreads();
    for (int j = 0; j < ntile; ++j) {
        const int kt = tile_of(j);
        if (j + 1 < ntile) dma(tile_of(j + 1), (j + 1) & 1);
        const LAS unsigned char* kb = lds + (j & 1) * AT_BUF; const LAS unsigned char* vb = kb + AT_KBYTES;
        const bool band = IS_A && !u.isc && kt >= 4;
        const int kpos0 = (kt - 4) * 64;
        bf16x8 kf[NS]; u32x4 vf[8];
        auto kread = [&](int sub) {
#pragma unroll
            for (int s = 0; s < NS; ++s) kf[s] = *(const LAS bf16x8*)(kb + 8192 * sub + (koff0 ^ (32 * s))); };
        auto vread = [&](int sub) {
#pragma unroll
            for (int dvt = 0; dvt < 4; ++dvt)
#pragma unroll
                for (int s2 = 0; s2 < 2; ++s2) vf[2 * dvt + s2] = *(const LAS u32x4*)(vb + 4096 * dvt + (voff0 ^ (64 * sub + 32 * s2))); };
        kread(0);
        vread(0);
        __builtin_amdgcn_sched_barrier(0);
#pragma unroll
        for (int sub = 0; sub < 2; ++sub) {
            f32x16 sacc;
#pragma unroll
            for (int i = 0; i < 16; ++i) sacc[i] = -bound2;
#pragma unroll
            for (int s = 0; s < NS; ++s) sacc = __builtin_amdgcn_mfma_f32_32x32x16_bf16(kf[s], qf[s], sacc, 0, 0, 0);
            float p[16];
#pragma unroll
            for (int i = 0; i < 16; ++i) { float e = __builtin_amdgcn_exp2f(sacc[i]);
                if (band) { const int kpos = kpos0 + 32 * sub + (i & 3) + 8 * (i >> 2) + 4 * h5; const int dlt = kpos - t; e = (dlt <= 128 && dlt >= -128) ? e : 0.f; }
                p[i] = e; lsum += e; }
            bf16x8 pb[2];
#pragma unroll
            for (int s2 = 0; s2 < 2; ++s2) { u32x4 pk; pk.x = cvt_pk_bf16(p[8 * s2 + 0], p[8 * s2 + 1]); pk.y = cvt_pk_bf16(p[8 * s2 + 2], p[8 * s2 + 3]); pk.z = cvt_pk_bf16(p[8 * s2 + 4], p[8 * s2 + 5]); pk.w = cvt_pk_bf16(p[8 * s2 + 6], p[8 * s2 + 7]);
                pb[s2] = __builtin_bit_cast(bf16x8, pk); }
            __builtin_amdgcn_sched_barrier(0);
            if (sub == 0) { kread(1); __builtin_amdgcn_sched_barrier(0); }
#pragma unroll
            for (int dvt = 0; dvt < 4; ++dvt)
#pragma unroll
                for (int s2 = 0; s2 < 2; ++s2) oacc[dvt] = __builtin_amdgcn_mfma_f32_32x32x16_bf16(__builtin_bit_cast(bf16x8, vf[2 * dvt + s2]), pb[s2], oacc[dvt], 0, 0, 0);
            __builtin_amdgcn_sched_barrier(0);
            if (sub == 0) { vread(1); __builtin_amdgcn_sched_barrier(0); }
        }
        asm volatile("s_waitcnt vmcnt(0)" ::: "memory");
        __syncthreads();
    }
    float ltot = lsum + shx(lsum, 32, lane) + sinkp;
    const float linv = 1.0f / ltot;
    bf16_t* orow = F_O + (size_t)qrow * 4096;
    if (IS_A) {
#pragma unroll
        for (int dvt = 0; dvt < 4; ++dvt)
#pragma unroll
            for (int g = 0; g < 4; ++g) { u32x2 o; o.x = cvt_pk_bf16(oacc[dvt][4 * g] * linv, oacc[dvt][4 * g + 1] * linv); o.y = cvt_pk_bf16(oacc[dvt][4 * g + 2] * linv, oacc[dvt][4 * g + 3] * linv);
                *(u32x2*)(orow + head * 128 + 32 * dvt + 8 * g + 4 * h5) = o; }
    } else {
        LAS float* xch = (LAS float*)(lds + AT_XCH) + (w & 3) * 4096;
        if (w >= 4) {
#pragma unroll
            for (int dvt = 0; dvt < 4; ++dvt)
#pragma unroll
                for (int i = 0; i < 16; ++i) xch[(dvt * 16 + i) * 64 + lane] = oacc[dvt][i] * linv;
        }
        __syncthreads();
        if (w < 4) {
            const float* lb = F_lam_b + l * 256;
            const float d1 = wave_sum(lb[lane] * lb[64 + lane], lane), d2 = wave_sum(lb[128 + lane] * lb[192 + lane], lane);
            const float lam_init = 0.8f - 0.6f * expf(-0.3f * (float)l), lam = expf(d1) - expf(d2) + lam_init;
            float ss = 0.f;
#pragma unroll
            for (int dvt = 0; dvt < 4; ++dvt)
#pragma unroll
                for (int i = 0; i < 16; ++i) { const float d = oacc[dvt][i] * linv - lam * xch[(dvt * 16 + i) * 64 + lane]; oacc[dvt][i] = d; ss += d * d; }
            ss += shx(ss, 32, lane);
            const float rn = rsqrtf(ss * (1.0f / 128.0f) + 1e-6f) * (1.0f - lam_init);
            const float* sg = F_subln_b + l * 128;
#pragma unroll
            for (int dvt = 0; dvt < 4; ++dvt)
#pragma unroll
                for (int g = 0; g < 4; ++g) { const int dv = 32 * dvt + 8 * g + 4 * h5; const f32x4 gg = *(const f32x4*)(sg + dv);
                    u32x2 o; o.x = cvt_pk_bf16(oacc[dvt][4 * g] * rn * gg.x, oacc[dvt][4 * g + 1] * rn * gg.y); o.y = cvt_pk_bf16(oacc[dvt][4 * g + 2] * rn * gg.z, oacc[dvt][4 * g + 3] * rn * gg.w);
                    *(u32x2*)(orow + 1024 + head * 128 + dv) = o; }
        }
    }
}
__device__ __forceinline__ float gelu_tanh(float x) { const float z = 0.7978845608028654f * (x + 0.044715f * x * x * x); const float e = __expf(2.0f * z); return 0.5f * x * (2.0f - 2.0f / (1.0f + e)); }
#define F_HB ((bf16_t*)(F.ws + WS_HB))
__device__ __forceinline__ void lru_unit(const Frame& F, int l, int b, int blk, int d) {
    const int tid = F.tid, lane = F.lane, w = F.wave, ch = tid & 127, tq = tid >> 7, fr = lane & 15, fq = lane >> 4;
    LAS float* U = (LAS float*)F.lds;
    LAS bf16_t* Ub = (LAS bf16_t*)(F.lds + 32768);
    LAS f32x2* AV = (LAS f32x2*)(F.lds + 32768 + 17408);
    LAS f32x2* SEG = (LAS f32x2*)(F.lds + 32768 + 17408 + 65536);
    LAS float* HC = (LAS float*)(F.lds + 32768 + 17408 + 65536 + 4096);
    const bf16_t* P1 = F_P1;
    const int cg = blk * 128 + ch;
    const float cw0 = F_conv_w[(l * 4 + 0) * 1024 + cg], cw1 = F_conv_w[(l * 4 + 1) * 1024 + cg], cw2 = F_conv_w[(l * 4 + 2) * 1024 + cg], cw3 = F_conv_w[(l * 4 + 3) * 1024 + cg], cb = F_conv_b[l * 1024 + cg];
    const bool ctx_out = l < DEPTH - 1;
    bf16_t* hout = (d == 0) ? F_O + 2048 + cg : F_HB + cg; const size_t hstride = (d == 0) ? 4096 : 1024;
    bf16x8 wr[4], wi[4];
    { const float* wrp = F_w_rg + ((size_t)((l * 2 + d) * 8 + blk) * 128) * 128 + 16 * w + fr; const float* wip = F_w_ig + ((size_t)((l * 2 + d) * 8 + blk) * 128) * 128 + 16 * w + fr;
#pragma unroll
        for (int ks = 0; ks < 4; ++ks) { u32x4 a, c2; const int c0 = 32 * ks + 8 * fq;
            a.x = cvt_pk_bf16(wrp[(c0 + 0) * 128], wrp[(c0 + 1) * 128]); a.y = cvt_pk_bf16(wrp[(c0 + 2) * 128], wrp[(c0 + 3) * 128]); a.z = cvt_pk_bf16(wrp[(c0 + 4) * 128], wrp[(c0 + 5) * 128]); a.w = cvt_pk_bf16(wrp[(c0 + 6) * 128], wrp[(c0 + 7) * 128]);
            c2.x = cvt_pk_bf16(wip[(c0 + 0) * 128], wip[(c0 + 1) * 128]); c2.y = cvt_pk_bf16(wip[(c0 + 2) * 128], wip[(c0 + 3) * 128]); c2.z = cvt_pk_bf16(wip[(c0 + 4) * 128], wip[(c0 + 5) * 128]); c2.w = cvt_pk_bf16(wip[(c0 + 6) * 128], wip[(c0 + 7) * 128]);
            wr[ks] = __builtin_bit_cast(bf16x8, a); wi[ks] = __builtin_bit_cast(bf16x8, c2); } }
    const int cj = blk * 128 + 16 * w + fr;
    const float br = F_b_rg[(l * 2 + d) * 1024 + cj], bi = F_b_ig[(l * 2 + d) * 1024 + cj];
    const float sp8 = 8.0f * log1pf(expf(-F_lru_lambda[(l * 2 + d) * 1024 + cj]));
    if (tid < 128) HC[tid] = 0.f;
    auto geom = [&](int step, int& rowbase, int& t0, int& seglen) { const bool isc = step < 4; const int idx = isc ? step : step - 4, nch = isc ? 4 : 32, ci = (d == 0) ? idx : nch - 1 - idx; t0 = ci * 64; seglen = isc ? CTXL : SEQ; rowbase = isc ? b * CTXL : NCTX + b * SEQ; };
    unsigned short xr[19];
    auto ldraw = [&](int step) { int rowbase, t0, seglen; geom(step, rowbase, t0, seglen); const int ts = t0 + tq * 16;
#pragma unroll
        for (int i = 0; i < 19; ++i) { const int t = ts - 2 + i; xr[i] = (t >= 0 && t < seglen) ? P1[(size_t)(rowbase + t) * N1 + C_CX + cg] : (unsigned short)0; } };
    ldraw(0);
    for (int step = 0; step < 36; ++step) {
        int rowbase, t0, seglen; geom(step, rowbase, t0, seglen);
        const bool isc = step < 4;
#pragma unroll
        for (int tt = 0; tt < 16; ++tt) { const float u = cb + cw0 * bf2f(xr[tt]) + cw1 * bf2f(xr[tt + 1]) + cw2 * bf2f(xr[tt + 2]) + cw3 * bf2f(xr[tt + 3]);
            U[(tq * 16 + tt) * 128 + ch] = u; Ub[(tq * 16 + tt) * 136 + ch] = (bf16_t)(cvt_pk_bf16(u, 0.f) & 0xffffu); }
        __syncthreads();
        if (step + 1 < 36) ldraw(step + 1);
#pragma unroll
        for (int mt = 0; mt < 4; ++mt) { f32x4 ar = (f32x4){0.f, 0.f, 0.f, 0.f}, ai = ar;
#pragma unroll
            for (int ks = 0; ks < 4; ++ks) { const bf16x8 a = *(const LAS bf16x8*)(Ub + (16 * mt + fr) * 136 + 32 * ks + 8 * fq);
                ar = __builtin_amdgcn_mfma_f32_16x16x32_bf16(a, wr[ks], ar, 0, 0, 0); ai = __builtin_amdgcn_mfma_f32_16x16x32_bf16(a, wi[ks], ai, 0, 0, 0); }
#pragma unroll
            for (int rg = 0; rg < 4; ++rg) { const int tok = 16 * mt + 4 * fq + rg, cl = 16 * w + fr;
                const float r = sigmoidf_(ar[rg] + br), ig = sigmoidf_(ai[rg] + bi); const float a_ = __expf(-sp8 * r);
                const float v = __builtin_amdgcn_sqrtf(fmaxf(1.0f - a_ * a_, 0.f)) * ig * U[tok * 128 + cl]; AV[tok * 128 + cl] = (f32x2){a_, v}; } }
        __syncthreads();
        float hl[16], cp[16];
        { float h = 0.f, pr = 1.f;
#pragma unroll
            for (int i = 0; i < 16; ++i) { const int p = 16 * tq + i, tok = (d == 0) ? p : 63 - p; const f32x2 av = AV[tok * 128 + ch]; h = av.x * h + av.y; pr *= av.x; hl[i] = h; cp[i] = pr; }
            SEG[tq * 128 + ch] = (f32x2){pr, h}; }
        __syncthreads();
        { float carry = HC[ch];
#pragma unroll
            for (int sg = 0; sg < 3; ++sg) { const f32x2 ps = SEG[sg * 128 + ch]; carry = (sg < tq) ? ps.x * carry + ps.y : carry; }
            const bool wr_out = !isc || ctx_out;
#pragma unroll
            for (int i = 0; i < 16; ++i) { const float h = hl[i] + cp[i] * carry; hl[i] = h;
                if (wr_out) { const int p = 16 * tq + i, tok = (d == 0) ? p : 63 - p; hout[(size_t)(rowbase + t0 + tok) * hstride] = (bf16_t)(cvt_pk_bf16(h, 0.f) & 0xffffu); } }
            __syncthreads();
            if (tq == 3) HC[ch] = hl[15]; }
    }
    __syncthreads();
}
__device__ __forceinline__ void lru_finish(const Frame& F, int l) {
    const size_t gt = (size_t)F.vcu * NTHR + F.tid, NGT = (size_t)F.G * NTHR;
    const size_t row_lo = (l == DEPTH - 1) ? NCTX : 0;
    for (size_t i = row_lo * 128 + gt; i < (size_t)NTOK * 128; i += NGT) { const size_t row = i >> 7; const int c8 = (int)(i & 127) * 8;
        bf16_t* op = F_O + row * 4096 + 2048 + c8;
        const u32x4 hf = *(const u32x4*)op, hb = *(const u32x4*)(F_HB + row * 1024 + c8), yv = *(const u32x4*)(F_P1 + row * N1 + C_CY + c8);
        u32x4 o;
        o.x = cvt_pk_bf16((bf_lo(hf.x) + bf_lo(hb.x)) * gelu_tanh(bf_lo(yv.x)), (bf_hi(hf.x) + bf_hi(hb.x)) * gelu_tanh(bf_hi(yv.x)));
        o.y = cvt_pk_bf16((bf_lo(hf.y) + bf_lo(hb.y)) * gelu_tanh(bf_lo(yv.y)), (bf_hi(hf.y) + bf_hi(hb.y)) * gelu_tanh(bf_hi(yv.y)));
        o.z = cvt_pk_bf16((bf_lo(hf.z) + bf_lo(hb.z)) * gelu_tanh(bf_lo(yv.z)), (bf_hi(hf.z) + bf_hi(hb.z)) * gelu_tanh(bf_hi(yv.z)));
        o.w = cvt_pk_bf16((bf_lo(hf.w) + bf_lo(hb.w)) * gelu_tanh(bf_lo(yv.w)), (bf_hi(hf.w) + bf_hi(hb.w)) * gelu_tanh(bf_hi(yv.w)));
        *(u32x4*)op = o; }
}

#define F_DSCR ((bf16_t*)(F.ws + WS_DSCR))
__device__ __forceinline__ void gla_unit(const Frame& F, int l, int b, int h, int d) {
    const int tid = F.tid, lane = F.lane, w = F.wave, kk_ = tid & 127, sc_ = tid >> 7, fr = lane & 15, fq = lane >> 4;
    LAS bf16_t* Qt = (LAS bf16_t*)F.lds;
    LAS bf16_t* Kh = (LAS bf16_t*)(F.lds + 17408);
    LAS bf16_t* KtT = (LAS bf16_t*)(F.lds + 34816);
    LAS bf16_t* Vt = (LAS bf16_t*)(F.lds + 34816 + 18432);
    LAS float* Dc = (LAS float*)(F.lds + 34816 + 36864);
    const bf16_t* P1 = F_P1;
    float lbv = 0.f;
    if (l > 0) { const float x0 = F_lb_d[(0 * 2 + d) * 1024 + h * 128 + kk_], x1 = F_lb_d[(1 * 2 + d) * 1024 + h * 128 + kk_]; lbv = 1.0f / (1.0f + expf(x0 - x1)); }
    const int zcol = (d == 0 ? C_DFF : C_DFB) + h * 128 + kk_, qcol = C_DQ + h * 128 + kk_, vcol = C_DI + h * 128 + kk_;
    f32x4 S[8];
#pragma unroll
    for (int i = 0; i < 8; ++i) S[i] = (f32x4){0.f, 0.f, 0.f, 0.f};
    bf16_t* dscr = (d == 0) ? F_O + 3072 : F_DSCR; const size_t dstride = (d == 0) ? 4096 : 1024;
    const bool ctx_out = l < DEPTH - 1;
    unsigned short zr[16], qr[16], vr[16];
    auto geom = [&](int step, int& rowbase, int& t0) { const bool isc = step < 4; const int idx = isc ? step : step - 4, nch = isc ? 4 : 32, ci = (d == 0) ? idx : nch - 1 - idx; t0 = ci * 64; rowbase = isc ? b * CTXL : NCTX + b * SEQ; };
    auto ldraw = [&](int step) { int rowbase, t0; geom(step, rowbase, t0);
#pragma unroll
        for (int tt = 0; tt < 16; ++tt) { const int p = 16 * sc_ + tt; const size_t row = (size_t)(rowbase + t0 + (d == 0 ? p : 63 - p)); zr[tt] = P1[row * N1 + zcol]; qr[tt] = P1[row * N1 + qcol]; vr[tt] = P1[row * N1 + vcol]; } };
    ldraw(0);
    for (int step = 0; step < 36; ++step) {
        const bool isc = step < 4; int rowbase, t0; geom(step, rowbase, t0);
        { float kh[16]; float eb = 1.0f;
#pragma unroll
            for (int tt = 0; tt < 16; ++tt) { const int p = 16 * sc_ + tt;
                const float z = bf2f(zr[tt]), q = bf2f(qr[tt]);
                const float sg = sigmoidf_(z); const float f = lbv + (1.0f - lbv) * sg; eb = fmaxf(eb * f, 1e-35f);
                const float ebi = __builtin_amdgcn_rcpf(eb);
                kh[tt] = (1.0f - lbv) * (1.0f - sg) * ebi;
                Qt[p * 136 + kk_] = (bf16_t)(cvt_pk_bf16(q * eb, 0.f) & 0xffffu);
                Kh[p * 136 + kk_] = (bf16_t)(cvt_pk_bf16(kh[tt], 0.f) & 0xffffu); }
            const float ebl = eb;
            u32x4 k0, k1, v0, v1;
            k0.x = cvt_pk_bf16(kh[0] * ebl, kh[1] * ebl); k0.y = cvt_pk_bf16(kh[2] * ebl, kh[3] * ebl); k0.z = cvt_pk_bf16(kh[4] * ebl, kh[5] * ebl); k0.w = cvt_pk_bf16(kh[6] * ebl, kh[7] * ebl);
            k1.x = cvt_pk_bf16(kh[8] * ebl, kh[9] * ebl); k1.y = cvt_pk_bf16(kh[10] * ebl, kh[11] * ebl); k1.z = cvt_pk_bf16(kh[12] * ebl, kh[13] * ebl); k1.w = cvt_pk_bf16(kh[14] * ebl, kh[15] * ebl);
            v0.x = (unsigned)vr[0] | ((unsigned)vr[1] << 16); v0.y = (unsigned)vr[2] | ((unsigned)vr[3] << 16); v0.z = (unsigned)vr[4] | ((unsigned)vr[5] << 16); v0.w = (unsigned)vr[6] | ((unsigned)vr[7] << 16);
            v1.x = (unsigned)vr[8] | ((unsigned)vr[9] << 16); v1.y = (unsigned)vr[10] | ((unsigned)vr[11] << 16); v1.z = (unsigned)vr[12] | ((unsigned)vr[13] << 16); v1.w = (unsigned)vr[14] | ((unsigned)vr[15] << 16);
            *(LAS u32x4*)(KtT + kk_ * 72 + 16 * sc_) = k0; *(LAS u32x4*)(KtT + kk_ * 72 + 16 * sc_ + 8) = k1;
            *(LAS u32x4*)(Vt + kk_ * 72 + 16 * sc_) = v0; *(LAS u32x4*)(Vt + kk_ * 72 + 16 * sc_ + 8) = v1;
            Dc[sc_ * 128 + kk_] = ebl; }
        __syncthreads();
        if (step + 1 < 36) ldraw(step + 1);
        LAS u32x2* ATT = (LAS u32x2*)(F.lds + 73728);
        if (__builtin_amdgcn_readfirstlane(w) < 4) { const int sc = __builtin_amdgcn_readfirstlane(w); f32x4 att = (f32x4){0.f, 0.f, 0.f, 0.f};
#pragma unroll
            for (int ks = 0; ks < 4; ++ks) { const bf16x8 a = *(const LAS bf16x8*)(Kh + (16 * sc + fr) * 136 + 32 * ks + 8 * fq), bq = *(const LAS bf16x8*)(Qt + (16 * sc + fr) * 136 + 32 * ks + 8 * fq);
                att = __builtin_amdgcn_mfma_f32_16x16x32_bf16(a, bq, att, 0, 0, 0); }
#pragma unroll
            for (int rg = 0; rg < 4; ++rg) att[rg] = (4 * fq + rg <= fr) ? att[rg] : 0.f;
            ATT[sc * 64 + lane] = (u32x2){cvt_pk_bf16(att[0], att[1]), cvt_pk_bf16(att[2], att[3])}; }
        __syncthreads();
        u32x2 attb2[4];
#pragma unroll
        for (int sc = 0; sc < 4; ++sc) attb2[sc] = ATT[sc * 64 + lane];
#pragma unroll
        for (int sc = 0; sc < 4; ++sc) {
            const u32x4 attb = (u32x4){attb2[sc].x, attb2[sc].y, 0u, 0u};
            f32x4 o = (f32x4){0.f, 0.f, 0.f, 0.f};
#pragma unroll
            for (int ks = 0; ks < 4; ++ks) { u32x4 sa; sa.x = cvt_pk_bf16(S[2 * ks][0], S[2 * ks][1]); sa.y = cvt_pk_bf16(S[2 * ks][2], S[2 * ks][3]); sa.z = cvt_pk_bf16(S[2 * ks + 1][0], S[2 * ks + 1][1]); sa.w = cvt_pk_bf16(S[2 * ks + 1][2], S[2 * ks + 1][3]);
                const u32x2 q0 = *(const LAS u32x2*)(Qt + (16 * sc + fr) * 136 + 32 * ks + 4 * fq), q1 = *(const LAS u32x2*)(Qt + (16 * sc + fr) * 136 + 32 * ks + 16 + 4 * fq);
                const u32x4 qb = (u32x4){q0.x, q0.y, q1.x, q1.y};
                o = __builtin_amdgcn_mfma_f32_16x16x32_bf16(__builtin_bit_cast(bf16x8, sa), __builtin_bit_cast(bf16x8, qb), o, 0, 0, 0); }
            { const u32x2 v0 = *(const LAS u32x2*)(Vt + (16 * w + fr) * 72 + 16 * sc + 4 * fq); const u32x4 va = (u32x4){v0.x, v0.y, 0u, 0u};
                o = __builtin_amdgcn_mfma_f32_16x16x32_bf16(__builtin_bit_cast(bf16x8, va), __builtin_bit_cast(bf16x8, attb), o, 0, 0, 0); }
            if (!isc || ctx_out) { const int p = 16 * sc + fr; const size_t row = (size_t)(rowbase + t0 + (d == 0 ? p : 63 - p));
                u32x2 ov; ov.x = cvt_pk_bf16(o[0], o[1]); ov.y = cvt_pk_bf16(o[2], o[3]); *(u32x2*)(dscr + row * dstride + h * 128 + 16 * w + 4 * fq) = ov; }
            u32x4 vb = (u32x4){0u, 0u, 0u, 0u};
            if (fq < 2) vb = *(const LAS u32x4*)(Vt + (16 * w + fr) * 72 + 16 * sc + 8 * fq);
#pragma unroll
            for (int kt = 0; kt < 8; ++kt) { const f32x4 dc = *(const LAS f32x4*)(Dc + sc * 128 + 16 * kt + 4 * fq); S[kt] *= dc;
                u32x4 ka = (u32x4){0u, 0u, 0u, 0u};
                if (fq < 2) ka = *(const LAS u32x4*)(KtT + (16 * kt + fr) * 72 + 16 * sc + 8 * fq);
                S[kt] = __builtin_amdgcn_mfma_f32_16x16x32_bf16(__builtin_bit_cast(bf16x8, ka), __builtin_bit_cast(bf16x8, vb), S[kt], 0, 0, 0); }
        }
        __syncthreads();
    }
}
__device__ __forceinline__ void gla_finish(const Frame& F, int l) {
    const int gw = F.vcu * NWAVES + F.wave, NGW = F.G * NWAVES, lane = F.lane;
    const int row_lo = (l == DEPTH - 1) ? NCTX : 0;
    const int c0 = 16 * lane, hc = c0 & 127;
    float gn[16];
#pragma unroll
    for (int q = 0; q < 4; ++q) { const f32x4 g4 = *(const f32x4*)(F_onorm_d + l * 128 + hc + 4 * q); gn[4 * q] = g4.x; gn[4 * q + 1] = g4.y; gn[4 * q + 2] = g4.z; gn[4 * q + 3] = g4.w; }
    for (int row = row_lo + gw; row < NTOK; row += NGW) {
        bf16_t* op = F_O + (size_t)row * 4096 + 3072 + c0;
        const u32x4 a0 = *(const u32x4*)op, a1 = *(const u32x4*)(op + 8);
        const u32x4 b0 = *(const u32x4*)(F_DSCR + (size_t)row * 1024 + c0), b1 = *(const u32x4*)(F_DSCR + (size_t)row * 1024 + c0 + 8);
        const u32x4 g0 = *(const u32x4*)(F_P1 + (size_t)row * N1 + C_DG + c0), g1 = *(const u32x4*)(F_P1 + (size_t)row * N1 + C_DG + c0 + 8);
        const unsigned aw[8] = {a0.x, a0.y, a0.z, a0.w, a1.x, a1.y, a1.z, a1.w}, bw[8] = {b0.x, b0.y, b0.z, b0.w, b1.x, b1.y, b1.z, b1.w}, gw_[8] = {g0.x, g0.y, g0.z, g0.w, g1.x, g1.y, g1.z, g1.w};
        float o[16]; float ss = 0.f;
#pragma unroll
        for (int q = 0; q < 8; ++q) { o[2 * q] = bf_lo(aw[q]) + bf_lo(bw[q]); o[2 * q + 1] = bf_hi(aw[q]) + bf_hi(bw[q]); ss += o[2 * q] * o[2 * q] + o[2 * q + 1] * o[2 * q + 1]; }
        ss += shx(ss, 1, lane); ss += shx(ss, 2, lane); ss += shx(ss, 4, lane);
        const float rn = rsqrtf(ss * (1.0f / 128.0f) + 1e-6f);
        unsigned ow[8];
#pragma unroll
        for (int q = 0; q < 8; ++q) { const float ga = bf_lo(gw_[q]), gb = bf_hi(gw_[q]);
            ow[q] = cvt_pk_bf16(o[2 * q] * rn * gn[2 * q] * ga * sigmoidf_(ga), o[2 * q + 1] * rn * gn[2 * q + 1] * gb * sigmoidf_(gb)); }
        *(u32x4*)op = (u32x4){ow[0], ow[1], ow[2], ow[3]}; *(u32x4*)(op + 8) = (u32x4){ow[4], ow[5], ow[6], ow[7]};
    }
}
__device__ __forceinline__ void mix_phase(const Frame& F0, int l) {
    const Frame& F = F0;
    const bool ctx_out = l < DEPTH - 1;
    const int nBl = 8 * 8 * 16, nBc = ctx_out ? 8 * 8 * 2 : 0, nAl = 8 * 2 * 32, nAc = ctx_out ? 8 * 2 * 4 : 0;
    const int nC = ENABLE_C ? 128 : 0, nD = ENABLE_D ? 128 : 0;
    const int total = nC + nD + nBl + nBc + nAl + nAc;
    volatile LAS int* slot = (volatile LAS int*)(F.lds + MISC_OFF + 64);
    unsigned* head = F_ctl + CW_QUEUE + 64 * l;
    for (;;) {
        __syncthreads();
        if (F.tid == 0) *slot = (int)atomicAdd(head, 1u);
        __syncthreads();
        int q = *slot; q = __builtin_amdgcn_readfirstlane(q);
        if (q >= total) break;
        Frame U = F0;
        U.ws = opaque_ptr(F0.ws); U.out = opaque_ptr(F0.out); asm volatile("" : "+v"(U.tid)); U.lane = U.tid & 63;
        const Frame& F = U;
        AttnUnit u;
        if (q < nC) { lru_unit(F, l, q >> 4, (q >> 1) & 7, q & 1); continue; }
        q -= nC;
        if (q < nD) { gla_unit(F, l, q >> 4, (q >> 1) & 7, q & 1); continue; }
        q -= nD;
        if (q < nBl) { u.isA = false; u.isc = false; u.b = q >> 7; u.h = (q >> 4) & 7; u.qt = q & 15; attn_unit<false>(F, l, u); continue; }
        q -= nBl;
        if (q < nBc) { u.isA = false; u.isc = true; u.b = q >> 4; u.h = (q >> 1) & 7; u.qt = q & 1; attn_unit<false>(F, l, u); continue; }
        q -= nBc;
        if (q < nAl) { u.isA = true; u.isc = false; u.b = q >> 6; u.h = (q >> 5) & 1; u.qt = q & 31; attn_unit<true>(F, l, u); continue; }
        q -= nAl;
        { u.isA = true; u.isc = true; u.b = q >> 3; u.h = (q >> 2) & 1; u.qt = q & 3; attn_unit<true>(F, l, u); }
    }
}
__device__ __forceinline__ void zero_o_cols(const Frame& F, int c0, int c1) {
    const int w8 = (c1 - c0) / 8; const size_t gt = (size_t)F.vcu * NTHR + F.tid, NGT = (size_t)F.G * NTHR;
    unsigned z = 0u; asm volatile("" : "+v"(z));
    for (size_t i = gt; i < (size_t)NTOK * w8; i += NGT) { const size_t row = i / w8, c = i % w8; *(u32x4*)(F_O + row * 4096 + c0 + c * 8) = (u32x4){z, z, z, z}; }
}

constexpr int PH_P0 = 0, PH_PER_LAYER = 10, PH_FINAL = 1 + DEPTH * PH_PER_LAYER, N_PHASES = PH_FINAL + 1;
enum { L_NORM1 = 0, L_INPROJ, L_PREP, L_MIX, L_GATE, L_MERGE, L_OUT, L_NORM2, L_MOE1, L_MOE2 };
__global__ void __launch_bounds__(NTHR, 2) trunk_fwd(Args args) {
    extern __shared__ __attribute__((aligned(16))) unsigned char lds_raw[];
    Frame F;
    F.lds = (LAS unsigned char*)lds_raw;
    F.tid = threadIdx.x; F.lane = F.tid & 63; F.wave = __builtin_amdgcn_readfirstlane(F.tid >> 6);
    F.G = gridDim.x; { const int bx = blockIdx.x; F.vcu = (F.G % 8 == 0) ? (bx % 8) * (F.G / 8) + bx / 8 : bx; }
    F.a = &args; F.ws = args.ws; F.out = args.out;
    volatile LAS unsigned* MISC = (volatile LAS unsigned*)(F.lds + MISC_OFF);
    if (F.tid < 32) MISC[F.tid] = 0u;
    __syncthreads();
    const int lo = args.ph_lo, hi = args.ph_hi;
    XcdBarrier bar; bar.bar = F_ctl + CW_BAR; bar.x = 0; bar.st = nullptr;
    if (hi - lo > 1) bar = xcd_barrier_post(F_ctl + CW_BAR, MISC + 8);
#define IN(k) (lo <= (k) && (k) < hi)
#define SEAM(k) do { if (IN(k) && IN((k) + 1)) xcd_barrier(bar); } while (0)

    if (IN(PH_P0)) { { const Frame P = phase_frame(F); p0_mod(P); } { const Frame P = phase_frame(F); p0_weights(P); }
#if !ENABLE_MIX
        { const Frame P = phase_frame(F); p0_copy_x(P); }
#endif
    }
    SEAM(PH_P0);
    for (int l = 0; l < DEPTH; ++l) {
        const int base = 1 + l * PH_PER_LAYER;
        const int pm0 = (l == DEPTH - 1) ? 8 : 0;
        if (IN(base + L_NORM1)) { const Frame P = phase_frame(F); norm_phase<1>(P, l); }
        SEAM(base + L_NORM1);
#if ENABLE_MIX
        if (IN(base + L_INPROJ)) { const Frame Fo = F; const Frame F = phase_frame(Fo);
            PolDenseBf16 S; S.K = D; S.lda = D * 2; S.ldb = D * 2; S.A = (const char*)F_H; S.B = (const char*)(F_WIN + (size_t)l * INW * D); S.C = F_P1; S.ldc = N1; S.nM = 72; S.nN = 46; S.pm0 = 0; S.G = F.G; S.c = (int)blockIdx.x;
            g8::gemm_phase(F.lds, S, F.tid);
        }
        SEAM(base + L_INPROJ);
        if (IN(base + L_PREP)) { const Frame P = phase_frame(F); prep_phase(P, l); if (!ENABLE_C) zero_o_cols(P, 2048, 3072); if (!ENABLE_D) zero_o_cols(P, 3072, 4096); }
        SEAM(base + L_PREP);
        if (IN(base + L_MIX)) { const Frame P = phase_frame(F); mix_phase(P, l); }
        SEAM(base + L_MIX);
        if (IN(base + L_GATE)) { const Frame Fo = F; const Frame F = phase_frame(Fo);
            if (ENABLE_D) gla_finish(F, l);
            if (ENABLE_C) lru_finish(F, l);
            if (hi - lo > 1) xcd_barrier(bar);
            PolDenseBf16 S; S.K = D; S.lda = D * 2; S.ldb = D * 2; S.A = (const char*)F_H; S.B = (const char*)(F_WIN + ((size_t)l * INW + N1) * D); S.C = F_P1; S.ldc = NG; S.nM = 72 - pm0; S.nN = 32; S.pm0 = pm0; S.G = F.G; S.c = (int)blockIdx.x;
            g8::gemm_phase(F.lds, S, F.tid);
        }
        SEAM(base + L_GATE);
        if (IN(base + L_MERGE)) { const Frame Fo = F; const Frame F = phase_frame(Fo);
            PolMerge S; S.K = 1024; S.lda = 4096 * 2; S.ldb = 1024 * 2; S.A = (const char*)F_O; S.B = (const char*)(F_WBR + (size_t)l * 4 * D * 1024); S.Gt = F_P1; S.Yo = F_Y; S.nM = 64; S.pm0 = 8; S.G = F.G; S.c = (int)blockIdx.x;
            g8::gemm_phase(F.lds, S, F.tid);
        }
        SEAM(base + L_MERGE);
        if (IN(base + L_OUT)) {
            const bool split = (l < DEPTH - 1) && (F.G > 64);
            if (split && (int)blockIdx.x < 64) { const Frame Fo = F; const Frame F = phase_frame(Fo);
                PolMerge S; S.K = 1024; S.lda = 4096 * 2; S.ldb = 1024 * 2; S.A = (const char*)F_O; S.B = (const char*)(F_WBR + (size_t)l * 4 * D * 1024); S.Gt = F_P1; S.Yo = F_Y; S.nM = 8; S.pm0 = 0; S.G = 64; S.c = (int)blockIdx.x;
                g8::gemm_phase(F.lds, S, F.tid);
            } else { const Frame Fo = F; const Frame F = phase_frame(Fo);
                PolOut S; S.K = D; S.lda = D * 2; S.ldb = D * 2; S.A = (const char*)F_Y; S.B = (const char*)(F_WOUT + (size_t)l * D * D);
                S.xin_c = (l == 0) ? F_ctx : F_XC; S.xin_l = (l == 0) ? F_x : F.out; S.xout_c = F_XC; S.xout_l = F.out; S.mod_l = F_MOD + (size_t)l * 9 * 6 * D; S.nM = 64; S.pm0 = 8;
                S.G = split ? F.G - 64 : F.G; S.c = split ? (int)blockIdx.x - 64 : (int)blockIdx.x;
                g8::gemm_phase(F.lds, S, F.tid);
            }
            if (split) {
                if (hi - lo > 1) xcd_barrier(bar);
                const Frame Fo = F; const Frame F = phase_frame(Fo);
                PolOut S; S.K = D; S.lda = D * 2; S.ldb = D * 2; S.A = (const char*)F_Y; S.B = (const char*)(F_WOUT + (size_t)l * D * D);
                S.xin_c = (l == 0) ? F_ctx : F_XC; S.xin_l = (l == 0) ? F_x : F.out; S.xout_c = F_XC; S.xout_l = F.out; S.mod_l = F_MOD + (size_t)l * 9 * 6 * D; S.nM = 8; S.pm0 = 0; S.G = F.G; S.c = (int)blockIdx.x;
                g8::gemm_phase(F.lds, S, F.tid);
            }
        }
        SEAM(base + L_OUT);
#endif
        if (IN(base + L_NORM2)) { const Frame P = phase_frame(F); norm2_phase(P, l); }
        SEAM(base + L_NORM2);
        if (IN(base + L_MOE1)) { const Frame Fo = F; const Frame F = phase_frame(Fo);
            PolMoe<1> S; S.K = D; S.lda = D * 2; S.ldb = D * 2; S.A = (const char*)F_H; S.Bw = (const char*)(F_WGU + (size_t)l * NEXP * 1024 * D); S.C = (bf16_t*)(F.ws + WS_DSCR); S.list = F_LIST; S.nN = 4; S.G = F.G; S.c = (int)blockIdx.x; S.tab = (LAS int*)(F.lds + 131072); S.tid = F.tid;
            S.init(F_ctl + CW_CNT + 64 * l);
            g8::gemm_phase(F.lds, S, F.tid);
        }
        SEAM(base + L_MOE1);
        if (IN(base + L_MOE2)) { const Frame Fo = F; const Frame F = phase_frame(Fo);
            PolMoe<2> S; S.K = DFF; S.lda = DFF * 2; S.ldb = DFF * 2; S.A = (const char*)(F.ws + WS_DSCR); S.Bw = (const char*)(F_WD + (size_t)l * NEXP * D * DFF); S.C = F_O; S.list = F_LIST; S.nN = 8; S.G = F.G; S.c = (int)blockIdx.x; S.tab = (LAS int*)(F.lds + 131072); S.tid = F.tid;
            S.init(F_ctl + CW_CNT + 64 * l);
            g8::gemm_phase(F.lds, S, F.tid);
        }
        SEAM(base + L_MOE2);
        (void)pm0;
    }
    if (IN(PH_FINAL)) { const Frame P = phase_frame(F); norm_phase<3>(P, 0); }
#undef IN
#undef SEAM
}

extern "C" void kernel_launch(void* const* d_in, const int* in_sizes, int n_in, void* d_out, int out_size, void* d_ws, size_t ws_size, hipStream_t stream) {
    static int grid = 0;
    if (grid == 0) {
        if (n_in != 32 || out_size != NLAT * D || ws_size < WS_END) { fprintf(stderr, "kernel_launch: unexpected shapes (n_in %d, out %d, ws %zu)\n", n_in, out_size, ws_size); grid = -1; return; }
        int dev = 0, cus = 0, per_cu = 0;
        if (hipGetDevice(&dev) != hipSuccess || hipDeviceGetAttribute(&cus, hipDeviceAttributeMultiprocessorCount, dev) != hipSuccess) { grid = -1; return; }
        if (hipFuncSetAttribute((const void*)trunk_fwd, hipFuncAttributeMaxDynamicSharedMemorySize, LDS_BYTES) != hipSuccess) { fprintf(stderr, "kernel_launch: hipFuncSetAttribute failed\n"); grid = -1; return; }
        if (hipOccupancyMaxActiveBlocksPerMultiprocessor(&per_cu, (const void*)trunk_fwd, NTHR, LDS_BYTES) != hipSuccess || per_cu < 1) fprintf(stderr, "kernel_launch: occupancy query says %d\n", per_cu);
        (void)hipGetLastError();
        grid = cus;
    }
    if (grid < 0) return;
    if (hipMemsetAsync((char*)d_ws + WS_CTL, 0, CTL_ZERO_BYTES, stream) != hipSuccess) return;
    Args a{};
    for (int i = 0; i < 32; ++i) a.in[i] = (const float*)d_in[i];
    a.out = (float*)d_out; a.ws = (unsigned char*)d_ws;
#if N_LAUNCH_MODE == 1
    a.ph_lo = 0; a.ph_hi = N_PHASES;
    hipLaunchKernelGGL(trunk_fwd, dim3(grid), dim3(NTHR), LDS_BYTES, stream, a);
#else
    for (int p = 0; p < N_PHASES; ++p) {
        const int pl = (p - 1) % PH_PER_LAYER;
#if !ENABLE_MIX
        if (p >= 1 && p < PH_FINAL && pl >= L_INPROJ && pl <= L_OUT) continue;
#endif
        a.ph_lo = p; a.ph_hi = p + 1;
        hipLaunchKernelGGL(trunk_fwd, dim3(grid), dim3(NTHR), LDS_BYTES, stream, a);
    }
#endif
}
```

```cpp
#include <hip/hip_runtime.h>
#include <cstdio>
#include <cstdint>

#ifndef N_LAUNCH_MODE
#define N_LAUNCH_MODE 1
#endif
#ifndef ENABLE_C
#define ENABLE_C 1
#endif
#ifndef ENABLE_D
#define ENABLE_D 1
#endif
#ifndef ENABLE_MIX
#define ENABLE_MIX 1
#endif

#define LAS __attribute__((address_space(3)))
#define GAS __attribute__((address_space(1)))
typedef unsigned short bf16_t;
typedef short bf16x8 __attribute__((ext_vector_type(8)));
typedef short bf16x4 __attribute__((ext_vector_type(4)));
typedef float f32x2 __attribute__((ext_vector_type(2)));
typedef float f32x4 __attribute__((ext_vector_type(4)));
typedef float f32x16 __attribute__((ext_vector_type(16)));
typedef unsigned u32x2 __attribute__((ext_vector_type(2)));
typedef unsigned u32x4 __attribute__((ext_vector_type(4)));

constexpr int D = 2048, NB = 8, SEQ = 2048, CTXL = 256, DEPTH = 2;
constexpr int NCTX = NB * CTXL, NLAT = NB * SEQ, NTOK = NCTX + NLAT;
constexpr int N1 = 11776, NG = 8192, INW = N1 + NG;
constexpr int NEXP = 16, DFF = 512;
constexpr int NWAVES = 8, NTHR = 512;
constexpr int C_AQ = 0, C_AK = 1024, C_AV = 1280, C_BQ = 1536, C_BK = 2560, C_BV = 3584, C_CX = 4608, C_CY = 5632, C_DQ = 6656, C_DFF = 7680, C_DFB = 8704, C_DI = 9728, C_DG = 10752;

constexpr size_t MiB = 1u << 20;
constexpr size_t WS_CTL = 0, CTL_ZERO_BYTES = 2 * MiB;
constexpr size_t WS_MOD = 1 * MiB;
constexpr size_t WS_WIN = 2 * MiB;
constexpr size_t WS_WBR = 158 * MiB;
constexpr size_t WS_WOUT = 190 * MiB;
constexpr size_t WS_WGU = 206 * MiB;
constexpr size_t WS_WD = 334 * MiB;
constexpr size_t WS_H = 398 * MiB;
constexpr size_t WS_Y = 470 * MiB;
constexpr size_t WS_P1 = 542 * MiB;
constexpr size_t WS_O = 956 * MiB;
constexpr size_t WS_XC = 1100 * MiB;
constexpr size_t WS_HID = 1116 * MiB;
constexpr size_t WS_LIST = 1152 * MiB;
constexpr size_t WS_RW = 1154 * MiB;
constexpr size_t WS_DSCR = 1156 * MiB;
constexpr size_t WS_HB = 1192 * MiB;
constexpr size_t WS_END = 1228 * MiB;
constexpr int CW_BAR = 4096;
constexpr int CW_CNT = 8192;
constexpr int CW_QUEUE = 8448;

constexpr int LDS_BYTES = 147456;
constexpr int MISC_OFF = 131072 + 8192;

typedef __bf16 bf16x2_t __attribute__((ext_vector_type(2)));
__device__ __forceinline__ unsigned cvt_pk_bf16(float lo, float hi) { const bf16x2_t r = __builtin_convertvector((f32x2){lo, hi}, bf16x2_t); return __builtin_bit_cast(unsigned, r); }
__device__ __forceinline__ float bf_lo(unsigned u) { return __uint_as_float(u << 16); }
__device__ __forceinline__ float bf_hi(unsigned u) { return __uint_as_float(u & 0xffff0000u); }
__device__ __forceinline__ float bf2f(bf16_t b) { return __uint_as_float(((unsigned)b) << 16); }
__device__ __forceinline__ float shx(float v, int mask, int lane) { return __builtin_bit_cast(float, __builtin_amdgcn_ds_bpermute((lane ^ mask) << 2, __builtin_bit_cast(int, v))); }
__device__ __forceinline__ float wave_sum(float v, int lane) {
#pragma unroll
    for (int o = 1; o < 64; o <<= 1) v += shx(v, o, lane);
    return v;
}
__device__ __forceinline__ float wave_max(float v, int lane) {
#pragma unroll
    for (int o = 1; o < 64; o <<= 1) v = fmaxf(v, shx(v, o, lane));
    return v;
}
__device__ __forceinline__ float sigmoidf_(float x) { return __builtin_amdgcn_rcpf(1.0f + __expf(-x)); }
#define LDS_WAIT() asm volatile("s_waitcnt lgkmcnt(0)" ::: "memory")
#define VM_WAIT() asm volatile("s_waitcnt vmcnt(0)" ::: "memory")

__device__ __forceinline__ int opaque_int(int x);
template <class T> __device__ __forceinline__ T* opaque_ptr(T* p) { return (T*)((unsigned char*)p + opaque_int(0)); }
__device__ __forceinline__ int opaque_int(int x) { asm volatile("" : "+v"(x)); return __builtin_amdgcn_readfirstlane(x); }
#define XB_TMO      128
#define XB_XCNT(j)  (256  + 64 * (j))
#define XB_XSUB(j)  (1280 + 64 * (j))
#define XB_XGEN(j)  (2304 + 64 * (j))
#define XB_TOP      3328
#define XB_TOPGEN   3392
#define XCD_BAR_WORDS 3456
#define XB_SPIN_CAP (1u << 22)
__device__ __forceinline__ unsigned xb_ld(unsigned* p)              { return __hip_atomic_load(p, __ATOMIC_RELAXED, __HIP_MEMORY_SCOPE_AGENT); }
__device__ __forceinline__ unsigned xb_add(unsigned* p, unsigned v) { return __hip_atomic_fetch_add(p, v, __ATOMIC_RELAXED, __HIP_MEMORY_SCOPE_AGENT); }
__device__ __forceinline__ unsigned xb_xcc_id() { return (unsigned)__builtin_amdgcn_s_getreg((3 << 11) | 20) & 0xFu; }
#define XB_SPIN(cond, bar) do { unsigned _sp = 0; while (cond) { __builtin_amdgcn_s_sleep(1); \
    if ((++_sp & 255u) == 0u) { if (xb_ld(&(bar)[XB_TMO])) break; if (_sp > XB_SPIN_CAP) { atomicAdd(&(bar)[XB_TMO], 1u); break; } } } } while (0)
struct XcdBarrier { unsigned* bar; unsigned x; volatile LAS unsigned* st; };
__device__ __forceinline__ XcdBarrier xcd_barrier_post(unsigned* bar, volatile LAS unsigned* st) {
    XcdBarrier b; b.bar = bar; b.x = xb_xcc_id(); b.st = st;
    if (threadIdx.x == 0) (void)xb_add(&bar[XB_XCNT(b.x)], 1u);
    return b;
}
__device__ __forceinline__ void xcd_barrier_complete(unsigned* bar, unsigned x, unsigned& nloc, unsigned& nx) {
    const unsigned G = gridDim.x * gridDim.y * gridDim.z;
    unsigned sum, cnt, mine, sp = 0u;
    for (;;) {
        sum = 0u; cnt = 0u; mine = 0u;
#pragma unroll
        for (unsigned j = 0; j < 16; ++j) { const unsigned c = xb_ld(&bar[XB_XCNT(j)]); sum += c; cnt += (c > 0u) ? 1u : 0u; mine = (j == x) ? c : mine; }
        if (sum == G) break;
        __builtin_amdgcn_s_sleep(1);
        if ((++sp & 255u) == 0u) { if (xb_ld(&bar[XB_TMO])) break; if (sp > XB_SPIN_CAP) { atomicAdd(&bar[XB_TMO], 1u); break; } }
    }
    nloc = mine > 0u ? mine : 1u; nx = cnt > 0u ? cnt : 1u;
}
__device__ __forceinline__ void xcd_barrier(const XcdBarrier& b) {
    asm volatile("s_waitcnt vmcnt(0)" ::: "memory");
    __syncthreads();
    if (threadIdx.x == 0) {
        unsigned* bar = opaque_ptr(b.bar);
        __builtin_amdgcn_s_waitcnt(0);
        unsigned nloc = b.st[0], nx = b.st[1];
        if (nloc == 0u) { xcd_barrier_complete(bar, b.x, nloc, nx); b.st[0] = nloc; b.st[1] = nx; }
        const unsigned old = xb_add(&bar[XB_XSUB(b.x)], 1u);
        const unsigned gen = old / nloc;
        if (old + 1u == (gen + 1u) * nloc) {
            __builtin_amdgcn_fence(__ATOMIC_RELEASE, "agent");
            asm volatile("s_waitcnt vmcnt(0)" ::: "memory");
            const unsigned og = xb_add(&bar[XB_TOP], 1u);
            const unsigned tg = og / nx;
            if (og + 1u == (tg + 1u) * nx) xb_add(&bar[XB_TOPGEN], 1u);
            else XB_SPIN(xb_ld(&bar[XB_TOPGEN]) == tg, bar);
            __builtin_amdgcn_fence(__ATOMIC_ACQUIRE, "agent");
            xb_add(&bar[XB_XGEN(b.x)], 1u);
            asm volatile("s_waitcnt vmcnt(0)" ::: "memory");
        } else {
            XB_SPIN(xb_ld(&bar[XB_XGEN(b.x)]) == gen, bar);
            __builtin_amdgcn_fence(__ATOMIC_ACQUIRE, "agent");
            asm volatile("s_waitcnt vmcnt(0)" ::: "memory");
        }
    }
    __syncthreads();
}

struct Args { const float* in[32]; float* out; unsigned char* ws; int ph_lo, ph_hi; };
struct Frame {
    LAS unsigned char* lds;
    const Args* a;
    unsigned char* ws; float* out;
    int tid, lane, wave, G, vcu;
};
#define FIN(k) (F.a->in[k])
#define F_x FIN(0)
#define F_c FIN(1)
#define F_ctx FIN(2)
#define F_cctx FIN(3)
#define F_w_ada FIN(4)
#define F_b_ada FIN(5)
#define F_norm1_g FIN(6)
#define F_norm2_g FIN(7)
#define F_w_in FIN(8)
#define F_qn_a FIN(9)
#define F_kn_a FIN(10)
#define F_sink_a FIN(11)
#define F_qn_b FIN(12)
#define F_kn_b FIN(13)
#define F_lam_b FIN(14)
#define F_subln_b FIN(15)
#define F_conv_w FIN(16)
#define F_conv_b FIN(17)
#define F_w_rg FIN(18)
#define F_b_rg FIN(19)
#define F_w_ig FIN(20)
#define F_b_ig FIN(21)
#define F_lru_lambda FIN(22)
#define F_lb_d FIN(23)
#define F_onorm_d FIN(24)
#define F_w_branch FIN(25)
#define F_w_out FIN(26)
#define F_w_router FIN(27)
#define F_b_router FIN(28)
#define F_w_gate FIN(29)
#define F_w_up FIN(30)
#define F_w_down FIN(31)
#define F_ctl ((unsigned*)(F.ws + WS_CTL))
#define F_MOD ((float*)(F.ws + WS_MOD))
#define F_WIN ((bf16_t*)(F.ws + WS_WIN))
#define F_WBR ((bf16_t*)(F.ws + WS_WBR))
#define F_WOUT ((bf16_t*)(F.ws + WS_WOUT))
#define F_WGU ((bf16_t*)(F.ws + WS_WGU))
#define F_WD ((bf16_t*)(F.ws + WS_WD))
#define F_H ((bf16_t*)(F.ws + WS_H))
#define F_Y ((bf16_t*)(F.ws + WS_Y))
#define F_P1 ((bf16_t*)(F.ws + WS_P1))
#define F_O ((bf16_t*)(F.ws + WS_O))
#define F_HID ((bf16_t*)(F.ws + WS_HID))
#define F_XC ((float*)(F.ws + WS_XC))
#define F_LIST ((unsigned*)(F.ws + WS_LIST))
#define F_RW ((float*)(F.ws + WS_RW))
__device__ __forceinline__ Frame phase_frame(const Frame& F) {
    Frame P = F;
    P.ws = opaque_ptr(F.ws); P.out = opaque_ptr(F.out);
    P.wave = opaque_int(F.wave); P.G = opaque_int(F.G); P.vcu = opaque_int(F.vcu);
    unsigned ln; asm volatile("v_mbcnt_lo_u32_b32 %0, -1, 0\n\tv_mbcnt_hi_u32_b32 %0, -1, %0" : "=v"(ln));
    P.lane = (int)ln; P.tid = P.wave * 64 + (int)ln;
    return P;
}
__device__ __forceinline__ int mod_index(int row) { return row < NCTX ? 8 : ((row - NCTX) >> 11); }
__device__ __forceinline__ float* xrow_ptr(const Frame& F, int row) { return row < NCTX ? F_XC + (size_t)row * D : F.out + (size_t)(row - NCTX) * D; }
__device__ __forceinline__ const float* xin_ptr(const Frame& F, int row) { return row < NCTX ? F_ctx + (size_t)row * D : F_x + (size_t)(row - NCTX) * D; }

__device__ __forceinline__ void p0_mod(const Frame& F) {
    LAS float* sl = (LAS float*)F.lds;
    LAS float* part = (LAS float*)(F.lds + 9 * D * 4);
    for (int idx = F.tid; idx < 9 * D; idx += NTHR) { const int i = idx >> 11, k = idx & (D - 1); const float v = (i < 8) ? F_c[i * D + k] : F_cctx[k]; sl[idx] = v / (1.0f + __expf(-v)); }
    __syncthreads();
    for (int it = F.vcu; it < DEPTH * 96; it += F.G) {
        const int l = it / 96, jb = it % 96;
        const float* w = F_w_ada + ((size_t)l * D + F.wave * 256) * (6 * D) + jb * 128 + F.lane * 2;
        f32x2 acc[9];
#pragma unroll
        for (int i = 0; i < 9; ++i) acc[i] = (f32x2){0.f, 0.f};
#pragma unroll 8
        for (int k = 0; k < 256; ++k) {
            const f32x2 wv = *(const f32x2*)(w + (size_t)k * (6 * D));
#pragma unroll
            for (int i = 0; i < 9; ++i) acc[i] += sl[i * D + F.wave * 256 + k] * wv;
        }
#pragma unroll
        for (int i = 0; i < 9; ++i) *(LAS f32x2*)(part + (F.wave * 9 + i) * 128 + F.lane * 2) = acc[i];
        __syncthreads();
        for (int idx = F.tid; idx < 9 * 128; idx += NTHR) { const int i = idx >> 7, cidx = idx & 127; float sum = F_b_ada[(size_t)l * 6 * D + jb * 128 + cidx];
#pragma unroll
            for (int wv = 0; wv < 8; ++wv) sum += part[(wv * 9 + i) * 128 + cidx];
            F_MOD[((size_t)(l * 9 + i)) * (6 * D) + jb * 128 + cidx] = sum; }
        __syncthreads();
    }
    __syncthreads();
}
__device__ __forceinline__ void tr_item(const float* W, int ldw, int k0, int n0, bf16_t* dst, int ldd, LAS float* scr, int lane) {
    float tv[32];
#pragma unroll
    for (int i = 0; i < 32; ++i) { const int kk = 2 * i + (lane >> 5); tv[i] = W[(size_t)(k0 + kk) * ldw + n0 + (lane & 31)]; }
#pragma unroll
    for (int i = 0; i < 32; ++i) { const int kk = 2 * i + (lane >> 5); scr[kk * 33 + (lane & 31)] = tv[i]; }
    LDS_WAIT(); asm volatile("" ::: "memory");
    const int c = lane & 7;
#pragma unroll
    for (int j = 0; j < 4; ++j) { const int n = (lane >> 3) + 8 * j; const LAS float* s = scr + (8 * c) * 33 + n;
        u32x4 o; o.x = cvt_pk_bf16(s[0 * 33], s[1 * 33]); o.y = cvt_pk_bf16(s[2 * 33], s[3 * 33]); o.z = cvt_pk_bf16(s[4 * 33], s[5 * 33]); o.w = cvt_pk_bf16(s[6 * 33], s[7 * 33]);
        *(u32x4*)(dst + (size_t)n * ldd + k0 + 8 * c) = o; }
    LDS_WAIT(); asm volatile("" ::: "memory");
}
__device__ __forceinline__ void p0_weights(const Frame& F) {
    LAS float* scr = (LAS float*)(F.lds + F.wave * 8704);
    const int gw = F.vcu * NWAVES + F.wave, NGW = F.G * NWAVES;
    constexpr int I_IN = 32 * 624, I_BR = 16 * 64, I_OUT = 32 * 64, I_G = 32 * 16, I_D = 8 * 64;
    constexpr int S0 = DEPTH * I_IN, S1 = S0 + DEPTH * 4 * I_BR, S2 = S1 + DEPTH * I_OUT, S3 = S2 + DEPTH * NEXP * I_G, S4 = S3 + DEPTH * NEXP * I_G, S5 = S4 + DEPTH * NEXP * I_D;
    for (int it = gw; it < S5; it += NGW) {
        if (it < S0) { const int l = it / I_IN, r = it % I_IN, kb = r / 624, nb = r % 624;
            tr_item(F_w_in + (size_t)l * D * INW, INW, kb * 64, nb * 32, F_WIN + ((size_t)l * INW + nb * 32) * D, D, scr, F.lane); }
        else if (it < S1) { const int q = it - S0, m = q / I_BR, r = q % I_BR, kb = r / 64, nb = r % 64;
            tr_item(F_w_branch + (size_t)m * 1024 * D, D, kb * 64, nb * 32, F_WBR + ((size_t)m * D + nb * 32) * 1024, 1024, scr, F.lane); }
        else if (it < S2) { const int q = it - S1, l = q / I_OUT, r = q % I_OUT, kb = r / 64, nb = r % 64;
            tr_item(F_w_out + (size_t)l * D * D, D, kb * 64, nb * 32, F_WOUT + ((size_t)l * D + nb * 32) * D, D, scr, F.lane); }
        else if (it < S4) { const bool up = it >= S3; const int q = it - (up ? S3 : S2), m = q / I_G, r = q % I_G, kb = r / 16, nb = r % 16;
            const int n0 = nb * 32, drow = 256 * (n0 >> 7) + (n0 & 127) + (up ? 128 : 0);
            tr_item((up ? F_w_up : F_w_gate) + (size_t)m * D * DFF, DFF, kb * 64, n0, F_WGU + ((size_t)m * 1024 + drow) * D, D, scr, F.lane); }
        else { const int q = it - S4, m = q / I_D, r = q % I_D, kb = r / 64, nb = r % 64;
            tr_item(F_w_down + (size_t)m * DFF * D, D, kb * 64, nb * 32, F_WD + ((size_t)m * D + nb * 32) * DFF, DFF, scr, F.lane); }
    }
    __syncthreads();
}
__device__ __forceinline__ void p0_copy_x(const Frame& F) {
    const size_t gt = (size_t)F.vcu * NTHR + F.tid, NGT = (size_t)F.G * NTHR;
    for (size_t i = gt; i < (size_t)NTOK * D / 4; i += NGT) { const int row = (int)(i / (D / 4)); const int c4 = (int)(i % (D / 4));
        *((f32x4*)xrow_ptr(F, row) + c4) = *((const f32x4*)xin_ptr(F, row) + c4); }
}

template <int WHICH>
__device__ __forceinline__ void norm_phase(const Frame& F, int l) {
    const int gw = F.vcu * NWAVES + F.wave, NGW = F.G * NWAVES, lane = F.lane;
    LAS float* wrT = (LAS float*)F.lds;
    if (WHICH == 2) {
        for (int idx = F.tid; idx < D * NEXP; idx += NTHR) { const int e = idx >> 11, col = idx & (D - 1); wrT[idx] = F_w_router[col * NEXP + e]; }
        if (F.tid < 16) ((LAS unsigned*)(F.lds + 131072))[F.tid] = 0u;
        __syncthreads();
    }
    LAS unsigned* lcnt = (LAS unsigned*)(F.lds + 131072); LAS unsigned* lbase = lcnt + 16; LAS int* lrec = (LAS int*)(F.lds + 131072 + 256);
    int nrec = 0;
    const int row_lo = (WHICH == 3 || (WHICH == 2 && l == DEPTH - 1)) ? NCTX : 0;
    const bf16_t* Y2 = F_O;
    for (int row = row_lo + gw; row < NTOK; row += NGW) {
        const int mi = mod_index(row);
        f32x4 v[8];
        float* xr = xrow_ptr(F, row);
        if (WHICH == 1 && l == 0) { const float* xi = xin_ptr(F, row);
#pragma unroll
            for (int j = 0; j < 8; ++j) v[j] = *(const f32x4*)(xi + 4 * lane + 256 * j);
        } else {
#pragma unroll
            for (int j = 0; j < 8; ++j) v[j] = *(const f32x4*)(xr + 4 * lane + 256 * j);
        }
        if ((WHICH == 1 && l > 0) || WHICH == 3) {
            const int lp = (WHICH == 3) ? DEPTH - 1 : l - 1;
            const float* g2 = F_MOD + ((size_t)(lp * 9 + mi)) * (6 * D) + 5 * D;
            const f32x2 rw = *(const f32x2*)(F_RW + 2 * (size_t)row);
            const bf16_t* ya = Y2 + (size_t)(2 * row) * D; const bf16_t* yb = ya + D;
#pragma unroll
            for (int j = 0; j < 8; ++j) { const int col = 4 * lane + 256 * j; const f32x4 g = *(const f32x4*)(g2 + col);
                const u32x2 a = *(const u32x2*)(ya + col), b = *(const u32x2*)(yb + col);
                v[j].x += g.x * (rw.x * bf_lo(a.x) + rw.y * bf_lo(b.x)); v[j].y += g.y * (rw.x * bf_hi(a.x) + rw.y * bf_hi(b.x));
                v[j].z += g.z * (rw.x * bf_lo(a.y) + rw.y * bf_lo(b.y)); v[j].w += g.w * (rw.x * bf_hi(a.y) + rw.y * bf_hi(b.y));
                *(f32x4*)(xr + col) = v[j]; }
        }
        if (WHICH == 3) continue;
        float ss = 0.f;
#pragma unroll
        for (int j = 0; j < 8; ++j) ss += (v[j].x * v[j].x + v[j].y * v[j].y) + (v[j].z * v[j].z + v[j].w * v[j].w);
        const float rinv = rsqrtf(wave_sum(ss, lane) * (1.0f / D) + 1e-6f);
        const float* gn = (WHICH == 1 ? F_norm1_g : F_norm2_g) + (size_t)l * D;
        const float* md = F_MOD + ((size_t)(l * 9 + mi)) * (6 * D) + (WHICH == 1 ? 0 : 3) * D;
        bf16_t* hr = F_H + (size_t)row * D;
#pragma unroll
        for (int j = 0; j < 8; ++j) { const int col = 4 * lane + 256 * j; const f32x4 g = *(const f32x4*)(gn + col), sh = *(const f32x4*)(md + col), sc = *(const f32x4*)(md + D + col);
            v[j].x = v[j].x * rinv * g.x * (1.0f + sc.x) + sh.x; v[j].y = v[j].y * rinv * g.y * (1.0f + sc.y) + sh.y;
            v[j].z = v[j].z * rinv * g.z * (1.0f + sc.z) + sh.z; v[j].w = v[j].w * rinv * g.w * (1.0f + sc.w) + sh.w;
            u32x2 o; o.x = cvt_pk_bf16(v[j].x, v[j].y); o.y = cvt_pk_bf16(v[j].z, v[j].w); *(u32x2*)(hr + col) = o; }
        if (WHICH == 2) {
            float lg[NEXP];
#pragma unroll
            for (int e = 0; e < NEXP; ++e) { float a = 0.f;
#pragma unroll
                for (int j = 0; j < 8; ++j) { const f32x4 w = *(const LAS f32x4*)(wrT + e * D + 4 * lane + 256 * j); a += (v[j].x * w.x + v[j].y * w.y) + (v[j].z * w.z + v[j].w * w.w); }
                lg[e] = wave_sum(a, lane); }
            float aff[NEXP], sel[NEXP];
#pragma unroll
            for (int e = 0; e < NEXP; ++e) { aff[e] = 1.0f / (1.0f + expf(-lg[e])); sel[e] = aff[e] + F_b_router[e]; }
            int grp = 0; float best = -1e30f;
#pragma unroll
            for (int g = 0; g < 4; ++g) { float m1 = -1e30f, m2 = -1e30f;
#pragma unroll
                for (int q = 0; q < 4; ++q) { const float s = sel[4 * g + q]; if (s > m1) { m2 = m1; m1 = s; } else if (s > m2) m2 = s; }
                const float gs = m1 + m2; if (gs > best) { best = gs; grp = g; } }
            int i0 = 0, i1 = 0; float s0 = -1e30f, s1 = -1e30f, a0 = 0.f, a1 = 0.f;
#pragma unroll
            for (int g = 0; g < 4; ++g)
#pragma unroll
                for (int q = 0; q < 4; ++q) { const float s = sel[4 * g + q], a = aff[4 * g + q]; const bool in = (g == grp);
                    if (in && s > s0) { s1 = s0; i1 = i0; a1 = a0; s0 = s; i0 = 4 * g + q; a0 = a; } else if (in && s > s1) { s1 = s; i1 = 4 * g + q; a1 = a; } }
            if (lane == 0) {
                const float inv = 1.0f / (a0 + a1);
                *(f32x2*)(F_RW + 2 * (size_t)row) = (f32x2){a0 * inv, a1 * inv};
                LAS int* rec = lrec + (F.wave * 16 + nrec) * 4;
                rec[0] = i0; rec[1] = i1; rec[2] = (int)__hip_atomic_fetch_add(lcnt + i0, 1u, __ATOMIC_RELAXED, __HIP_MEMORY_SCOPE_WORKGROUP); rec[3] = (int)__hip_atomic_fetch_add(lcnt + i1, 1u, __ATOMIC_RELAXED, __HIP_MEMORY_SCOPE_WORKGROUP);
            }
            ++nrec;
        }
    }
    if (WHICH == 2) {
        __syncthreads();
        if (F.tid < 16) lbase[F.tid] = atomicAdd(F_ctl + CW_CNT + 64 * l + F.tid, lcnt[F.tid]);
        __syncthreads();
        if (lane < nrec) { const int row = row_lo + gw + lane * NGW; const LAS int* rec = lrec + (F.wave * 16 + lane) * 4; const int i0 = rec[0], i1 = rec[1];
            F_LIST[(size_t)i0 * NTOK + lbase[i0] + rec[2]] = 2u * row; F_LIST[(size_t)i1 * NTOK + lbase[i1] + rec[3]] = 2u * row + 1u; }
        __syncthreads();
    }
}

__device__ __forceinline__ constexpr int bitrev5(int v) { return ((v & 1) << 4) | ((v & 2) << 2) | (v & 4) | ((v & 8) >> 2) | ((v & 16) >> 4); }
__device__ __forceinline__ void norm2_phase(const Frame& F, int l) {
    const int gw = F.vcu * NWAVES + F.wave, NGW = F.G * NWAVES, lane = F.lane;
    LAS float* wrT = (LAS float*)F.lds;
    for (int idx = F.tid; idx < D * NEXP; idx += NTHR) { const int e = idx >> 11, col = idx & (D - 1); wrT[idx] = F_w_router[col * NEXP + e]; }
    LAS unsigned* lcnt = (LAS unsigned*)(F.lds + 131072); LAS unsigned* lbase = lcnt + 16; LAS int* lrec = (LAS int*)(F.lds + 131072 + 256);
    if (F.tid < 16) lcnt[F.tid] = 0u;
    int nrec = 0;
    __syncthreads();
    const int row_lo = (l == DEPTH - 1) ? NCTX : 0;
    float brt[NEXP];
#pragma unroll
    for (int e = 0; e < NEXP; ++e) brt[e] = F_b_router[e];
    for (int row0 = row_lo + 2 * gw; row0 < NTOK; row0 += 2 * NGW) {
        const int mi = mod_index(row0);
        f32x4 v[2][8];
#pragma unroll
        for (int r = 0; r < 2; ++r) { const float* xr = xrow_ptr(F, row0 + r);
#pragma unroll
            for (int j = 0; j < 8; ++j) v[r][j] = *(const f32x4*)(xr + 4 * lane + 256 * j); }
        float ss0 = 0.f, ss1 = 0.f;
#pragma unroll
        for (int j = 0; j < 8; ++j) { ss0 += (v[0][j].x * v[0][j].x + v[0][j].y * v[0][j].y) + (v[0][j].z * v[0][j].z + v[0][j].w * v[0][j].w); ss1 += (v[1][j].x * v[1][j].x + v[1][j].y * v[1][j].y) + (v[1][j].z * v[1][j].z + v[1][j].w * v[1][j].w); }
        const float rinv[2] = {rsqrtf(wave_sum(ss0, lane) * (1.0f / D) + 1e-6f), rsqrtf(wave_sum(ss1, lane) * (1.0f / D) + 1e-6f)};
        const float* gn = F_norm2_g + (size_t)l * D;
        const float* md = F_MOD + ((size_t)(l * 9 + mi)) * (6 * D) + 3 * D;
#pragma unroll
        for (int j = 0; j < 8; ++j) { const int col = 4 * lane + 256 * j; const f32x4 g = *(const f32x4*)(gn + col), sh = *(const f32x4*)(md + col), sc = *(const f32x4*)(md + D + col);
#pragma unroll
            for (int r = 0; r < 2; ++r) { f32x4& q = v[r][j];
                q.x = q.x * rinv[r] * g.x * (1.0f + sc.x) + sh.x; q.y = q.y * rinv[r] * g.y * (1.0f + sc.y) + sh.y; q.z = q.z * rinv[r] * g.z * (1.0f + sc.z) + sh.z; q.w = q.w * rinv[r] * g.w * (1.0f + sc.w) + sh.w;
                u32x2 o; o.x = cvt_pk_bf16(q.x, q.y); o.y = cvt_pk_bf16(q.z, q.w); *(u32x2*)(F_H + (size_t)(row0 + r) * D + col) = o; } }
        float x[32];
#pragma unroll
        for (int e = 0; e < NEXP; ++e) { float a0 = 0.f, a1 = 0.f;
#pragma unroll
            for (int j = 0; j < 8; ++j) { const f32x4 w = *(const LAS f32x4*)(wrT + e * D + 4 * lane + 256 * j);
                a0 += (v[0][j].x * w.x + v[0][j].y * w.y) + (v[0][j].z * w.z + v[0][j].w * w.w); a1 += (v[1][j].x * w.x + v[1][j].y * w.y) + (v[1][j].z * w.z + v[1][j].w * w.w); }
            x[e] = a0; x[16 + e] = a1; }
#pragma unroll
        for (int k = 0; k < 5; ++k) { const int half = 16 >> k; const bool bit = (lane >> k) & 1;
#pragma unroll
            for (int i = 0; i < half; ++i) { const float send = bit ? x[i] : x[i + half], keep = bit ? x[i + half] : x[i]; x[i] = keep + shx(send, 1 << k, lane); } }
        const float tot = x[0] + shx(x[0], 32, lane);
        const float affv = 1.0f / (1.0f + expf(-tot));
#pragma unroll
        for (int r = 0; r < 2; ++r) {
            float aff[NEXP], sel[NEXP];
#pragma unroll
            for (int e = 0; e < NEXP; ++e) { aff[e] = __builtin_bit_cast(float, __builtin_amdgcn_readlane(__builtin_bit_cast(int, affv), bitrev5(r * 16 + e))); sel[e] = aff[e] + brt[e]; }
            int grp = 0; float best = -1e30f;
#pragma unroll
            for (int g = 0; g < 4; ++g) { float m1 = -1e30f, m2 = -1e30f;
#pragma unroll
                for (int q = 0; q < 4; ++q) { const float s = sel[4 * g + q]; if (s > m1) { m2 = m1; m1 = s; } else if (s > m2) m2 = s; }
                const float gs = m1 + m2; if (gs > best) { best = gs; grp = g; } }
            int i0 = 0, i1 = 0; float s0 = -1e30f, s1 = -1e30f, a0 = 0.f, a1 = 0.f;
#pragma unroll
            for (int g = 0; g < 4; ++g)
#pragma unroll
                for (int q = 0; q < 4; ++q) { const float s = sel[4 * g + q], a = aff[4 * g + q]; const bool in = (g == grp);
                    if (in && s > s0) { s1 = s0; i1 = i0; a1 = a0; s0 = s; i0 = 4 * g + q; a0 = a; } else if (in && s > s1) { s1 = s; i1 = 4 * g + q; a1 = a; } }
            if (lane == 0) { const int row = row0 + r;
                const float inv = 1.0f / (a0 + a1);
                *(f32x2*)(F_RW + 2 * (size_t)row) = (f32x2){a0 * inv, a1 * inv};
                LAS int* rec = lrec + (F.wave * 16 + nrec) * 4;
                rec[0] = i0; rec[1] = i1; rec[2] = (int)__hip_atomic_fetch_add(lcnt + i0, 1u, __ATOMIC_RELAXED, __HIP_MEMORY_SCOPE_WORKGROUP); rec[3] = (int)__hip_atomic_fetch_add(lcnt + i1, 1u, __ATOMIC_RELAXED, __HIP_MEMORY_SCOPE_WORKGROUP); }
            ++nrec;
        }
    }
    __syncthreads();
    if (F.tid < 16) lbase[F.tid] = atomicAdd(F_ctl + CW_CNT + 64 * l + F.tid, lcnt[F.tid]);
    __syncthreads();
    if (lane < nrec) { const int row = row_lo + 2 * gw + (lane >> 1) * 2 * NGW + (lane & 1); const LAS int* rec = lrec + (F.wave * 16 + lane) * 4; const int i0 = rec[0], i1 = rec[1];
        F_LIST[(size_t)i0 * NTOK + lbase[i0] + rec[2]] = 2u * row; F_LIST[(size_t)i1 * NTOK + lbase[i1] + rec[3]] = 2u * row + 1u; }
    __syncthreads();
}

namespace g8 {
constexpr int BM = 256, BK = 64, HALF = 128, HTB = HALF * BK * 2, STAGE_BYTES = 8 * HTB;
__device__ __forceinline__ int lds_byte(int r, int c) { const int st = (r >> 4) * 2 + (c >> 5), rr = r & 15, cc = c & 31, ob = rr * 64 + cc * 2; return st * 1024 + (ob ^ (((ob >> 9) & 1) << 5)); }
__device__ __forceinline__ void stage_rc(int b, int& R, int& C) { const int st = b / 1024, sb = b % 1024, swz = sb ^ (((sb >> 9) & 1) << 5); R = (st >> 1) * 16 + swz / 64; C = (st & 1) * 32 + (swz % 64) / 2; }
__device__ __forceinline__ int perm32(int rho) { const int n = rho >> 4, i = rho & 15; return 8 * (i >> 2) + 4 * n + (i & 3); }
__device__ __forceinline__ void tile_order(int L, int nM, int nN, int& pm, int& pn) {
    const int nwg = nM * nN; int wgid = L;
    { const int q = nwg / 8, r = nwg % 8, xcd = wgid % 8, off = wgid / 8; wgid = (xcd < r ? xcd * (q + 1) : r * (q + 1) + (xcd - r) * q) + off; }
    const int nig = 8 * nN, gid = wgid / nig, fm = gid * 8, gsz = (nM - fm) < 8 ? (nM - fm) : 8;
    pm = fm + ((wgid % nig) % gsz); pn = (wgid % nig) / gsz;
}
struct GU { int pm, pn, aux, valid; const char* A; const char* B; };

template <class P>
__device__ __forceinline__ void gemm_phase(LAS unsigned char* lds, const P& S, const int tid) {
    const int wid = __builtin_amdgcn_readfirstlane(tid >> 6), lane = tid & 63, wr = wid >> 2, wc = wid & 3, fr = lane & 15, fq = lane >> 4;
    const int K = S.K, nt = K / BK;
    const unsigned lda = S.lda, ldb = S.ldb;
    int Rr[2], Cc[2]; unsigned voffB[2];
#pragma unroll
    for (int i = 0; i < 2; ++i) { stage_rc(tid * 16 + i * 8192, Rr[i], Cc[i]); const int Rb = P::PERM ? ((Rr[i] & ~31) + perm32(Rr[i] & 31)) : Rr[i]; voffB[i] = (unsigned)Rb * ldb + (unsigned)Cc[i] * 2u; }
    unsigned offA[2][2], offAn[2][2];
#pragma unroll
    for (int h = 0; h < 2; ++h)
#pragma unroll
        for (int i = 0; i < 2; ++i) { offA[h][i] = (unsigned)(h * HALF + Rr[i]) * lda + (unsigned)Cc[i] * 2u; offAn[h][i] = offA[h][i]; }
    const size_t kstep = (size_t)(BK * 2);
    const size_t hstepB = (size_t)HALF * ldb;
    const unsigned ldsw = (unsigned)wid * 1024u;
    const int aoff = lds_byte(wr * 64 + fr, fq * 8), boff = lds_byte(wc * 32 + fr, fq * 8);
#define G8_SA(b, h) (((b) * 2 + (h)) * HTB)
#define G8_SB(b, h) ((4 + (b) * 2 + (h)) * HTB)
#define G8_STAGE_A(bufoff, gbase, offs, h) do { _Pragma("unroll") for (int _i = 0; _i < 2; ++_i) \
        __builtin_amdgcn_global_load_lds((const unsigned*)((const char*)(gbase) + (offs)[h][_i]), (LAS unsigned*)(lds + (bufoff) + ldsw + _i * 8192), 16, 0, 0); } while (0)
#define G8_STAGE_B(bufoff, gbase) do { _Pragma("unroll") for (int _i = 0; _i < 2; ++_i) \
        __builtin_amdgcn_global_load_lds((const unsigned*)((const char*)(gbase) + voffB[_i]), (LAS unsigned*)(lds + (bufoff) + ldsw + _i * 8192), 16, 0, 0); } while (0)
#define G8_LDA(dst, b, h) do { _Pragma("unroll") for (int m = 0; m < 4; ++m) _Pragma("unroll") for (int k = 0; k < 2; ++k) dst[m][k] = *(const LAS bf16x8*)(lds + G8_SA(b, h) + aoff + m * 2048 + k * 1024); } while (0)
#define G8_LDB(dst, b, h) do { _Pragma("unroll") for (int n = 0; n < 2; ++n) _Pragma("unroll") for (int k = 0; k < 2; ++k) dst[n][k] = *(const LAS bf16x8*)(lds + G8_SB(b, h) + boff + n * 2048 + k * 1024); } while (0)
#define G8_MMA(ai, bj, At, Bt) do { __builtin_amdgcn_s_setprio(1); _Pragma("unroll") for (int m = 0; m < 4; ++m) _Pragma("unroll") for (int n = 0; n < 2; ++n) _Pragma("unroll") for (int k = 0; k < 2; ++k) \
        acc[ai][bj][m][n] = __builtin_amdgcn_mfma_f32_16x16x32_bf16(Bt[n][k], At[m][k], acc[ai][bj][m][n], 0, 0, 0); __builtin_amdgcn_s_setprio(0); } while (0)
#define G8_WAIT_V(n) asm volatile("s_waitcnt vmcnt(" #n ")" ::: "memory")
#define G8_WAIT_L(n) asm volatile("s_waitcnt lgkmcnt(" #n ")" ::: "memory")
#define G8_BAR __builtin_amdgcn_s_barrier()
#define G8_SCHED __builtin_amdgcn_sched_barrier(0)
    GU cur, nxt; int ui = 0;
    if (!S.next(0, cur)) return;
    if constexpr (P::GATHER) { S.rows(cur, offA); asm volatile("" : "+v"(offA[0][0]), "+v"(offA[0][1]), "+v"(offA[1][0]), "+v"(offA[1][1])); }
    f32x4 acc[2][2][4][2];
#pragma unroll
    for (int a = 0; a < 2; ++a)
#pragma unroll
        for (int b = 0; b < 2; ++b)
#pragma unroll
            for (int m = 0; m < 4; ++m)
#pragma unroll
                for (int n = 0; n < 2; ++n) acc[a][b][m][n] = (f32x4){0.f, 0.f, 0.f, 0.f};
    bf16x8 At[4][2], B0[2][2], B1[2][2];
    const char* cA = cur.A; const char* cB = cur.B;
    G8_STAGE_B(G8_SB(0, 0), cB); G8_STAGE_A(G8_SA(0, 0), cA, offA, 0); G8_STAGE_B(G8_SB(0, 1), cB + hstepB); G8_STAGE_A(G8_SA(0, 1), cA, offA, 1);
    if (wr == 1) G8_BAR;
    G8_WAIT_V(4); G8_BAR;
    G8_STAGE_B(G8_SB(1, 0), cB + kstep); G8_STAGE_A(G8_SA(1, 0), cA + kstep, offA, 0); G8_STAGE_B(G8_SB(1, 1), cB + hstepB + kstep);
    G8_WAIT_V(6); G8_BAR;
    for (;;) {
        const bool has_next = S.next(ui + 1, nxt);
        const char* nA = has_next ? nxt.A : cA; const char* nB = has_next ? nxt.B : cB;
        if constexpr (P::GATHER) {
            if (has_next) S.rows(nxt, offAn);
            else {
#pragma unroll
                for (int h = 0; h < 2; ++h)
#pragma unroll
                    for (int i = 0; i < 2; ++i) offAn[h][i] = offA[h][i]; }
            asm volatile("" : "+v"(offAn[0][0]), "+v"(offAn[0][1]), "+v"(offAn[1][0]), "+v"(offAn[1][1]));
        }
        for (int t = 0; t < nt; t += 2) {
            const bool last = (t == nt - 2);
            const char* a1 = cA + (size_t)(t + 1) * kstep;
            const char* a2 = last ? nA : cA + (size_t)(t + 2) * kstep; const char* b2 = last ? nB : cB + (size_t)(t + 2) * kstep;
            const char* a3 = a2 + kstep; const char* b3 = b2 + kstep;
            unsigned o2[2][2];
#pragma unroll
            for (int h = 0; h < 2; ++h)
#pragma unroll
                for (int i = 0; i < 2; ++i) o2[h][i] = (P::GATHER && last) ? offAn[h][i] : offA[h][i];
            G8_LDB(B0, 0, 0); G8_SCHED; G8_LDA(At, 0, 0); G8_STAGE_A(G8_SA(1, 1), a1, offA, 1);
            G8_WAIT_L(8); G8_BAR; G8_WAIT_L(0); G8_MMA(0, 0, At, B0); G8_BAR; G8_SCHED;
            G8_LDB(B1, 0, 1); G8_STAGE_B(G8_SB(0, 0), b2);
            G8_BAR; G8_WAIT_L(0); G8_MMA(0, 1, At, B1); G8_BAR;
            G8_LDA(At, 0, 1); G8_STAGE_A(G8_SA(0, 0), a2, o2, 0);
            G8_BAR; G8_WAIT_L(0); G8_MMA(1, 0, At, B0); G8_BAR; G8_SCHED;
            G8_STAGE_B(G8_SB(0, 1), b2 + hstepB);
            G8_WAIT_V(6); G8_BAR; G8_MMA(1, 1, At, B1); G8_BAR;
            G8_LDB(B0, 1, 0); G8_SCHED; G8_LDA(At, 1, 0); G8_STAGE_A(G8_SA(0, 1), a2, o2, 1);
            G8_WAIT_L(8); G8_BAR; G8_WAIT_L(0); G8_MMA(0, 0, At, B0); G8_BAR; G8_SCHED;
            G8_LDB(B1, 1, 1); G8_STAGE_B(G8_SB(1, 0), b3);
            G8_BAR; G8_WAIT_L(0); G8_MMA(0, 1, At, B1); G8_BAR;
            G8_LDA(At, 1, 1); G8_STAGE_A(G8_SA(1, 0), a3, o2, 0);
            G8_BAR; G8_WAIT_L(0); G8_MMA(1, 0, At, B0); G8_BAR; G8_SCHED;
            G8_STAGE_B(G8_SB(1, 1), b3 + hstepB);
            G8_WAIT_V(6); G8_BAR; G8_MMA(1, 1, At, B1); G8_BAR;
        }
        S.epi(acc, cur, wr, wc, fr, fq);
        if (!has_next) break;
#pragma unroll
        for (int a = 0; a < 2; ++a)
#pragma unroll
            for (int b = 0; b < 2; ++b)
#pragma unroll
                for (int m = 0; m < 4; ++m)
#pragma unroll
                    for (int n = 0; n < 2; ++n) acc[a][b][m][n] = (f32x4){0.f, 0.f, 0.f, 0.f};
        cur = nxt; cA = nA; cB = nB; ++ui;
        if constexpr (P::GATHER) {
#pragma unroll
            for (int h = 0; h < 2; ++h)
#pragma unroll
                for (int i = 0; i < 2; ++i) offA[h][i] = offAn[h][i]; }
    }
    G8_WAIT_V(0);
    if (wr == 0) G8_BAR;
    G8_BAR;
#undef G8_SA
#undef G8_SB
#undef G8_STAGE_A
#undef G8_STAGE_B
#undef G8_LDA
#undef G8_LDB
#undef G8_MMA
#undef G8_WAIT_V
#undef G8_WAIT_L
#undef G8_BAR
#undef G8_SCHED
}
}

struct PolDenseBf16 {
    static constexpr bool PERM = true, GATHER = false;
    int K; unsigned lda, ldb;
    const char* A; const char* B; bf16_t* C; int ldc; int nM, nN, pm0, G, c;
    __device__ __forceinline__ bool next(int i, g8::GU& u) const {
        const int L = i * G + c; if (L >= nM * nN) return false;
        g8::tile_order(L, nM, nN, u.pm, u.pn); u.pm += pm0; u.aux = 0; u.valid = 256;
        u.A = A + (size_t)u.pm * 256 * lda; u.B = B + (size_t)u.pn * 256 * ldb; return true;
    }
    __device__ __forceinline__ void epi(const f32x4 (&acc)[2][2][4][2], const g8::GU& u, int wr, int wc, int fr, int fq) const {
        const int row0 = u.pm * 256 + wr * 64 + fr, col0 = u.pn * 256 + wc * 32 + 8 * fq;
#pragma unroll
        for (int ai = 0; ai < 2; ++ai)
#pragma unroll
            for (int m = 0; m < 4; ++m) { bf16_t* rowp = C + (size_t)(row0 + ai * 128 + m * 16) * ldc + col0;
#pragma unroll
                for (int bj = 0; bj < 2; ++bj) { const f32x4 v0 = acc[ai][bj][m][0], v1 = acc[ai][bj][m][1];
                    u32x4 w; w.x = cvt_pk_bf16(v0[0], v0[1]); w.y = cvt_pk_bf16(v0[2], v0[3]); w.z = cvt_pk_bf16(v1[0], v1[1]); w.w = cvt_pk_bf16(v1[2], v1[3]);
                    *(u32x4*)(rowp + bj * 128) = w; } }
    }
};
template <int WHICH>
struct PolMoe {
    static constexpr bool PERM = true, GATHER = (WHICH == 1);
    int K; unsigned lda, ldb;
    const char* A; const char* Bw; bf16_t* C; const unsigned* list; int nN, G, c;
    int tid; LAS int* tab;
    __device__ __forceinline__ void init(const unsigned* cntw) {
        if (tid == 0) { int nt = 0;
            for (int e = 0; e < NEXP; ++e) { const int ce = (int)cntw[e];
                for (int t = 0; t * 256 < ce; ++t) { tab[4 + 4 * nt] = e; tab[5 + 4 * nt] = e * NTOK + t * 256; tab[6 + 4 * nt] = (ce - t * 256) < 256 ? (ce - t * 256) : 256; ++nt; } }
            tab[0] = nt; }
        __syncthreads();
    }
    __device__ __forceinline__ bool next(int i, g8::GU& u) const {
        const int L = i * G + c; if (L >= __builtin_amdgcn_readfirstlane(tab[0]) * nN) return false;
        const int mt = L / nN; u.pn = L % nN;
        const int e = __builtin_amdgcn_readfirstlane(tab[4 + 4 * mt]); u.pm = __builtin_amdgcn_readfirstlane(tab[5 + 4 * mt]); u.valid = __builtin_amdgcn_readfirstlane(tab[6 + 4 * mt]); u.aux = mt;
        u.A = (WHICH == 1) ? A : A + (size_t)mt * 256 * lda; u.B = Bw + ((size_t)e * (WHICH == 1 ? 1024 : D) + (size_t)u.pn * 256) * ldb; return true;
    }
    __device__ __forceinline__ unsigned slot_of(const g8::GU& u, int r) const { const int rr = r < u.valid ? r : 0; return list[u.pm + rr]; }
    __device__ __forceinline__ void rows(const g8::GU& u, unsigned (&off)[2][2]) const {
#pragma unroll
        for (int i = 0; i < 2; ++i) { int R, C; g8::stage_rc(tid * 16 + i * 8192, R, C);
#pragma unroll
            for (int h = 0; h < 2; ++h) { const unsigned s = slot_of(u, h * 128 + R); off[h][i] = (s >> 1) * lda + (unsigned)C * 2u; } }
    }
    __device__ __forceinline__ void epi(const f32x4 (&acc)[2][2][4][2], const g8::GU& u, int wr, int wc, int fr, int fq) const {
        if (WHICH == 1) {
#pragma unroll
            for (int ai = 0; ai < 2; ++ai)
#pragma unroll
                for (int m = 0; m < 4; ++m) { const int r = ai * 128 + wr * 64 + m * 16 + fr;
                    const f32x4 g0 = acc[ai][0][m][0], g1 = acc[ai][0][m][1], u0 = acc[ai][1][m][0], u1 = acc[ai][1][m][1];
                    float h[8];
#pragma unroll
                    for (int q = 0; q < 4; ++q) { h[q] = g0[q] * sigmoidf_(g0[q]) * u0[q]; h[4 + q] = g1[q] * sigmoidf_(g1[q]) * u1[q]; }
                    u32x4 w; w.x = cvt_pk_bf16(h[0], h[1]); w.y = cvt_pk_bf16(h[2], h[3]); w.z = cvt_pk_bf16(h[4], h[5]); w.w = cvt_pk_bf16(h[6], h[7]);
                    *(u32x4*)(C + ((size_t)u.aux * 256 + r) * DFF + u.pn * 128 + wc * 32 + 8 * fq) = w; }
        } else {
            unsigned sl[2][4];
#pragma unroll
            for (int ai = 0; ai < 2; ++ai)
#pragma unroll
                for (int m = 0; m < 4; ++m) sl[ai][m] = slot_of(u, ai * 128 + wr * 64 + m * 16 + fr);
#pragma unroll
            for (int ai = 0; ai < 2; ++ai)
#pragma unroll
                for (int m = 0; m < 4; ++m) { const int r = ai * 128 + wr * 64 + m * 16 + fr; const bool ok = r < u.valid;
#pragma unroll
                    for (int bj = 0; bj < 2; ++bj) { const f32x4 v0 = acc[ai][bj][m][0], v1 = acc[ai][bj][m][1];
                        u32x4 w; w.x = cvt_pk_bf16(v0[0], v0[1]); w.y = cvt_pk_bf16(v0[2], v0[3]); w.z = cvt_pk_bf16(v1[0], v1[1]); w.w = cvt_pk_bf16(v1[2], v1[3]);
                        if (ok) *(u32x4*)(C + (size_t)sl[ai][m] * D + u.pn * 256 + bj * 128 + wc * 32 + 8 * fq) = w; } }
        }
    }
};

struct PolMerge {
    static constexpr bool PERM = true, GATHER = false;
    int K; unsigned lda, ldb;
    const char* A; const char* B; bf16_t* Gt; bf16_t* Yo; int nM, pm0, G, c;
    __device__ __forceinline__ bool next(int i, g8::GU& u) const {
        const int L = (i >> 2) * G + c; if (L >= nM * 8) return false;
        g8::tile_order(L, nM, 8, u.pm, u.pn); u.pm += pm0; u.aux = i & 3; u.valid = 256;
        u.A = A + (size_t)u.pm * 256 * lda + (size_t)u.aux * 2048; u.B = B + ((size_t)u.aux * D + (size_t)u.pn * 256) * ldb; return true;
    }
    __device__ __forceinline__ void epi(const f32x4 (&acc)[2][2][4][2], const g8::GU& u, int wr, int wc, int fr, int fq) const {
        const int row0 = u.pm * 256 + wr * 64 + fr, col0 = u.pn * 256 + wc * 32 + 8 * fq, n = u.aux;
#pragma unroll
        for (int ai = 0; ai < 2; ++ai) {
            u32x4 gv[4][2]; unsigned long long pq[4][2][2];
#pragma unroll
            for (int m = 0; m < 4; ++m)
#pragma unroll
                for (int bj = 0; bj < 2; ++bj) { const bf16_t* gp = Gt + (size_t)(row0 + ai * 128 + m * 16) * NG + n * D + col0 + bj * 128;
                    gv[m][bj] = *(const u32x4*)gp;
                    if (n > 0) { const u32x4 pv = *(const u32x4*)(gp - D); pq[m][bj][0] = (unsigned long long)pv.x | ((unsigned long long)pv.y << 32); pq[m][bj][1] = (unsigned long long)pv.z | ((unsigned long long)pv.w << 32); }
                    else { pq[m][bj][0] = 0ull; pq[m][bj][1] = 0ull; } }
#pragma unroll
            for (int m = 0; m < 4; ++m) { bf16_t* grow = Gt + (size_t)(row0 + ai * 128 + m * 16) * NG + n * D + col0;
#pragma unroll
                for (int bj = 0; bj < 2; ++bj) { const f32x4 v0 = acc[ai][bj][m][0], v1 = acc[ai][bj][m][1]; const u32x4 g = gv[m][bj];
                    const unsigned p0 = (unsigned)pq[m][bj][0], p1 = (unsigned)(pq[m][bj][0] >> 32), p2 = (unsigned)pq[m][bj][1], p3 = (unsigned)(pq[m][bj][1] >> 32);
                    float r[8];
                    r[0] = v0[0] * sigmoidf_(bf_lo(g.x)) + bf_lo(p0); r[1] = v0[1] * sigmoidf_(bf_hi(g.x)) + bf_hi(p0); r[2] = v0[2] * sigmoidf_(bf_lo(g.y)) + bf_lo(p1); r[3] = v0[3] * sigmoidf_(bf_hi(g.y)) + bf_hi(p1);
                    r[4] = v1[0] * sigmoidf_(bf_lo(g.z)) + bf_lo(p2); r[5] = v1[1] * sigmoidf_(bf_hi(g.z)) + bf_hi(p2); r[6] = v1[2] * sigmoidf_(bf_lo(g.w)) + bf_lo(p3); r[7] = v1[3] * sigmoidf_(bf_hi(g.w)) + bf_hi(p3);
                    u32x4 w; w.x = cvt_pk_bf16(r[0], r[1]); w.y = cvt_pk_bf16(r[2], r[3]); w.z = cvt_pk_bf16(r[4], r[5]); w.w = cvt_pk_bf16(r[6], r[7]);
                    if (n < 3) *(u32x4*)(grow + bj * 128) = w;
                    else *(u32x4*)(Yo + (size_t)(row0 + ai * 128 + m * 16) * D + col0 + bj * 128) = w; } }
            asm volatile("" ::: "memory");
        }
    }
};
struct PolOut {
    static constexpr bool PERM = false, GATHER = false;
    int K; unsigned lda, ldb;
    const char* A; const char* B; const float* xin_c; const float* xin_l; float* xout_c; float* xout_l; const float* mod_l; int nM, pm0, G, c;
    __device__ __forceinline__ bool next(int i, g8::GU& u) const {
        const int L = i * G + c; if (L >= nM * 8) return false;
        g8::tile_order(L, nM, 8, u.pm, u.pn); u.pm += pm0; u.aux = 0; u.valid = 256;
        u.A = A + (size_t)u.pm * 256 * lda; u.B = B + (size_t)u.pn * 256 * ldb; return true;
    }
    __device__ __forceinline__ void epi(const f32x4 (&acc)[2][2][4][2], const g8::GU& u, int wr, int wc, int fr, int fq) const {
        const bool isc = u.pm < 8;
        const int mi = isc ? 8 : ((u.pm - 8) >> 3);
        const int lrow0 = (isc ? u.pm * 256 : (u.pm - 8) * 256) + wr * 64 + fr, col0 = u.pn * 256 + wc * 32 + 4 * fq;
        const float* xi = isc ? xin_c : xin_l; float* xo = isc ? xout_c : xout_l;
        const float* g1 = mod_l + (size_t)mi * (6 * D) + 2 * D + col0;
        f32x4 gv[2][2];
#pragma unroll
        for (int bj = 0; bj < 2; ++bj)
#pragma unroll
            for (int n = 0; n < 2; ++n) gv[bj][n] = *(const f32x4*)(g1 + bj * 128 + n * 16);
#pragma unroll
        for (int ai = 0; ai < 2; ++ai) {
            f32x4 xv[4][2][2];
#pragma unroll
            for (int m = 0; m < 4; ++m) { const size_t off = (size_t)(lrow0 + ai * 128 + m * 16) * D + col0;
#pragma unroll
                for (int bj = 0; bj < 2; ++bj)
#pragma unroll
                    for (int n = 0; n < 2; ++n) xv[m][bj][n] = *(const f32x4*)(xi + off + bj * 128 + n * 16); }
#pragma unroll
            for (int m = 0; m < 4; ++m) { const size_t off = (size_t)(lrow0 + ai * 128 + m * 16) * D + col0;
#pragma unroll
                for (int bj = 0; bj < 2; ++bj)
#pragma unroll
                    for (int n = 0; n < 2; ++n) *(f32x4*)(xo + off + bj * 128 + n * 16) = xv[m][bj][n] + gv[bj][n] * acc[ai][bj][m][n]; }
            asm volatile("" ::: "memory");
        }
    }
};

constexpr float LOG2E = 1.4426950408889634f;
constexpr int NKEY = CTXL + SEQ;
#define F_KB ((bf16_t*)(F.ws + WS_Y))
#define F_VTB ((bf16_t*)(F.ws + WS_Y + 36 * MiB))
#define F_KA ((bf16_t*)(F.ws + WS_HID))
#define F_VTA ((bf16_t*)(F.ws + WS_HID + 9 * MiB))
__device__ __forceinline__ void prep_phase(const Frame& F, int l) {
    const int gw = F.vcu * NWAVES + F.wave, NGW = F.G * NWAVES, lane = F.lane;
    bf16_t* P1 = F_P1;
    const f32x2 gqa = *(const f32x2*)(F_qn_a + l * 128 + 2 * lane), gka = *(const f32x2*)(F_kn_a + l * 128 + 2 * lane);
    const f32x2 gqb = *(const f32x2*)(F_qn_b + l * 64 + ((2 * lane) & 63)), gkb = *(const f32x2*)(F_kn_b + l * 64 + ((2 * lane) & 63));
    const float invA0 = exp2f(-(float)((2 * lane) & 31) * (13.287712379549449f / 32.0f)), invA1 = exp2f(-(float)((2 * lane + 1) & 31) * (13.287712379549449f / 32.0f));
    const float invB0 = exp2f(-(float)((2 * lane) & 15) * (13.287712379549449f / 16.0f)), invB1 = exp2f(-(float)((2 * lane + 1) & 15) * (13.287712379549449f / 16.0f));
    const float sgnA = (lane & 16) ? 1.f : -1.f, sgnB = (lane & 8) ? 1.f : -1.f;
    for (int row = gw; row < NTOK; row += NGW) {
        const bool isc = row < NCTX; const int b = isc ? (row >> 8) : ((row - NCTX) >> 11), t = isc ? (row & 255) : ((row - NCTX) & 2047);
        const int key = isc ? t : CTXL + t;
        const float prow = (float)(t >> 6), pcol = (float)(t & 63);
        bf16_t* pr = P1 + (size_t)row * N1;
        unsigned raw[26];
#pragma unroll
        for (int hh = 0; hh < 10; ++hh) raw[hh] = *(const unsigned*)(pr + (hh < 8 ? C_AQ + hh * 128 : C_AK + (hh - 8) * 128) + 2 * lane);
#pragma unroll
        for (int hh = 0; hh < 16; ++hh) raw[10 + hh] = *(const unsigned*)(pr + (hh < 8 ? C_BQ : C_BK) + (hh & 7) * 128 + 2 * lane);
        float cA0 = 1.f, sA0 = 0.f, cA1 = 1.f, sA1 = 0.f, cB0 = 1.f, sB0 = 0.f, cB1 = 1.f, sB1 = 0.f;
        if (!isc) { const float pa = (lane & 32) ? pcol : prow, pb = (lane & 16) ? pcol : prow;
            sincosf(pa * invA0, &sA0, &cA0); sincosf(pa * invA1, &sA1, &cA1); sincosf(pb * invB0, &sB0, &cB0); sincosf(pb * invB1, &sB1, &cB1); }
#pragma unroll
        for (int hh = 0; hh < 10; ++hh) {
            const bool isq = hh < 8;
            float a0 = bf_lo(raw[hh]), a1 = bf_hi(raw[hh]);
            const float rinv = rsqrtf(wave_sum(a0 * a0 + a1 * a1, lane) * (1.0f / 128.0f) + 1e-6f);
            a0 *= rinv * (isq ? gqa.x : gka.x); a1 *= rinv * (isq ? gqa.y : gka.y);
            const float p0 = shx(a0, 16, lane), p1 = shx(a1, 16, lane);
            float o0 = a0 * cA0 + sgnA * p0 * sA0, o1 = a1 * cA1 + sgnA * p1 * sA1;
            if (isq) { const float sc = 0.08838834764831845f * LOG2E; o0 *= sc; o1 *= sc; }
            bf16_t* dst = isq ? pr + C_AQ + hh * 128 : F_KA + (((size_t)(b * 2 + (hh - 8)) * NKEY + key) * 128);
            *(unsigned*)(dst + 2 * lane) = cvt_pk_bf16(o0, o1);
        }
#pragma unroll
        for (int hh = 0; hh < 16; ++hh) {
            const bool isq = hh < 8; const int h = hh & 7;
            float a0 = bf_lo(raw[10 + hh]), a1 = bf_hi(raw[10 + hh]);
            float ss = a0 * a0 + a1 * a1;
#pragma unroll
            for (int o = 1; o < 32; o <<= 1) ss += shx(ss, o, lane);
            const float rinv = rsqrtf(ss * (1.0f / 64.0f) + 1e-6f);
            a0 *= rinv * (isq ? gqb.x : gkb.x); a1 *= rinv * (isq ? gqb.y : gkb.y);
            const float p0 = shx(a0, 8, lane), p1 = shx(a1, 8, lane);
            float o0 = a0 * cB0 + sgnB * p0 * sB0, o1 = a1 * cB1 + sgnB * p1 * sB1;
            if (isq) { const float sc = 0.125f * LOG2E; o0 *= sc; o1 *= sc; }
            bf16_t* dst = isq ? pr + C_BQ + h * 128 : F_KB + (((size_t)(b * 8 + h) * NKEY + key) * 128);
            *(unsigned*)(dst + 2 * lane) = cvt_pk_bf16(o0, o1);
        }
    }
    for (int it = gw; it < 288 * 40; it += NGW) {
        const int tile = it / 40, q = it % 40; const bool isA = q < 8; const int head = isA ? (q >> 2) : ((q - 8) >> 2), slab = q & 3;
        const bool isc = tile < 32; const int b = isc ? (tile >> 2) : ((tile - 32) >> 5), t0 = isc ? ((tile & 3) * 64) : (((tile - 32) & 31) * 64);
        const int row = (isc ? b * CTXL : NCTX + b * SEQ) + t0 + lane, key = (isc ? 0 : CTXL) + t0 + lane;
        const bf16_t* src = P1 + (size_t)row * N1 + (isA ? C_AV : C_BV) + head * 128 + slab * 32;
        u32x4 v[4];
#pragma unroll
        for (int j = 0; j < 4; ++j) v[j] = *(const u32x4*)(src + 8 * j);
        const int keyp = (key & ~12) | ((key & 8) >> 1) | ((key & 4) << 1);
        bf16_t* dst = (isA ? F_VTA + ((size_t)(b * 2 + head) * 128 + slab * 32) * NKEY : F_VTB + ((size_t)(b * 8 + head) * 128 + slab * 32) * NKEY) + keyp;
#pragma unroll
        for (int j = 0; j < 4; ++j) { const unsigned w[4] = {v[j].x, v[j].y, v[j].z, v[j].w};
#pragma unroll
            for (int e = 0; e < 4; ++e) { dst[(size_t)(8 * j + 2 * e) * NKEY] = (bf16_t)(w[e] & 0xffffu); dst[(size_t)(8 * j + 2 * e + 1) * NKEY] = (bf16_t)(w[e] >> 16); } }
    }
}

constexpr int AT_KBYTES = 64 * 256, AT_VBYTES = 128 * 128, AT_BUF = AT_KBYTES + AT_VBYTES, AT_XCH = 2 * AT_BUF;
struct AttnUnit { bool isA, isc; int b, h, qt; };
template <bool IS_A>
__device__ __forceinline__ void attn_unit(const Frame& F, int l, const AttnUnit u) {
    constexpr int NS = IS_A ? 8 : 4;
    const int tid = F.tid, lane = F.lane, w = F.wave, r = lane & 31, h5 = lane >> 5;
    LAS unsigned char* lds = F.lds;
    int t, head, dofs, qcol0;
    if (IS_A) { const int g = w >> 1, qb = w & 1; t = u.qt * 64 + 32 * qb + r; head = u.h * 4 + g; dofs = 0; qcol0 = C_AQ + head * 128; }
    else { const int comp = w >> 2, qb = w & 3; t = u.qt * 128 + 32 * qb + r; head = u.h; dofs = comp * 64; qcol0 = C_BQ + head * 128 + comp * 64; }
    const int qrow = (u.isc ? u.b * CTXL : NCTX + u.b * SEQ) + t;
    const int nhk = IS_A ? 2 : 8;
    const bf16_t* Kb = (IS_A ? F_KA : F_KB) + (size_t)(u.b * nhk + u.h) * NKEY * 128;
    const bf16_t* Vt = (IS_A ? F_VTA : F_VTB) + (size_t)(u.b * nhk + u.h) * 128 * NKEY;
    int lt_lo = 0, ntile;
    if (u.isc) ntile = 4;
    else if (IS_A) { lt_lo = u.qt - 2 < 0 ? 0 : u.qt - 2; const int lt_hi = u.qt + 2 > 31 ? 31 : u.qt + 2; ntile = 4 + lt_hi - lt_lo + 1; }
    else ntile = 36;
    const int wu = __builtin_amdgcn_readfirstlane(w);
    auto tile_of = [&](int j) -> int { return (IS_A && !u.isc && j >= 4) ? 4 + lt_lo + (j - 4) : j; };
    auto dma = [&](int kt, int buf) {
#pragma unroll
        for (int i = 0; i < 2; ++i) { const int blk = 2 * wu + i; const int row = 4 * blk + (lane >> 4); const int c = (lane & 15) ^ (row & 15);
            __builtin_amdgcn_global_load_lds((const unsigned*)((const unsigned char*)Kb + ((size_t)(kt * 64 + row)) * 256 + c * 16), (LAS unsigned*)(lds + buf * AT_BUF + blk * 1024), 16, 0, 0); }
#pragma unroll
        for (int i = 0; i < 2; ++i) { const int blk = 2 * wu + i; const int row = 8 * blk + (lane >> 3); const int c = (lane & 7) ^ ((row >> 1) & 7);
            __builtin_amdgcn_global_load_lds((const unsigned*)((const unsigned char*)Vt + (size_t)row * (NKEY * 2) + kt * 128 + c * 16), (LAS unsigned*)(lds + buf * AT_BUF + AT_KBYTES + blk * 1024), 16, 0, 0); }
    };
    dma(tile_of(0), 0);
    float bound2, sinkp = 0.f;
    if (IS_A) { const float gq = wave_max(fmaxf(fabsf(F_qn_a[l * 128 + lane]), fabsf(F_qn_a[l * 128 + 64 + lane])), lane), gk = wave_max(fmaxf(fabsf(F_kn_a[l * 128 + lane]), fabsf(F_kn_a[l * 128 + 64 + lane])), lane);
        bound2 = LOG2E * 11.313708498984761f * gq * gk; sinkp = exp2f(F_sink_a[l * 8 + head] * LOG2E - bound2); }
    else { const float gq = wave_max(fabsf(F_qn_b[l * 64 + lane]), lane), gk = wave_max(fabsf(F_kn_b[l * 64 + lane]), lane); bound2 = LOG2E * 8.0f * gq * gk; }
    bf16x8 qf[NS];
    { const bf16_t* qp = F_P1 + (size_t)qrow * N1 + qcol0 + 8 * h5;
#pragma unroll
        for (int s = 0; s < NS; ++s) qf[s] = *(const bf16x8*)(qp + 16 * s); }
    f32x16 oacc[4];
#pragma unroll
    for (int i = 0; i < 4; ++i)
#pragma unroll
        for (int j = 0; j < 16; ++j) oacc[i][j] = 0.f;
    float lsum = 0.f;
    const int koff0 = r * 256 + (((dofs >> 3) + h5) ^ (r & 15)) * 16;
    const int voff0 = r * 128 + (h5 ^ ((r >> 1) & 7)) * 16;
    asm volatile("s_waitcnt vmcnt(0)" ::: "memory");
    __syncthreads();
    for (int j = 0; j < ntile; ++j) {
        const int kt = tile_of(j);
        if (j + 1 < ntile) dma(tile_of(j + 1), (j + 1) & 1);
        const LAS unsigned char* kb = lds + (j & 1) * AT_BUF; const LAS unsigned char* vb = kb + AT_KBYTES;
        const bool band = IS_A && !u.isc && kt >= 4;
        const int kpos0 = (kt - 4) * 64;
        bf16x8 kf[NS]; u32x4 vf[8];
        auto kread = [&](int sub) {
#pragma unroll
            for (int s = 0; s < NS; ++s) kf[s] = *(const LAS bf16x8*)(kb + 8192 * sub + (koff0 ^ (32 * s))); };
        auto vread = [&](int sub) {
#pragma unroll
            for (int dvt = 0; dvt < 4; ++dvt)
#pragma unroll
                for (int s2 = 0; s2 < 2; ++s2) vf[2 * dvt + s2] = *(const LAS u32x4*)(vb + 4096 * dvt + (voff0 ^ (64 * sub + 32 * s2))); };
        kread(0);
        vread(0);
        __builtin_amdgcn_sched_barrier(0);
#pragma unroll
        for (int sub = 0; sub < 2; ++sub) {
            f32x16 sacc;
#pragma unroll
            for (int i = 0; i < 16; ++i) sacc[i] = -bound2;
#pragma unroll
            for (int s = 0; s < NS; ++s) sacc = __builtin_amdgcn_mfma_f32_32x32x16_bf16(kf[s], qf[s], sacc, 0, 0, 0);
            float p[16];
#pragma unroll
            for (int i = 0; i < 16; ++i) { float e = __builtin_amdgcn_exp2f(sacc[i]);
                if (band) { const int kpos = kpos0 + 32 * sub + (i & 3) + 8 * (i >> 2) + 4 * h5; const int dlt = kpos - t; e = (dlt <= 128 && dlt >= -128) ? e : 0.f; }
                p[i] = e; lsum += e; }
            bf16x8 pb[2];
#pragma unroll
            for (int s2 = 0; s2 < 2; ++s2) { u32x4 pk; pk.x = cvt_pk_bf16(p[8 * s2 + 0], p[8 * s2 + 1]); pk.y = cvt_pk_bf16(p[8 * s2 + 2], p[8 * s2 + 3]); pk.z = cvt_pk_bf16(p[8 * s2 + 4], p[8 * s2 + 5]); pk.w = cvt_pk_bf16(p[8 * s2 + 6], p[8 * s2 + 7]);
                pb[s2] = __builtin_bit_cast(bf16x8, pk); }
            __builtin_amdgcn_sched_barrier(0);
            if (sub == 0) { kread(1); __builtin_amdgcn_sched_barrier(0); }
#pragma unroll
            for (int dvt = 0; dvt < 4; ++dvt)
#pragma unroll
                for (int s2 = 0; s2 < 2; ++s2) oacc[dvt] = __builtin_amdgcn_mfma_f32_32x32x16_bf16(__builtin_bit_cast(bf16x8, vf[2 * dvt + s2]), pb[s2], oacc[dvt], 0, 0, 0);
            __builtin_amdgcn_sched_barrier(0);
            if (sub == 0) { vread(1); __builtin_amdgcn_sched_barrier(0); }
        }
        asm volatile("s_waitcnt vmcnt(0)" ::: "memory");
        __syncthreads();
    }
    float ltot = lsum + shx(lsum, 32, lane) + sinkp;
    const float linv = 1.0f / ltot;
    bf16_t* orow = F_O + (size_t)qrow * 4096;
    if (IS_A) {
#pragma unroll
        for (int dvt = 0; dvt < 4; ++dvt)
#pragma unroll
            for (int g = 0; g < 4; ++g) { u32x2 o; o.x = cvt_pk_bf16(oacc[dvt][4 * g] * linv, oacc[dvt][4 * g + 1] * linv); o.y = cvt_pk_bf16(oacc[dvt][4 * g + 2] * linv, oacc[dvt][4 * g + 3] * linv);
                *(u32x2*)(orow + head * 128 + 32 * dvt + 8 * g + 4 * h5) = o; }
    } else {
        LAS float* xch = (LAS float*)(lds + AT_XCH) + (w & 3) * 4096;
        if (w >= 4) {
#pragma unroll
            for (int dvt = 0; dvt < 4; ++dvt)
#pragma unroll
                for (int i = 0; i < 16; ++i) xch[(dvt * 16 + i) * 64 + lane] = oacc[dvt][i] * linv;
        }
        __syncthreads();
        if (w < 4) {
            const float* lb = F_lam_b + l * 256;
            const float d1 = wave_sum(lb[lane] * lb[64 + lane], lane), d2 = wave_sum(lb[128 + lane] * lb[192 + lane], lane);
            const float lam_init = 0.8f - 0.6f * expf(-0.3f * (float)l), lam = expf(d1) - expf(d2) + lam_init;
            float ss = 0.f;
#pragma unroll
            for (int dvt = 0; dvt < 4; ++dvt)
#pragma unroll
                for (int i = 0; i < 16; ++i) { const float d = oacc[dvt][i] * linv - lam * xch[(dvt * 16 + i) * 64 + lane]; oacc[dvt][i] = d; ss += d * d; }
            ss += shx(ss, 32, lane);
            const float rn = rsqrtf(ss * (1.0f / 128.0f) + 1e-6f) * (1.0f - lam_init);
            const float* sg = F_subln_b + l * 128;
#pragma unroll
            for (int dvt = 0; dvt < 4; ++dvt)
#pragma unroll
                for (int g = 0; g < 4; ++g) { const int dv = 32 * dvt + 8 * g + 4 * h5; const f32x4 gg = *(const f32x4*)(sg + dv);
                    u32x2 o; o.x = cvt_pk_bf16(oacc[dvt][4 * g] * rn * gg.x, oacc[dvt][4 * g + 1] * rn * gg.y); o.y = cvt_pk_bf16(oacc[dvt][4 * g + 2] * rn * gg.z, oacc[dvt][4 * g + 3] * rn * gg.w);
                    *(u32x2*)(orow + 1024 + head * 128 + dv) = o; }
        }
    }
}
__device__ __forceinline__ float gelu_tanh(float x) { const float z = 0.7978845608028654f * (x + 0.044715f * x * x * x); const float e = __expf(2.0f * z); return 0.5f * x * (2.0f - 2.0f / (1.0f + e)); }
#define F_HB ((bf16_t*)(F.ws + WS_HB))
__device__ __forceinline__ void lru_unit(const Frame& F, int l, int b, int blk, int d) {
    const int tid = F.tid, lane = F.lane, w = F.wave, ch = tid & 127, tq = tid >> 7, fr = lane & 15, fq = lane >> 4;
    LAS float* U = (LAS float*)F.lds;
    LAS bf16_t* Ub = (LAS bf16_t*)(F.lds + 32768);
    LAS f32x2* AV = (LAS f32x2*)(F.lds + 32768 + 17408);
    LAS f32x2* SEG = (LAS f32x2*)(F.lds + 32768 + 17408 + 65536);
    LAS float* HC = (LAS float*)(F.lds + 32768 + 17408 + 65536 + 4096);
    const bf16_t* P1 = F_P1;
    const int cg = blk * 128 + ch;
    const float cw0 = F_conv_w[(l * 4 + 0) * 1024 + cg], cw1 = F_conv_w[(l * 4 + 1) * 1024 + cg], cw2 = F_conv_w[(l * 4 + 2) * 1024 + cg], cw3 = F_conv_w[(l * 4 + 3) * 1024 + cg], cb = F_conv_b[l * 1024 + cg];
    const bool ctx_out = l < DEPTH - 1;
    bf16_t* hout = (d == 0) ? F_O + 2048 + cg : F_HB + cg; const size_t hstride = (d == 0) ? 4096 : 1024;
    bf16x8 wr[4], wi[4];
    { const float* wrp = F_w_rg + ((size_t)((l * 2 + d) * 8 + blk) * 128) * 128 + 16 * w + fr; const float* wip = F_w_ig + ((size_t)((l * 2 + d) * 8 + blk) * 128) * 128 + 16 * w + fr;
#pragma unroll
        for (int ks = 0; ks < 4; ++ks) { u32x4 a, c2; const int c0 = 32 * ks + 8 * fq;
            a.x = cvt_pk_bf16(wrp[(c0 + 0) * 128], wrp[(c0 + 1) * 128]); a.y = cvt_pk_bf16(wrp[(c0 + 2) * 128], wrp[(c0 + 3) * 128]); a.z = cvt_pk_bf16(wrp[(c0 + 4) * 128], wrp[(c0 + 5) * 128]); a.w = cvt_pk_bf16(wrp[(c0 + 6) * 128], wrp[(c0 + 7) * 128]);
            c2.x = cvt_pk_bf16(wip[(c0 + 0) * 128], wip[(c0 + 1) * 128]); c2.y = cvt_pk_bf16(wip[(c0 + 2) * 128], wip[(c0 + 3) * 128]); c2.z = cvt_pk_bf16(wip[(c0 + 4) * 128], wip[(c0 + 5) * 128]); c2.w = cvt_pk_bf16(wip[(c0 + 6) * 128], wip[(c0 + 7) * 128]);
            wr[ks] = __builtin_bit_cast(bf16x8, a); wi[ks] = __builtin_bit_cast(bf16x8, c2); } }
    const int cj = blk * 128 + 16 * w + fr;
    const float br = F_b_rg[(l * 2 + d) * 1024 + cj], bi = F_b_ig[(l * 2 + d) * 1024 + cj];
    const float sp8 = 8.0f * log1pf(expf(-F_lru_lambda[(l * 2 + d) * 1024 + cj]));
    if (tid < 128) HC[tid] = 0.f;
    auto geom = [&](int step, int& rowbase, int& t0, int& seglen) { const bool isc = step < 4; const int idx = isc ? step : step - 4, nch = isc ? 4 : 32, ci = (d == 0) ? idx : nch - 1 - idx; t0 = ci * 64; seglen = isc ? CTXL : SEQ; rowbase = isc ? b * CTXL : NCTX + b * SEQ; };
    unsigned short xr[19];
    auto ldraw = [&](int step) { int rowbase, t0, seglen; geom(step, rowbase, t0, seglen); const int ts = t0 + tq * 16;
#pragma unroll
        for (int i = 0; i < 19; ++i) { const int t = ts - 2 + i; xr[i] = (t >= 0 && t < seglen) ? P1[(size_t)(rowbase + t) * N1 + C_CX + cg] : (unsigned short)0; } };
    ldraw(0);
    for (int step = 0; step < 36; ++step) {
        int rowbase, t0, seglen; geom(step, rowbase, t0, seglen);
        const bool isc = step < 4;
#pragma unroll
        for (int tt = 0; tt < 16; ++tt) { const float u = cb + cw0 * bf2f(xr[tt]) + cw1 * bf2f(xr[tt + 1]) + cw2 * bf2f(xr[tt + 2]) + cw3 * bf2f(xr[tt + 3]);
            U[(tq * 16 + tt) * 128 + ch] = u; Ub[(tq * 16 + tt) * 136 + ch] = (bf16_t)(cvt_pk_bf16(u, 0.f) & 0xffffu); }
        __syncthreads();
        if (step + 1 < 36) ldraw(step + 1);
#pragma unroll
        for (int mt = 0; mt < 4; ++mt) { f32x4 ar = (f32x4){0.f, 0.f, 0.f, 0.f}, ai = ar;
#pragma unroll
            for (int ks = 0; ks < 4; ++ks) { const bf16x8 a = *(const LAS bf16x8*)(Ub + (16 * mt + fr) * 136 + 32 * ks + 8 * fq);
                ar = __builtin_amdgcn_mfma_f32_16x16x32_bf16(a, wr[ks], ar, 0, 0, 0); ai = __builtin_amdgcn_mfma_f32_16x16x32_bf16(a, wi[ks], ai, 0, 0, 0); }
#pragma unroll
            for (int rg = 0; rg < 4; ++rg) { const int tok = 16 * mt + 4 * fq + rg, cl = 16 * w + fr;
                const float r = sigmoidf_(ar[rg] + br), ig = sigmoidf_(ai[rg] + bi); const float a_ = __expf(-sp8 * r);
                const float v = __builtin_amdgcn_sqrtf(fmaxf(1.0f - a_ * a_, 0.f)) * ig * U[tok * 128 + cl]; AV[tok * 128 + cl] = (f32x2){a_, v}; } }
        __syncthreads();
        float hl[16], cp[16];
        { float h = 0.f, pr = 1.f;
#pragma unroll
            for (int i = 0; i < 16; ++i) { const int p = 16 * tq + i, tok = (d == 0) ? p : 63 - p; const f32x2 av = AV[tok * 128 + ch]; h = av.x * h + av.y; pr *= av.x; hl[i] = h; cp[i] = pr; }
            SEG[tq * 128 + ch] = (f32x2){pr, h}; }
        __syncthreads();
        { float carry = HC[ch];
#pragma unroll
            for (int sg = 0; sg < 3; ++sg) { const f32x2 ps = SEG[sg * 128 + ch]; carry = (sg < tq) ? ps.x * carry + ps.y : carry; }
            const bool wr_out = !isc || ctx_out;
#pragma unroll
            for (int i = 0; i < 16; ++i) { const float h = hl[i] + cp[i] * carry; hl[i] = h;
                if (wr_out) { const int p = 16 * tq + i, tok = (d == 0) ? p : 63 - p; hout[(size_t)(rowbase + t0 + tok) * hstride] = (bf16_t)(cvt_pk_bf16(h, 0.f) & 0xffffu); } }
            __syncthreads();
            if (tq == 3) HC[ch] = hl[15]; }
    }
    __syncthreads();
}
__device__ __forceinline__ void lru_finish(const Frame& F, int l) {
    const size_t gt = (size_t)F.vcu * NTHR + F.tid, NGT = (size_t)F.G * NTHR;
    const size_t row_lo = (l == DEPTH - 1) ? NCTX : 0;
    for (size_t i = row_lo * 128 + gt; i < (size_t)NTOK * 128; i += NGT) { const size_t row = i >> 7; const int c8 = (int)(i & 127) * 8;
        bf16_t* op = F_O + row * 4096 + 2048 + c8;
        const u32x4 hf = *(const u32x4*)op, hb = *(const u32x4*)(F_HB + row * 1024 + c8), yv = *(const u32x4*)(F_P1 + row * N1 + C_CY + c8);
        u32x4 o;
        o.x = cvt_pk_bf16((bf_lo(hf.x) + bf_lo(hb.x)) * gelu_tanh(bf_lo(yv.x)), (bf_hi(hf.x) + bf_hi(hb.x)) * gelu_tanh(bf_hi(yv.x)));
        o.y = cvt_pk_bf16((bf_lo(hf.y) + bf_lo(hb.y)) * gelu_tanh(bf_lo(yv.y)), (bf_hi(hf.y) + bf_hi(hb.y)) * gelu_tanh(bf_hi(yv.y)));
        o.z = cvt_pk_bf16((bf_lo(hf.z) + bf_lo(hb.z)) * gelu_tanh(bf_lo(yv.z)), (bf_hi(hf.z) + bf_hi(hb.z)) * gelu_tanh(bf_hi(yv.z)));
        o.w = cvt_pk_bf16((bf_lo(hf.w) + bf_lo(hb.w)) * gelu_tanh(bf_lo(yv.w)), (bf_hi(hf.w) + bf_hi(hb.w)) * gelu_tanh(bf_hi(yv.w)));
        *(u32x4*)op = o; }
}

#define F_DSCR ((bf16_t*)(F.ws + WS_DSCR))
__device__ __forceinline__ void gla_unit(const Frame& F, int l, int b, int h, int d) {
    const int tid = F.tid, lane = F.lane, w = F.wave, kk_ = tid & 127, sc_ = tid >> 7, fr = lane & 15, fq = lane >> 4;
    LAS bf16_t* Qt = (LAS bf16_t*)F.lds;
    LAS bf16_t* Kh = (LAS bf16_t*)(F.lds + 17408);
    LAS bf16_t* KtT = (LAS bf16_t*)(F.lds + 34816);
    LAS bf16_t* Vt = (LAS bf16_t*)(F.lds + 34816 + 18432);
    LAS float* Dc = (LAS float*)(F.lds + 34816 + 36864);
    const bf16_t* P1 = F_P1;
    float lbv = 0.f;
    if (l > 0) { const float x0 = F_lb_d[(0 * 2 + d) * 1024 + h * 128 + kk_], x1 = F_lb_d[(1 * 2 + d) * 1024 + h * 128 + kk_]; lbv = 1.0f / (1.0f + expf(x0 - x1)); }
    const int zcol = (d == 0 ? C_DFF : C_DFB) + h * 128 + kk_, qcol = C_DQ + h * 128 + kk_, vcol = C_DI + h * 128 + kk_;
    f32x4 S[8];
#pragma unroll
    for (int i = 0; i < 8; ++i) S[i] = (f32x4){0.f, 0.f, 0.f, 0.f};
    bf16_t* dscr = (d == 0) ? F_O + 3072 : F_DSCR; const size_t dstride = (d == 0) ? 4096 : 1024;
    const bool ctx_out = l < DEPTH - 1;
    unsigned short zr[16], qr[16], vr[16];
    auto geom = [&](int step, int& rowbase, int& t0) { const bool isc = step < 4; const int idx = isc ? step : step - 4, nch = isc ? 4 : 32, ci = (d == 0) ? idx : nch - 1 - idx; t0 = ci * 64; rowbase = isc ? b * CTXL : NCTX + b * SEQ; };
    auto ldraw = [&](int step) { int rowbase, t0; geom(step, rowbase, t0);
#pragma unroll
        for (int tt = 0; tt < 16; ++tt) { const int p = 16 * sc_ + tt; const size_t row = (size_t)(rowbase + t0 + (d == 0 ? p : 63 - p)); zr[tt] = P1[row * N1 + zcol]; qr[tt] = P1[row * N1 + qcol]; vr[tt] = P1[row * N1 + vcol]; } };
    ldraw(0);
    for (int step = 0; step < 36; ++step) {
        const bool isc = step < 4; int rowbase, t0; geom(step, rowbase, t0);
        { float kh[16]; float eb = 1.0f;
#pragma unroll
            for (int tt = 0; tt < 16; ++tt) { const int p = 16 * sc_ + tt;
                const float z = bf2f(zr[tt]), q = bf2f(qr[tt]);
                const float sg = sigmoidf_(z); const float f = lbv + (1.0f - lbv) * sg; eb = fmaxf(eb * f, 1e-35f);
                const float ebi = __builtin_amdgcn_rcpf(eb);
                kh[tt] = (1.0f - lbv) * (1.0f - sg) * ebi;
                Qt[p * 136 + kk_] = (bf16_t)(cvt_pk_bf16(q * eb, 0.f) & 0xffffu);
                Kh[p * 136 + kk_] = (bf16_t)(cvt_pk_bf16(kh[tt], 0.f) & 0xffffu); }
            const float ebl = eb;
            u32x4 k0, k1, v0, v1;
            k0.x = cvt_pk_bf16(kh[0] * ebl, kh[1] * ebl); k0.y = cvt_pk_bf16(kh[2] * ebl, kh[3] * ebl); k0.z = cvt_pk_bf16(kh[4] * ebl, kh[5] * ebl); k0.w = cvt_pk_bf16(kh[6] * ebl, kh[7] * ebl);
            k1.x = cvt_pk_bf16(kh[8] * ebl, kh[9] * ebl); k1.y = cvt_pk_bf16(kh[10] * ebl, kh[11] * ebl); k1.z = cvt_pk_bf16(kh[12] * ebl, kh[13] * ebl); k1.w = cvt_pk_bf16(kh[14] * ebl, kh[15] * ebl);
            v0.x = (unsigned)vr[0] | ((unsigned)vr[1] << 16); v0.y = (unsigned)vr[2] | ((unsigned)vr[3] << 16); v0.z = (unsigned)vr[4] | ((unsigned)vr[5] << 16); v0.w = (unsigned)vr[6] | ((unsigned)vr[7] << 16);
            v1.x = (unsigned)vr[8] | ((unsigned)vr[9] << 16); v1.y = (unsigned)vr[10] | ((unsigned)vr[11] << 16); v1.z = (unsigned)vr[12] | ((unsigned)vr[13] << 16); v1.w = (unsigned)vr[14] | ((unsigned)vr[15] << 16);
            *(LAS u32x4*)(KtT + kk_ * 72 + 16 * sc_) = k0; *(LAS u32x4*)(KtT + kk_ * 72 + 16 * sc_ + 8) = k1;
            *(LAS u32x4*)(Vt + kk_ * 72 + 16 * sc_) = v0; *(LAS u32x4*)(Vt + kk_ * 72 + 16 * sc_ + 8) = v1;
            Dc[sc_ * 128 + kk_] = ebl; }
        __syncthreads();
        if (step + 1 < 36) ldraw(step + 1);
        LAS u32x2* ATT = (LAS u32x2*)(F.lds + 73728);
        if (__builtin_amdgcn_readfirstlane(w) < 4) { const int sc = __builtin_amdgcn_readfirstlane(w); f32x4 att = (f32x4){0.f, 0.f, 0.f, 0.f};
#pragma unroll
            for (int ks = 0; ks < 4; ++ks) { const bf16x8 a = *(const LAS bf16x8*)(Kh + (16 * sc + fr) * 136 + 32 * ks + 8 * fq), bq = *(const LAS bf16x8*)(Qt + (16 * sc + fr) * 136 + 32 * ks + 8 * fq);
                att = __builtin_amdgcn_mfma_f32_16x16x32_bf16(a, bq, att, 0, 0, 0); }
#pragma unroll
            for (int rg = 0; rg < 4; ++rg) att[rg] = (4 * fq + rg <= fr) ? att[rg] : 0.f;
            ATT[sc * 64 + lane] = (u32x2){cvt_pk_bf16(att[0], att[1]), cvt_pk_bf16(att[2], att[3])}; }
        __syncthreads();
        u32x2 attb2[4];
#pragma unroll
        for (int sc = 0; sc < 4; ++sc) attb2[sc] = ATT[sc * 64 + lane];
#pragma unroll
        for (int sc = 0; sc < 4; ++sc) {
            f32x4 o = (f32x4){0.f, 0.f, 0.f, 0.f};
#pragma unroll
            for (int ks = 0; ks < 4; ++ks) { u32x4 sa; sa.x = cvt_pk_bf16(S[2 * ks][0], S[2 * ks][1]); sa.y = cvt_pk_bf16(S[2 * ks][2], S[2 * ks][3]); sa.z = cvt_pk_bf16(S[2 * ks + 1][0], S[2 * ks + 1][1]); sa.w = cvt_pk_bf16(S[2 * ks + 1][2], S[2 * ks + 1][3]);
                const u32x2 q0 = *(const LAS u32x2*)(Qt + (16 * sc + fr) * 136 + 32 * ks + 4 * fq), q1 = *(const LAS u32x2*)(Qt + (16 * sc + fr) * 136 + 32 * ks + 16 + 4 * fq);
                const u32x4 qb = (u32x4){q0.x, q0.y, q1.x, q1.y};
                o = __builtin_amdgcn_mfma_f32_16x16x32_bf16(__builtin_bit_cast(bf16x8, sa), __builtin_bit_cast(bf16x8, qb), o, 0, 0, 0); }
            const u32x2 v0 = *(const LAS u32x2*)(Vt + (16 * w + fr) * 72 + 16 * sc + 4 * fq);
            const u32x4 vb = (u32x4){v0.x, v0.y, 0u, 0u};
            o = __builtin_amdgcn_mfma_f32_16x16x32_bf16(__builtin_bit_cast(bf16x8, vb), __builtin_bit_cast(bf16x8, (u32x4){attb2[sc].x, attb2[sc].y, 0u, 0u}), o, 0, 0, 0);
            if (!isc || ctx_out) { const int p = 16 * sc + fr; const size_t row = (size_t)(rowbase + t0 + (d == 0 ? p : 63 - p));
                u32x2 ov; ov.x = cvt_pk_bf16(o[0], o[1]); ov.y = cvt_pk_bf16(o[2], o[3]); *(u32x2*)(dscr + row * dstride + h * 128 + 16 * w + 4 * fq) = ov; }
#pragma unroll
            for (int kt = 0; kt < 8; ++kt) { const f32x4 dc = *(const LAS f32x4*)(Dc + sc * 128 + 16 * kt + 4 * fq); S[kt] *= dc;
                const u32x2 ka = *(const LAS u32x2*)(KtT + (16 * kt + fr) * 72 + 16 * sc + 4 * fq);
                S[kt] = __builtin_amdgcn_mfma_f32_16x16x32_bf16(__builtin_bit_cast(bf16x8, (u32x4){ka.x, ka.y, 0u, 0u}), __builtin_bit_cast(bf16x8, vb), S[kt], 0, 0, 0); }
        }
        __syncthreads();
    }
}
__device__ __forceinline__ void gla_finish(const Frame& F, int l) {
    const int gw = F.vcu * NWAVES + F.wave, NGW = F.G * NWAVES, lane = F.lane;
    const int row_lo = (l == DEPTH - 1) ? NCTX : 0;
    const int c0 = 16 * lane, hc = c0 & 127;
    float gn[16];
#pragma unroll
    for (int q = 0; q < 4; ++q) { const f32x4 g4 = *(const f32x4*)(F_onorm_d + l * 128 + hc + 4 * q); gn[4 * q] = g4.x; gn[4 * q + 1] = g4.y; gn[4 * q + 2] = g4.z; gn[4 * q + 3] = g4.w; }
    for (int row = row_lo + gw; row < NTOK; row += NGW) {
        bf16_t* op = F_O + (size_t)row * 4096 + 3072 + c0;
        const u32x4 a0 = *(const u32x4*)op, a1 = *(const u32x4*)(op + 8);
        const u32x4 b0 = *(const u32x4*)(F_DSCR + (size_t)row * 1024 + c0), b1 = *(const u32x4*)(F_DSCR + (size_t)row * 1024 + c0 + 8);
        const u32x4 g0 = *(const u32x4*)(F_P1 + (size_t)row * N1 + C_DG + c0), g1 = *(const u32x4*)(F_P1 + (size_t)row * N1 + C_DG + c0 + 8);
        const unsigned aw[8] = {a0.x, a0.y, a0.z, a0.w, a1.x, a1.y, a1.z, a1.w}, bw[8] = {b0.x, b0.y, b0.z, b0.w, b1.x, b1.y, b1.z, b1.w}, gw_[8] = {g0.x, g0.y, g0.z, g0.w, g1.x, g1.y, g1.z, g1.w};
        float o[16]; float ss = 0.f;
#pragma unroll
        for (int q = 0; q < 8; ++q) { o[2 * q] = bf_lo(aw[q]) + bf_lo(bw[q]); o[2 * q + 1] = bf_hi(aw[q]) + bf_hi(bw[q]); ss += o[2 * q] * o[2 * q] + o[2 * q + 1] * o[2 * q + 1]; }
        ss += shx(ss, 1, lane); ss += shx(ss, 2, lane); ss += shx(ss, 4, lane);
        const float rn = rsqrtf(ss * (1.0f / 128.0f) + 1e-6f);
        unsigned ow[8];
#pragma unroll
        for (int q = 0; q < 8; ++q) { const float ga = bf_lo(gw_[q]), gb = bf_hi(gw_[q]);
            ow[q] = cvt_pk_bf16(o[2 * q] * rn * gn[2 * q] * ga * sigmoidf_(ga), o[2 * q + 1] * rn * gn[2 * q + 1] * gb * sigmoidf_(gb)); }
        *(u32x4*)op = (u32x4){ow[0], ow[1], ow[2], ow[3]}; *(u32x4*)(op + 8) = (u32x4){ow[4], ow[5], ow[6], ow[7]};
    }
}
__device__ __forceinline__ void mix_phase(const Frame& F0, int l) {
    const Frame& F = F0;
    const bool ctx_out = l < DEPTH - 1;
    const int nBl = 8 * 8 * 16, nBc = ctx_out ? 8 * 8 * 2 : 0, nAl = 8 * 2 * 32, nAc = ctx_out ? 8 * 2 * 4 : 0;
    const int nC = ENABLE_C ? 128 : 0, nD = ENABLE_D ? 128 : 0;
    const int total = nC + nD + nBl + nBc + nAl + nAc;
    volatile LAS int* slot = (volatile LAS int*)(F.lds + MISC_OFF + 64);
    unsigned* head = F_ctl + CW_QUEUE + 64 * l;
    for (;;) {
        __syncthreads();
        if (F.tid == 0) *slot = (int)atomicAdd(head, 1u);
        __syncthreads();
        int q = *slot; q = __builtin_amdgcn_readfirstlane(q);
        if (q >= total) break;
        Frame U = F0;
        U.ws = opaque_ptr(F0.ws); U.out = opaque_ptr(F0.out); asm volatile("" : "+v"(U.tid)); U.lane = U.tid & 63;
        const Frame& F = U;
        AttnUnit u;
        if (q < nC) { lru_unit(F, l, q >> 4, (q >> 1) & 7, q & 1); continue; }
        q -= nC;
        if (q < nD) { gla_unit(F, l, q >> 4, (q >> 1) & 7, q & 1); continue; }
        q -= nD;
        if (q < nBl) { u.isA = false; u.isc = false; u.b = q >> 7; u.h = (q >> 4) & 7; u.qt = q & 15; attn_unit<false>(F, l, u); continue; }
        q -= nBl;
        if (q < nBc) { u.isA = false; u.isc = true; u.b = q >> 4; u.h = (q >> 1) & 7; u.qt = q & 1; attn_unit<false>(F, l, u); continue; }
        q -= nBc;
        if (q < nAl) { u.isA = true; u.isc = false; u.b = q >> 6; u.h = (q >> 5) & 1; u.qt = q & 31; attn_unit<true>(F, l, u); continue; }
        q -= nAl;
        { u.isA = true; u.isc = true; u.b = q >> 3; u.h = (q >> 2) & 1; u.qt = q & 3; attn_unit<true>(F, l, u); }
    }
}
__device__ __forceinline__ void zero_o_cols(const Frame& F, int c0, int c1) {
    const int w8 = (c1 - c0) / 8; const size_t gt = (size_t)F.vcu * NTHR + F.tid, NGT = (size_t)F.G * NTHR;
    unsigned z = 0u; asm volatile("" : "+v"(z));
    for (size_t i = gt; i < (size_t)NTOK * w8; i += NGT) { const size_t row = i / w8, c = i % w8; *(u32x4*)(F_O + row * 4096 + c0 + c * 8) = (u32x4){z, z, z, z}; }
}

constexpr int PH_P0 = 0, PH_PER_LAYER = 10, PH_FINAL = 1 + DEPTH * PH_PER_LAYER, N_PHASES = PH_FINAL + 1;
enum { L_NORM1 = 0, L_INPROJ, L_PREP, L_MIX, L_GATE, L_MERGE, L_OUT, L_NORM2, L_MOE1, L_MOE2 };
__global__ void __launch_bounds__(NTHR, 2) trunk_fwd(Args args) {
    extern __shared__ __attribute__((aligned(16))) unsigned char lds_raw[];
    Frame F;
    F.lds = (LAS unsigned char*)lds_raw;
    F.tid = threadIdx.x; F.lane = F.tid & 63; F.wave = __builtin_amdgcn_readfirstlane(F.tid >> 6);
    F.G = gridDim.x; { const int bx = blockIdx.x; F.vcu = (F.G % 8 == 0) ? (bx % 8) * (F.G / 8) + bx / 8 : bx; }
    F.a = &args; F.ws = args.ws; F.out = args.out;
    volatile LAS unsigned* MISC = (volatile LAS unsigned*)(F.lds + MISC_OFF);
    if (F.tid < 32) MISC[F.tid] = 0u;
    __syncthreads();
    const int lo = args.ph_lo, hi = args.ph_hi;
    XcdBarrier bar; bar.bar = F_ctl + CW_BAR; bar.x = 0; bar.st = nullptr;
    if (hi - lo > 1) bar = xcd_barrier_post(F_ctl + CW_BAR, MISC + 8);
#define IN(k) (lo <= (k) && (k) < hi)
#define SEAM(k) do { if (IN(k) && IN((k) + 1)) xcd_barrier(bar); } while (0)

    if (IN(PH_P0)) { { const Frame P = phase_frame(F); p0_mod(P); } { const Frame P = phase_frame(F); p0_weights(P); }
#if !ENABLE_MIX
        { const Frame P = phase_frame(F); p0_copy_x(P); }
#endif
    }
    SEAM(PH_P0);
    for (int l = 0; l < DEPTH; ++l) {
        const int base = 1 + l * PH_PER_LAYER;
        const int pm0 = (l == DEPTH - 1) ? 8 : 0;
        if (IN(base + L_NORM1)) { const Frame P = phase_frame(F); norm_phase<1>(P, l); }
        SEAM(base + L_NORM1);
#if ENABLE_MIX
        if (IN(base + L_INPROJ)) { const Frame Fo = F; const Frame F = phase_frame(Fo);
            PolDenseBf16 S; S.K = D; S.lda = D * 2; S.ldb = D * 2; S.A = (const char*)F_H; S.B = (const char*)(F_WIN + (size_t)l * INW * D); S.C = F_P1; S.ldc = N1; S.nM = 72; S.nN = 46; S.pm0 = 0; S.G = F.G; S.c = (int)blockIdx.x;
            g8::gemm_phase(F.lds, S, F.tid);
        }
        SEAM(base + L_INPROJ);
        if (IN(base + L_PREP)) { const Frame P = phase_frame(F); prep_phase(P, l); if (!ENABLE_C) zero_o_cols(P, 2048, 3072); if (!ENABLE_D) zero_o_cols(P, 3072, 4096); }
        SEAM(base + L_PREP);
        if (IN(base + L_MIX)) { const Frame P = phase_frame(F); mix_phase(P, l); }
        SEAM(base + L_MIX);
        if (IN(base + L_GATE)) { const Frame Fo = F; const Frame F = phase_frame(Fo);
            if (ENABLE_D) gla_finish(F, l);
            if (ENABLE_C) lru_finish(F, l);
            if (hi - lo > 1) xcd_barrier(bar);
            PolDenseBf16 S; S.K = D; S.lda = D * 2; S.ldb = D * 2; S.A = (const char*)F_H; S.B = (const char*)(F_WIN + ((size_t)l * INW + N1) * D); S.C = F_P1; S.ldc = NG; S.nM = 72 - pm0; S.nN = 32; S.pm0 = pm0; S.G = F.G; S.c = (int)blockIdx.x;
            g8::gemm_phase(F.lds, S, F.tid);
        }
        SEAM(base + L_GATE);
        if (IN(base + L_MERGE)) { const Frame Fo = F; const Frame F = phase_frame(Fo);
            PolMerge S; S.K = 1024; S.lda = 4096 * 2; S.ldb = 1024 * 2; S.A = (const char*)F_O; S.B = (const char*)(F_WBR + (size_t)l * 4 * D * 1024); S.Gt = F_P1; S.Yo = F_Y; S.nM = 64; S.pm0 = 8; S.G = F.G; S.c = (int)blockIdx.x;
            g8::gemm_phase(F.lds, S, F.tid);
        }
        SEAM(base + L_MERGE);
        if (IN(base + L_OUT)) {
            const bool split = (l < DEPTH - 1) && (F.G > 64);
            if (split && (int)blockIdx.x < 64) { const Frame Fo = F; const Frame F = phase_frame(Fo);
                PolMerge S; S.K = 1024; S.lda = 4096 * 2; S.ldb = 1024 * 2; S.A = (const char*)F_O; S.B = (const char*)(F_WBR + (size_t)l * 4 * D * 1024); S.Gt = F_P1; S.Yo = F_Y; S.nM = 8; S.pm0 = 0; S.G = 64; S.c = (int)blockIdx.x;
                g8::gemm_phase(F.lds, S, F.tid);
            } else { const Frame Fo = F; const Frame F = phase_frame(Fo);
                PolOut S; S.K = D; S.lda = D * 2; S.ldb = D * 2; S.A = (const char*)F_Y; S.B = (const char*)(F_WOUT + (size_t)l * D * D);
                S.xin_c = (l == 0) ? F_ctx : F_XC; S.xin_l = (l == 0) ? F_x : F.out; S.xout_c = F_XC; S.xout_l = F.out; S.mod_l = F_MOD + (size_t)l * 9 * 6 * D; S.nM = 64; S.pm0 = 8;
                S.G = split ? F.G - 64 : F.G; S.c = split ? (int)blockIdx.x - 64 : (int)blockIdx.x;
                g8::gemm_phase(F.lds, S, F.tid);
            }
            if (split) {
                if (hi - lo > 1) xcd_barrier(bar);
                const Frame Fo = F; const Frame F = phase_frame(Fo);
                PolOut S; S.K = D; S.lda = D * 2; S.ldb = D * 2; S.A = (const char*)F_Y; S.B = (const char*)(F_WOUT + (size_t)l * D * D);
                S.xin_c = (l == 0) ? F_ctx : F_XC; S.xin_l = (l == 0) ? F_x : F.out; S.xout_c = F_XC; S.xout_l = F.out; S.mod_l = F_MOD + (size_t)l * 9 * 6 * D; S.nM = 8; S.pm0 = 0; S.G = F.G; S.c = (int)blockIdx.x;
                g8::gemm_phase(F.lds, S, F.tid);
            }
        }
        SEAM(base + L_OUT);
#endif
        if (IN(base + L_NORM2)) { const Frame P = phase_frame(F); norm2_phase(P, l); }
        SEAM(base + L_NORM2);
        if (IN(base + L_MOE1)) { const Frame Fo = F; const Frame F = phase_frame(Fo);
            PolMoe<1> S; S.K = D; S.lda = D * 2; S.ldb = D * 2; S.A = (const char*)F_H; S.Bw = (const char*)(F_WGU + (size_t)l * NEXP * 1024 * D); S.C = (bf16_t*)(F.ws + WS_DSCR); S.list = F_LIST; S.nN = 4; S.G = F.G; S.c = (int)blockIdx.x; S.tab = (LAS int*)(F.lds + 131072); S.tid = F.tid;
            S.init(F_ctl + CW_CNT + 64 * l);
            g8::gemm_phase(F.lds, S, F.tid);
        }
        SEAM(base + L_MOE1);
        if (IN(base + L_MOE2)) { const Frame Fo = F; const Frame F = phase_frame(Fo);
            PolMoe<2> S; S.K = DFF; S.lda = DFF * 2; S.ldb = DFF * 2; S.A = (const char*)(F.ws + WS_DSCR); S.Bw = (const char*)(F_WD + (size_t)l * NEXP * D * DFF); S.C = F_O; S.list = F_LIST; S.nN = 8; S.G = F.G; S.c = (int)blockIdx.x; S.tab = (LAS int*)(F.lds + 131072); S.tid = F.tid;
            S.init(F_ctl + CW_CNT + 64 * l);
            g8::gemm_phase(F.lds, S, F.tid);
        }
        SEAM(base + L_MOE2);
        (void)pm0;
    }
    if (IN(PH_FINAL)) { const Frame P = phase_frame(F); norm_phase<3>(P, 0); }
#undef IN
#undef SEAM
}

extern "C" void kernel_launch(void* const* d_in, const int* in_sizes, int n_in, void* d_out, int out_size, void* d_ws, size_t ws_size, hipStream_t stream) {
    static int grid = 0;
    if (grid == 0) {
        if (n_in != 32 || out_size != NLAT * D || ws_size < WS_END) { fprintf(stderr, "kernel_launch: unexpected shapes (n_in %d, out %d, ws %zu)\n", n_in, out_size, ws_size); grid = -1; return; }
        int dev = 0, cus = 0, per_cu = 0;
        if (hipGetDevice(&dev) != hipSuccess || hipDeviceGetAttribute(&cus, hipDeviceAttributeMultiprocessorCount, dev) != hipSuccess) { grid = -1; return; }
        if (hipFuncSetAttribute((const void*)trunk_fwd, hipFuncAttributeMaxDynamicSharedMemorySize, LDS_BYTES) != hipSuccess) { fprintf(stderr, "kernel_launch: hipFuncSetAttribute failed\n"); grid = -1; return; }
        if (hipOccupancyMaxActiveBlocksPerMultiprocessor(&per_cu, (const void*)trunk_fwd, NTHR, LDS_BYTES) != hipSuccess || per_cu < 1) fprintf(stderr, "kernel_launch: occupancy query says %d\n", per_cu);
        (void)hipGetLastError();
        grid = cus;
    }
    if (grid < 0) return;
    if (hipMemsetAsync((char*)d_ws + WS_CTL, 0, CTL_ZERO_BYTES, stream) != hipSuccess) return;
    Args a{};
    for (int i = 0; i < 32; ++i) a.in[i] = (const float*)d_in[i];
    a.out = (float*)d_out; a.ws = (unsigned char*)d_ws;
#if N_LAUNCH_MODE == 1
    a.ph_lo = 0; a.ph_hi = N_PHASES;
    hipLaunchKernelGGL(trunk_fwd, dim3(grid), dim3(NTHR), LDS_BYTES, stream, a);
#else
    for (int p = 0; p < N_PHASES; ++p) {
        const int pl = (p - 1) % PH_PER_LAYER;
#if !ENABLE_MIX
        if (p >= 1 && p < PH_FINAL && pl >= L_INPROJ && pl <= L_OUT) continue;
#endif
        a.ph_lo = p; a.ph_hi = p + 1;
        hipLaunchKernelGGL(trunk_fwd, dim3(grid), dim3(NTHR), LDS_BYTES, stream, a);
    }
#endif
}
```

```cpp
#include <hip/hip_runtime.h>
#include <cstdio>
#include <cstdint>

#ifndef N_LAUNCH_MODE
#define N_LAUNCH_MODE 1
#endif
#ifndef ENABLE_C
#define ENABLE_C 1
#endif
#ifndef ENABLE_D
#define ENABLE_D 1
#endif
#ifndef ENABLE_MIX
#define ENABLE_MIX 1
#endif

#define LAS __attribute__((address_space(3)))
#define GAS __attribute__((address_space(1)))
typedef unsigned short bf16_t;
typedef short bf16x8 __attribute__((ext_vector_type(8)));
typedef short bf16x4 __attribute__((ext_vector_type(4)));
typedef float f32x2 __attribute__((ext_vector_type(2)));
typedef float f32x4 __attribute__((ext_vector_type(4)));
typedef float f32x16 __attribute__((ext_vector_type(16)));
typedef unsigned u32x2 __attribute__((ext_vector_type(2)));
typedef unsigned u32x4 __attribute__((ext_vector_type(4)));

constexpr int D = 2048, NB = 8, SEQ = 2048, CTXL = 256, DEPTH = 2;
constexpr int NCTX = NB * CTXL, NLAT = NB * SEQ, NTOK = NCTX + NLAT;
constexpr int N1 = 11776, NG = 8192, INW = N1 + NG;
constexpr int NEXP = 16, DFF = 512;
constexpr int NWAVES = 8, NTHR = 512;
constexpr int C_AQ = 0, C_AK = 1024, C_AV = 1280, C_BQ = 1536, C_BK = 2560, C_BV = 3584, C_CX = 4608, C_CY = 5632, C_DQ = 6656, C_DFF = 7680, C_DFB = 8704, C_DI = 9728, C_DG = 10752;

constexpr size_t MiB = 1u << 20;
constexpr size_t WS_CTL = 0, CTL_ZERO_BYTES = 2 * MiB;
constexpr size_t WS_MOD = 1 * MiB;
constexpr size_t WS_WIN = 2 * MiB;
constexpr size_t WS_WBR = 158 * MiB;
constexpr size_t WS_WOUT = 190 * MiB;
constexpr size_t WS_WGU = 206 * MiB;
constexpr size_t WS_WD = 334 * MiB;
constexpr size_t WS_H = 398 * MiB;
constexpr size_t WS_Y = 470 * MiB;
constexpr size_t WS_P1 = 542 * MiB;
constexpr size_t WS_O = 956 * MiB;
constexpr size_t WS_XC = 1100 * MiB;
constexpr size_t WS_HID = 1116 * MiB;
constexpr size_t WS_LIST = 1152 * MiB;
constexpr size_t WS_RW = 1154 * MiB;
constexpr size_t WS_DSCR = 1156 * MiB;
constexpr size_t WS_HB = 1192 * MiB;
constexpr size_t WS_END = 1228 * MiB;
constexpr int CW_BAR = 4096;
constexpr int CW_CNT = 8192;
constexpr int CW_QUEUE = 8448;

constexpr int LDS_BYTES = 147456;
constexpr int MISC_OFF = 131072 + 8192;

typedef __bf16 bf16x2_t __attribute__((ext_vector_type(2)));
__device__ __forceinline__ unsigned cvt_pk_bf16(float lo, float hi) { const bf16x2_t r = __builtin_convertvector((f32x2){lo, hi}, bf16x2_t); return __builtin_bit_cast(unsigned, r); }
__device__ __forceinline__ float bf_lo(unsigned u) { return __uint_as_float(u << 16); }
__device__ __forceinline__ float bf_hi(unsigned u) { return __uint_as_float(u & 0xffff0000u); }
__device__ __forceinline__ float bf2f(bf16_t b) { return __uint_as_float(((unsigned)b) << 16); }
__device__ __forceinline__ float shx(float v, int mask, int lane) { return __builtin_bit_cast(float, __builtin_amdgcn_ds_bpermute((lane ^ mask) << 2, __builtin_bit_cast(int, v))); }
__device__ __forceinline__ float wave_sum(float v, int lane) {
#pragma unroll
    for (int o = 1; o < 64; o <<= 1) v += shx(v, o, lane);
    return v;
}
__device__ __forceinline__ float wave_max(float v, int lane) {
#pragma unroll
    for (int o = 1; o < 64; o <<= 1) v = fmaxf(v, shx(v, o, lane));
    return v;
}
__device__ __forceinline__ float sigmoidf_(float x) { return __builtin_amdgcn_rcpf(1.0f + __expf(-x)); }
#define LDS_WAIT() asm volatile("s_waitcnt lgkmcnt(0)" ::: "memory")
#define VM_WAIT() asm volatile("s_waitcnt vmcnt(0)" ::: "memory")

__device__ __forceinline__ int opaque_int(int x);
template <class T> __device__ __forceinline__ T* opaque_ptr(T* p) { return (T*)((unsigned char*)p + opaque_int(0)); }
__device__ __forceinline__ int opaque_int(int x) { asm volatile("" : "+v"(x)); return __builtin_amdgcn_readfirstlane(x); }
#define XB_TMO      128
#define XB_XCNT(j)  (256  + 64 * (j))
#define XB_XSUB(j)  (1280 + 64 * (j))
#define XB_XGEN(j)  (2304 + 64 * (j))
#define XB_TOP      3328
#define XB_TOPGEN   3392
#define XCD_BAR_WORDS 3456
#define XB_SPIN_CAP (1u << 22)
__device__ __forceinline__ unsigned xb_ld(unsigned* p)              { return __hip_atomic_load(p, __ATOMIC_RELAXED, __HIP_MEMORY_SCOPE_AGENT); }
__device__ __forceinline__ unsigned xb_add(unsigned* p, unsigned v) { return __hip_atomic_fetch_add(p, v, __ATOMIC_RELAXED, __HIP_MEMORY_SCOPE_AGENT); }
__device__ __forceinline__ unsigned xb_xcc_id() { return (unsigned)__builtin_amdgcn_s_getreg((3 << 11) | 20) & 0xFu; }
#define XB_SPIN(cond, bar) do { unsigned _sp = 0; while (cond) { __builtin_amdgcn_s_sleep(1); \
    if ((++_sp & 255u) == 0u) { if (xb_ld(&(bar)[XB_TMO])) break; if (_sp > XB_SPIN_CAP) { atomicAdd(&(bar)[XB_TMO], 1u); break; } } } } while (0)
struct XcdBarrier { unsigned* bar; unsigned x; volatile LAS unsigned* st; };
__device__ __forceinline__ XcdBarrier xcd_barrier_post(unsigned* bar, volatile LAS unsigned* st) {
    XcdBarrier b; b.bar = bar; b.x = xb_xcc_id(); b.st = st;
    if (threadIdx.x == 0) (void)xb_add(&bar[XB_XCNT(b.x)], 1u);
    return b;
}
__device__ __forceinline__ void xcd_barrier_complete(unsigned* bar, unsigned x, unsigned& nloc, unsigned& nx) {
    const unsigned G = gridDim.x * gridDim.y * gridDim.z;
    unsigned sum, cnt, mine, sp = 0u;
    for (;;) {
        sum = 0u; cnt = 0u; mine = 0u;
#pragma unroll
        for (unsigned j = 0; j < 16; ++j) { const unsigned c = xb_ld(&bar[XB_XCNT(j)]); sum += c; cnt += (c > 0u) ? 1u : 0u; mine = (j == x) ? c : mine; }
        if (sum == G) break;
        __builtin_amdgcn_s_sleep(1);
        if ((++sp & 255u) == 0u) { if (xb_ld(&bar[XB_TMO])) break; if (sp > XB_SPIN_CAP) { atomicAdd(&bar[XB_TMO], 1u); break; } }
    }
    nloc = mine > 0u ? mine : 1u; nx = cnt > 0u ? cnt : 1u;
}
__device__ __forceinline__ void xcd_barrier(const XcdBarrier& b) {
    asm volatile("s_waitcnt vmcnt(0)" ::: "memory");
    __syncthreads();
    if (threadIdx.x == 0) {
        unsigned* bar = opaque_ptr(b.bar);
        __builtin_amdgcn_s_waitcnt(0);
        unsigned nloc = b.st[0], nx = b.st[1];
        if (nloc == 0u) { xcd_barrier_complete(bar, b.x, nloc, nx); b.st[0] = nloc; b.st[1] = nx; }
        const unsigned old = xb_add(&bar[XB_XSUB(b.x)], 1u);
        const unsigned gen = old / nloc;
        if (old + 1u == (gen + 1u) * nloc) {
            __builtin_amdgcn_fence(__ATOMIC_RELEASE, "agent");
            asm volatile("s_waitcnt vmcnt(0)" ::: "memory");
            const unsigned og = xb_add(&bar[XB_TOP], 1u);
            const unsigned tg = og / nx;
            if (og + 1u == (tg + 1u) * nx) xb_add(&bar[XB_TOPGEN], 1u);
            else XB_SPIN(xb_ld(&bar[XB_TOPGEN]) == tg, bar);
            __builtin_amdgcn_fence(__ATOMIC_ACQUIRE, "agent");
            xb_add(&bar[XB_XGEN(b.x)], 1u);
            asm volatile("s_waitcnt vmcnt(0)" ::: "memory");
        } else {
            XB_SPIN(xb_ld(&bar[XB_XGEN(b.x)]) == gen, bar);
            __builtin_amdgcn_fence(__ATOMIC_ACQUIRE, "agent");
            asm volatile("s_waitcnt vmcnt(0)" ::: "memory");
        }
    }
    __syncthreads();
}

struct Args { const float* in[32]; float* out; unsigned char* ws; int ph_lo, ph_hi; };
struct Frame {
    LAS unsigned char* lds;
    const Args* a;
    unsigned char* ws; float* out;
    int tid, lane, wave, G, vcu;
};
#define FIN(k) (F.a->in[k])
#define F_x FIN(0)
#define F_c FIN(1)
#define F_ctx FIN(2)
#define F_cctx FIN(3)
#define F_w_ada FIN(4)
#define F_b_ada FIN(5)
#define F_norm1_g FIN(6)
#define F_norm2_g FIN(7)
#define F_w_in FIN(8)
#define F_qn_a FIN(9)
#define F_kn_a FIN(10)
#define F_sink_a FIN(11)
#define F_qn_b FIN(12)
#define F_kn_b FIN(13)
#define F_lam_b FIN(14)
#define F_subln_b FIN(15)
#define F_conv_w FIN(16)
#define F_conv_b FIN(17)
#define F_w_rg FIN(18)
#define F_b_rg FIN(19)
#define F_w_ig FIN(20)
#define F_b_ig FIN(21)
#define F_lru_lambda FIN(22)
#define F_lb_d FIN(23)
#define F_onorm_d FIN(24)
#define F_w_branch FIN(25)
#define F_w_out FIN(26)
#define F_w_router FIN(27)
#define F_b_router FIN(28)
#define F_w_gate FIN(29)
#define F_w_up FIN(30)
#define F_w_down FIN(31)
#define F_ctl ((unsigned*)(F.ws + WS_CTL))
#define F_MOD ((float*)(F.ws + WS_MOD))
#define F_WIN ((bf16_t*)(F.ws + WS_WIN))
#define F_WBR ((bf16_t*)(F.ws + WS_WBR))
#define F_WOUT ((bf16_t*)(F.ws + WS_WOUT))
#define F_WGU ((bf16_t*)(F.ws + WS_WGU))
#define F_WD ((bf16_t*)(F.ws + WS_WD))
#define F_H ((bf16_t*)(F.ws + WS_H))
#define F_Y ((bf16_t*)(F.ws + WS_Y))
#define F_P1 ((bf16_t*)(F.ws + WS_P1))
#define F_O ((bf16_t*)(F.ws + WS_O))
#define F_HID ((bf16_t*)(F.ws + WS_HID))
#define F_XC ((float*)(F.ws + WS_XC))
#define F_LIST ((unsigned*)(F.ws + WS_LIST))
#define F_RW ((float*)(F.ws + WS_RW))
__device__ __forceinline__ Frame phase_frame(const Frame& F) {
    Frame P = F;
    P.ws = opaque_ptr(F.ws); P.out = opaque_ptr(F.out);
    P.wave = opaque_int(F.wave); P.G = opaque_int(F.G); P.vcu = opaque_int(F.vcu);
    unsigned ln; asm volatile("v_mbcnt_lo_u32_b32 %0, -1, 0\n\tv_mbcnt_hi_u32_b32 %0, -1, %0" : "=v"(ln));
    P.lane = (int)ln; P.tid = P.wave * 64 + (int)ln;
    return P;
}
__device__ __forceinline__ int mod_index(int row) { return row < NCTX ? 8 : ((row - NCTX) >> 11); }
__device__ __forceinline__ float* xrow_ptr(const Frame& F, int row) { return row < NCTX ? F_XC + (size_t)row * D : F.out + (size_t)(row - NCTX) * D; }
__device__ __forceinline__ const float* xin_ptr(const Frame& F, int row) { return row < NCTX ? F_ctx + (size_t)row * D : F_x + (size_t)(row - NCTX) * D; }

__device__ __forceinline__ void p0_mod(const Frame& F) {
    LAS float* sl = (LAS float*)F.lds;
    LAS float* part = (LAS float*)(F.lds + 9 * D * 4);
    for (int idx = F.tid; idx < 9 * D; idx += NTHR) { const int i = idx >> 11, k = idx & (D - 1); const float v = (i < 8) ? F_c[i * D + k] : F_cctx[k]; sl[idx] = v / (1.0f + __expf(-v)); }
    __syncthreads();
    for (int it = F.vcu; it < DEPTH * 96; it += F.G) {
        const int l = it / 96, jb = it % 96;
        const float* w = F_w_ada + ((size_t)l * D + F.wave * 256) * (6 * D) + jb * 128 + F.lane * 2;
        f32x2 acc[9];
#pragma unroll
        for (int i = 0; i < 9; ++i) acc[i] = (f32x2){0.f, 0.f};
#pragma unroll 8
        for (int k = 0; k < 256; ++k) {
            const f32x2 wv = *(const f32x2*)(w + (size_t)k * (6 * D));
#pragma unroll
            for (int i = 0; i < 9; ++i) acc[i] += sl[i * D + F.wave * 256 + k] * wv;
        }
#pragma unroll
        for (int i = 0; i < 9; ++i) *(LAS f32x2*)(part + (F.wave * 9 + i) * 128 + F.lane * 2) = acc[i];
        __syncthreads();
        for (int idx = F.tid; idx < 9 * 128; idx += NTHR) { const int i = idx >> 7, cidx = idx & 127; float sum = F_b_ada[(size_t)l * 6 * D + jb * 128 + cidx];
#pragma unroll
            for (int wv = 0; wv < 8; ++wv) sum += part[(wv * 9 + i) * 128 + cidx];
            F_MOD[((size_t)(l * 9 + i)) * (6 * D) + jb * 128 + cidx] = sum; }
        __syncthreads();
    }
    __syncthreads();
}
__device__ __forceinline__ void tr_item(const float* W, int ldw, int k0, int n0, bf16_t* dst, int ldd, LAS float* scr, int lane) {
    float tv[32];
#pragma unroll
    for (int i = 0; i < 32; ++i) { const int kk = 2 * i + (lane >> 5); tv[i] = W[(size_t)(k0 + kk) * ldw + n0 + (lane & 31)]; }
#pragma unroll
    for (int i = 0; i < 32; ++i) { const int kk = 2 * i + (lane >> 5); scr[kk * 33 + (lane & 31)] = tv[i]; }
    LDS_WAIT(); asm volatile("" ::: "memory");
    const int c = lane & 7;
#pragma unroll
    for (int j = 0; j < 4; ++j) { const int n = (lane >> 3) + 8 * j; const LAS float* s = scr + (8 * c) * 33 + n;
        u32x4 o; o.x = cvt_pk_bf16(s[0 * 33], s[1 * 33]); o.y = cvt_pk_bf16(s[2 * 33], s[3 * 33]); o.z = cvt_pk_bf16(s[4 * 33], s[5 * 33]); o.w = cvt_pk_bf16(s[6 * 33], s[7 * 33]);
        *(u32x4*)(dst + (size_t)n * ldd + k0 + 8 * c) = o; }
    LDS_WAIT(); asm volatile("" ::: "memory");
}
__device__ __forceinline__ void p0_weights(const Frame& F) {
    LAS float* scr = (LAS float*)(F.lds + F.wave * 8704);
    const int gw = F.vcu * NWAVES + F.wave, NGW = F.G * NWAVES;
    constexpr int I_IN = 32 * 624, I_BR = 16 * 64, I_OUT = 32 * 64, I_G = 32 * 16, I_D = 8 * 64;
    constexpr int S0 = DEPTH * I_IN, S1 = S0 + DEPTH * 4 * I_BR, S2 = S1 + DEPTH * I_OUT, S3 = S2 + DEPTH * NEXP * I_G, S4 = S3 + DEPTH * NEXP * I_G, S5 = S4 + DEPTH * NEXP * I_D;
    for (int it = gw; it < S5; it += NGW) {
        if (it < S0) { const int l = it / I_IN, r = it % I_IN, kb = r / 624, nb = r % 624;
            tr_item(F_w_in + (size_t)l * D * INW, INW, kb * 64, nb * 32, F_WIN + ((size_t)l * INW + nb * 32) * D, D, scr, F.lane); }
        else if (it < S1) { const int q = it - S0, m = q / I_BR, r = q % I_BR, kb = r / 64, nb = r % 64;
            tr_item(F_w_branch + (size_t)m * 1024 * D, D, kb * 64, nb * 32, F_WBR + ((size_t)m * D + nb * 32) * 1024, 1024, scr, F.lane); }
        else if (it < S2) { const int q = it - S1, l = q / I_OUT, r = q % I_OUT, kb = r / 64, nb = r % 64;
            tr_item(F_w_out + (size_t)l * D * D, D, kb * 64, nb * 32, F_WOUT + ((size_t)l * D + nb * 32) * D, D, scr, F.lane); }
        else if (it < S4) { const bool up = it >= S3; const int q = it - (up ? S3 : S2), m = q / I_G, r = q % I_G, kb = r / 16, nb = r % 16;
            const int n0 = nb * 32, drow = 256 * (n0 >> 7) + (n0 & 127) + (up ? 128 : 0);
            tr_item((up ? F_w_up : F_w_gate) + (size_t)m * D * DFF, DFF, kb * 64, n0, F_WGU + ((size_t)m * 1024 + drow) * D, D, scr, F.lane); }
        else { const int q = it - S4, m = q / I_D, r = q % I_D, kb = r / 64, nb = r % 64;
            tr_item(F_w_down + (size_t)m * DFF * D, D, kb * 64, nb * 32, F_WD + ((size_t)m * D + nb * 32) * DFF, DFF, scr, F.lane); }
    }
    __syncthreads();
}
__device__ __forceinline__ void p0_copy_x(const Frame& F) {
    const size_t gt = (size_t)F.vcu * NTHR + F.tid, NGT = (size_t)F.G * NTHR;
    for (size_t i = gt; i < (size_t)NTOK * D / 4; i += NGT) { const int row = (int)(i / (D / 4)); const int c4 = (int)(i % (D / 4));
        *((f32x4*)xrow_ptr(F, row) + c4) = *((const f32x4*)xin_ptr(F, row) + c4); }
}

template <int WHICH>
__device__ __forceinline__ void norm_phase(const Frame& F, int l) {
    const int gw = F.vcu * NWAVES + F.wave, NGW = F.G * NWAVES, lane = F.lane;
    LAS float* wrT = (LAS float*)F.lds;
    if (WHICH == 2) {
        for (int idx = F.tid; idx < D * NEXP; idx += NTHR) { const int e = idx >> 11, col = idx & (D - 1); wrT[idx] = F_w_router[col * NEXP + e]; }
        if (F.tid < 16) ((LAS unsigned*)(F.lds + 131072))[F.tid] = 0u;
        __syncthreads();
    }
    LAS unsigned* lcnt = (LAS unsigned*)(F.lds + 131072); LAS unsigned* lbase = lcnt + 16; LAS int* lrec = (LAS int*)(F.lds + 131072 + 256);
    int nrec = 0;
    const int row_lo = (WHICH == 3 || (WHICH == 2 && l == DEPTH - 1)) ? NCTX : 0;
    const bf16_t* Y2 = F_O;
    for (int row = row_lo + gw; row < NTOK; row += NGW) {
        const int mi = mod_index(row);
        f32x4 v[8];
        float* xr = xrow_ptr(F, row);
        if (WHICH == 1 && l == 0) { const float* xi = xin_ptr(F, row);
#pragma unroll
            for (int j = 0; j < 8; ++j) v[j] = *(const f32x4*)(xi + 4 * lane + 256 * j);
        } else {
#pragma unroll
            for (int j = 0; j < 8; ++j) v[j] = *(const f32x4*)(xr + 4 * lane + 256 * j);
        }
        if ((WHICH == 1 && l > 0) || WHICH == 3) {
            const int lp = (WHICH == 3) ? DEPTH - 1 : l - 1;
            const float* g2 = F_MOD + ((size_t)(lp * 9 + mi)) * (6 * D) + 5 * D;
            const f32x2 rw = *(const f32x2*)(F_RW + 2 * (size_t)row);
            const bf16_t* ya = Y2 + (size_t)(2 * row) * D; const bf16_t* yb = ya + D;
#pragma unroll
            for (int j = 0; j < 8; ++j) { const int col = 4 * lane + 256 * j; const f32x4 g = *(const f32x4*)(g2 + col);
                const u32x2 a = *(const u32x2*)(ya + col), b = *(const u32x2*)(yb + col);
                v[j].x += g.x * (rw.x * bf_lo(a.x) + rw.y * bf_lo(b.x)); v[j].y += g.y * (rw.x * bf_hi(a.x) + rw.y * bf_hi(b.x));
                v[j].z += g.z * (rw.x * bf_lo(a.y) + rw.y * bf_lo(b.y)); v[j].w += g.w * (rw.x * bf_hi(a.y) + rw.y * bf_hi(b.y));
                *(f32x4*)(xr + col) = v[j]; }
        }
        if (WHICH == 3) continue;
        float ss = 0.f;
#pragma unroll
        for (int j = 0; j < 8; ++j) ss += (v[j].x * v[j].x + v[j].y * v[j].y) + (v[j].z * v[j].z + v[j].w * v[j].w);
        const float rinv = rsqrtf(wave_sum(ss, lane) * (1.0f / D) + 1e-6f);
        const float* gn = (WHICH == 1 ? F_norm1_g : F_norm2_g) + (size_t)l * D;
        const float* md = F_MOD + ((size_t)(l * 9 + mi)) * (6 * D) + (WHICH == 1 ? 0 : 3) * D;
        bf16_t* hr = F_H + (size_t)row * D;
#pragma unroll
        for (int j = 0; j < 8; ++j) { const int col = 4 * lane + 256 * j; const f32x4 g = *(const f32x4*)(gn + col), sh = *(const f32x4*)(md + col), sc = *(const f32x4*)(md + D + col);
            v[j].x = v[j].x * rinv * g.x * (1.0f + sc.x) + sh.x; v[j].y = v[j].y * rinv * g.y * (1.0f + sc.y) + sh.y;
            v[j].z = v[j].z * rinv * g.z * (1.0f + sc.z) + sh.z; v[j].w = v[j].w * rinv * g.w * (1.0f + sc.w) + sh.w;
            u32x2 o; o.x = cvt_pk_bf16(v[j].x, v[j].y); o.y = cvt_pk_bf16(v[j].z, v[j].w); *(u32x2*)(hr + col) = o; }
        if (WHICH == 2) {
            float lg[NEXP];
#pragma unroll
            for (int e = 0; e < NEXP; ++e) { float a = 0.f;
#pragma unroll
                for (int j = 0; j < 8; ++j) { const f32x4 w = *(const LAS f32x4*)(wrT + e * D + 4 * lane + 256 * j); a += (v[j].x * w.x + v[j].y * w.y) + (v[j].z * w.z + v[j].w * w.w); }
                lg[e] = wave_sum(a, lane); }
            float aff[NEXP], sel[NEXP];
#pragma unroll
            for (int e = 0; e < NEXP; ++e) { aff[e] = 1.0f / (1.0f + expf(-lg[e])); sel[e] = aff[e] + F_b_router[e]; }
            int grp = 0; float best = -1e30f;
#pragma unroll
            for (int g = 0; g < 4; ++g) { float m1 = -1e30f, m2 = -1e30f;
#pragma unroll
                for (int q = 0; q < 4; ++q) { const float s = sel[4 * g + q]; if (s > m1) { m2 = m1; m1 = s; } else if (s > m2) m2 = s; }
                const float gs = m1 + m2; if (gs > best) { best = gs; grp = g; } }
            int i0 = 0, i1 = 0; float s0 = -1e30f, s1 = -1e30f, a0 = 0.f, a1 = 0.f;
#pragma unroll
            for (int g = 0; g < 4; ++g)
#pragma unroll
                for (int q = 0; q < 4; ++q) { const float s = sel[4 * g + q], a = aff[4 * g + q]; const bool in = (g == grp);
                    if (in && s > s0) { s1 = s0; i1 = i0; a1 = a0; s0 = s; i0 = 4 * g + q; a0 = a; } else if (in && s > s1) { s1 = s; i1 = 4 * g + q; a1 = a; } }
            if (lane == 0) {
                const float inv = 1.0f / (a0 + a1);
                *(f32x2*)(F_RW + 2 * (size_t)row) = (f32x2){a0 * inv, a1 * inv};
                LAS int* rec = lrec + (F.wave * 16 + nrec) * 4;
                rec[0] = i0; rec[1] = i1; rec[2] = (int)__hip_atomic_fetch_add(lcnt + i0, 1u, __ATOMIC_RELAXED, __HIP_MEMORY_SCOPE_WORKGROUP); rec[3] = (int)__hip_atomic_fetch_add(lcnt + i1, 1u, __ATOMIC_RELAXED, __HIP_MEMORY_SCOPE_WORKGROUP);
            }
            ++nrec;
        }
    }
    if (WHICH == 2) {
        __syncthreads();
        if (F.tid < 16) lbase[F.tid] = atomicAdd(F_ctl + CW_CNT + 64 * l + F.tid, lcnt[F.tid]);
        __syncthreads();
        if (lane < nrec) { const int row = row_lo + gw + lane * NGW; const LAS int* rec = lrec + (F.wave * 16 + lane) * 4; const int i0 = rec[0], i1 = rec[1];
            F_LIST[(size_t)i0 * NTOK + lbase[i0] + rec[2]] = 2u * row; F_LIST[(size_t)i1 * NTOK + lbase[i1] + rec[3]] = 2u * row + 1u; }
        __syncthreads();
    }
}

__device__ __forceinline__ constexpr int bitrev5(int v) { return ((v & 1) << 4) | ((v & 2) << 2) | (v & 4) | ((v & 8) >> 2) | ((v & 16) >> 4); }
__device__ __forceinline__ void norm2_phase(const Frame& F, int l) {
    const int gw = F.vcu * NWAVES + F.wave, NGW = F.G * NWAVES, lane = F.lane;
    LAS float* wrT = (LAS float*)F.lds;
    for (int idx = F.tid; idx < D * NEXP; idx += NTHR) { const int e = idx >> 11, col = idx & (D - 1); wrT[idx] = F_w_router[col * NEXP + e]; }
    LAS unsigned* lcnt = (LAS unsigned*)(F.lds + 131072); LAS unsigned* lbase = lcnt + 16; LAS int* lrec = (LAS int*)(F.lds + 131072 + 256);
    if (F.tid < 16) lcnt[F.tid] = 0u;
    int nrec = 0;
    __syncthreads();
    const int row_lo = (l == DEPTH - 1) ? NCTX : 0;
    float brt[NEXP];
#pragma unroll
    for (int e = 0; e < NEXP; ++e) brt[e] = F_b_router[e];
    for (int row0 = row_lo + 2 * gw; row0 < NTOK; row0 += 2 * NGW) {
        const int mi = mod_index(row0);
        f32x4 v[2][8];
#pragma unroll
        for (int r = 0; r < 2; ++r) { const float* xr = xrow_ptr(F, row0 + r);
#pragma unroll
            for (int j = 0; j < 8; ++j) v[r][j] = *(const f32x4*)(xr + 4 * lane + 256 * j); }
        float ss0 = 0.f, ss1 = 0.f;
#pragma unroll
        for (int j = 0; j < 8; ++j) { ss0 += (v[0][j].x * v[0][j].x + v[0][j].y * v[0][j].y) + (v[0][j].z * v[0][j].z + v[0][j].w * v[0][j].w); ss1 += (v[1][j].x * v[1][j].x + v[1][j].y * v[1][j].y) + (v[1][j].z * v[1][j].z + v[1][j].w * v[1][j].w); }
        const float rinv[2] = {rsqrtf(wave_sum(ss0, lane) * (1.0f / D) + 1e-6f), rsqrtf(wave_sum(ss1, lane) * (1.0f / D) + 1e-6f)};
        const float* gn = F_norm2_g + (size_t)l * D;
        const float* md = F_MOD + ((size_t)(l * 9 + mi)) * (6 * D) + 3 * D;
#pragma unroll
        for (int j = 0; j < 8; ++j) { const int col = 4 * lane + 256 * j; const f32x4 g = *(const f32x4*)(gn + col), sh = *(const f32x4*)(md + col), sc = *(const f32x4*)(md + D + col);
#pragma unroll
            for (int r = 0; r < 2; ++r) { f32x4& q = v[r][j];
                q.x = q.x * rinv[r] * g.x * (1.0f + sc.x) + sh.x; q.y = q.y * rinv[r] * g.y * (1.0f + sc.y) + sh.y; q.z = q.z * rinv[r] * g.z * (1.0f + sc.z) + sh.z; q.w = q.w * rinv[r] * g.w * (1.0f + sc.w) + sh.w;
                u32x2 o; o.x = cvt_pk_bf16(q.x, q.y); o.y = cvt_pk_bf16(q.z, q.w); *(u32x2*)(F_H + (size_t)(row0 + r) * D + col) = o; } }
        float x[32];
#pragma unroll
        for (int e = 0; e < NEXP; ++e) { float a0 = 0.f, a1 = 0.f;
#pragma unroll
            for (int j = 0; j < 8; ++j) { const f32x4 w = *(const LAS f32x4*)(wrT + e * D + 4 * lane + 256 * j);
                a0 += (v[0][j].x * w.x + v[0][j].y * w.y) + (v[0][j].z * w.z + v[0][j].w * w.w); a1 += (v[1][j].x * w.x + v[1][j].y * w.y) + (v[1][j].z * w.z + v[1][j].w * w.w); }
            x[e] = a0; x[16 + e] = a1; }
#pragma unroll
        for (int k = 0; k < 5; ++k) { const int half = 16 >> k; const bool bit = (lane >> k) & 1;
#pragma unroll
            for (int i = 0; i < half; ++i) { const float send = bit ? x[i] : x[i + half], keep = bit ? x[i + half] : x[i]; x[i] = keep + shx(send, 1 << k, lane); } }
        const float tot = x[0] + shx(x[0], 32, lane);
        const float affv = 1.0f / (1.0f + expf(-tot));
#pragma unroll
        for (int r = 0; r < 2; ++r) {
            float aff[NEXP], sel[NEXP];
#pragma unroll
            for (int e = 0; e < NEXP; ++e) { aff[e] = __builtin_bit_cast(float, __builtin_amdgcn_readlane(__builtin_bit_cast(int, affv), bitrev5(r * 16 + e))); sel[e] = aff[e] + brt[e]; }
            int grp = 0; float best = -1e30f;
#pragma unroll
            for (int g = 0; g < 4; ++g) { float m1 = -1e30f, m2 = -1e30f;
#pragma unroll
                for (int q = 0; q < 4; ++q) { const float s = sel[4 * g + q]; if (s > m1) { m2 = m1; m1 = s; } else if (s > m2) m2 = s; }
                const float gs = m1 + m2; if (gs > best) { best = gs; grp = g; } }
            int i0 = 0, i1 = 0; float s0 = -1e30f, s1 = -1e30f, a0 = 0.f, a1 = 0.f;
#pragma unroll
            for (int g = 0; g < 4; ++g)
#pragma unroll
                for (int q = 0; q < 4; ++q) { const float s = sel[4 * g + q], a = aff[4 * g + q]; const bool in = (g == grp);
                    if (in && s > s0) { s1 = s0; i1 = i0; a1 = a0; s0 = s; i0 = 4 * g + q; a0 = a; } else if (in && s > s1) { s1 = s; i1 = 4 * g + q; a1 = a; } }
            if (lane == 0) { const int row = row0 + r;
                const float inv = 1.0f / (a0 + a1);
                *(f32x2*)(F_RW + 2 * (size_t)row) = (f32x2){a0 * inv, a1 * inv};
                LAS int* rec = lrec + (F.wave * 16 + nrec) * 4;
                rec[0] = i0; rec[1] = i1; rec[2] = (int)__hip_atomic_fetch_add(lcnt + i0, 1u, __ATOMIC_RELAXED, __HIP_MEMORY_SCOPE_WORKGROUP); rec[3] = (int)__hip_atomic_fetch_add(lcnt + i1, 1u, __ATOMIC_RELAXED, __HIP_MEMORY_SCOPE_WORKGROUP); }
            ++nrec;
        }
    }
    __syncthreads();
    if (F.tid < 16) lbase[F.tid] = atomicAdd(F_ctl + CW_CNT + 64 * l + F.tid, lcnt[F.tid]);
    __syncthreads();
    if (lane < nrec) { const int row = row_lo + 2 * gw + (lane >> 1) * 2 * NGW + (lane & 1); const LAS int* rec = lrec + (F.wave * 16 + lane) * 4; const int i0 = rec[0], i1 = rec[1];
        F_LIST[(size_t)i0 * NTOK + lbase[i0] + rec[2]] = 2u * row; F_LIST[(size_t)i1 * NTOK + lbase[i1] + rec[3]] = 2u * row + 1u; }
    __syncthreads();
}

namespace g8 {
constexpr int BM = 256, BK = 64, HALF = 128, HTB = HALF * BK * 2, STAGE_BYTES = 8 * HTB;
__device__ __forceinline__ int lds_byte(int r, int c) { const int st = (r >> 4) * 2 + (c >> 5), rr = r & 15, cc = c & 31, ob = rr * 64 + cc * 2; return st * 1024 + (ob ^ (((ob >> 9) & 1) << 5)); }
__device__ __forceinline__ void stage_rc(int b, int& R, int& C) { const int st = b / 1024, sb = b % 1024, swz = sb ^ (((sb >> 9) & 1) << 5); R = (st >> 1) * 16 + swz / 64; C = (st & 1) * 32 + (swz % 64) / 2; }
__device__ __forceinline__ int perm32(int rho) { const int n = rho >> 4, i = rho & 15; return 8 * (i >> 2) + 4 * n + (i & 3); }
__device__ __forceinline__ void tile_order(int L, int nM, int nN, int& pm, int& pn) {
    const int nwg = nM * nN; int wgid = L;
    { const int q = nwg / 8, r = nwg % 8, xcd = wgid % 8, off = wgid / 8; wgid = (xcd < r ? xcd * (q + 1) : r * (q + 1) + (xcd - r) * q) + off; }
    const int nig = 8 * nN, gid = wgid / nig, fm = gid * 8, gsz = (nM - fm) < 8 ? (nM - fm) : 8;
    pm = fm + ((wgid % nig) % gsz); pn = (wgid % nig) / gsz;
}
struct GU { int pm, pn, aux, valid; const char* A; const char* B; };

template <class P>
__device__ __forceinline__ void gemm_phase(LAS unsigned char* lds, const P& S, const int tid) {
    const int wid = __builtin_amdgcn_readfirstlane(tid >> 6), lane = tid & 63, wr = wid >> 2, wc = wid & 3, fr = lane & 15, fq = lane >> 4;
    const int K = S.K, nt = K / BK;
    const unsigned lda = S.lda, ldb = S.ldb;
    int Rr[2], Cc[2]; unsigned voffB[2];
#pragma unroll
    for (int i = 0; i < 2; ++i) { stage_rc(tid * 16 + i * 8192, Rr[i], Cc[i]); const int Rb = P::PERM ? ((Rr[i] & ~31) + perm32(Rr[i] & 31)) : Rr[i]; voffB[i] = (unsigned)Rb * ldb + (unsigned)Cc[i] * 2u; }
    unsigned offA[2][2], offAn[2][2];
#pragma unroll
    for (int h = 0; h < 2; ++h)
#pragma unroll
        for (int i = 0; i < 2; ++i) { offA[h][i] = (unsigned)(h * HALF + Rr[i]) * lda + (unsigned)Cc[i] * 2u; offAn[h][i] = offA[h][i]; }
    const size_t kstep = (size_t)(BK * 2);
    const size_t hstepB = (size_t)HALF * ldb;
    const unsigned ldsw = (unsigned)wid * 1024u;
    const int aoff = lds_byte(wr * 64 + fr, fq * 8), boff = lds_byte(wc * 32 + fr, fq * 8);
#define G8_SA(b, h) (((b) * 2 + (h)) * HTB)
#define G8_SB(b, h) ((4 + (b) * 2 + (h)) * HTB)
#define G8_STAGE_A(bufoff, gbase, offs, h) do { _Pragma("unroll") for (int _i = 0; _i < 2; ++_i) \
        __builtin_amdgcn_global_load_lds((const unsigned*)((const char*)(gbase) + (offs)[h][_i]), (LAS unsigned*)(lds + (bufoff) + ldsw + _i * 8192), 16, 0, 0); } while (0)
#define G8_STAGE_B(bufoff, gbase) do { _Pragma("unroll") for (int _i = 0; _i < 2; ++_i) \
        __builtin_amdgcn_global_load_lds((const unsigned*)((const char*)(gbase) + voffB[_i]), (LAS unsigned*)(lds + (bufoff) + ldsw + _i * 8192), 16, 0, 0); } while (0)
#define G8_LDA(dst, b, h) do { _Pragma("unroll") for (int m = 0; m < 4; ++m) _Pragma("unroll") for (int k = 0; k < 2; ++k) dst[m][k] = *(const LAS bf16x8*)(lds + G8_SA(b, h) + aoff + m * 2048 + k * 1024); } while (0)
#define G8_LDB(dst, b, h) do { _Pragma("unroll") for (int n = 0; n < 2; ++n) _Pragma("unroll") for (int k = 0; k < 2; ++k) dst[n][k] = *(const LAS bf16x8*)(lds + G8_SB(b, h) + boff + n * 2048 + k * 1024); } while (0)
#define G8_MMA(ai, bj, At, Bt) do { __builtin_amdgcn_s_setprio(1); _Pragma("unroll") for (int m = 0; m < 4; ++m) _Pragma("unroll") for (int n = 0; n < 2; ++n) _Pragma("unroll") for (int k = 0; k < 2; ++k) \
        acc[ai][bj][m][n] = __builtin_amdgcn_mfma_f32_16x16x32_bf16(Bt[n][k], At[m][k], acc[ai][bj][m][n], 0, 0, 0); __builtin_amdgcn_s_setprio(0); } while (0)
#define G8_WAIT_V(n) asm volatile("s_waitcnt vmcnt(" #n ")" ::: "memory")
#define G8_WAIT_L(n) asm volatile("s_waitcnt lgkmcnt(" #n ")" ::: "memory")
#define G8_BAR __builtin_amdgcn_s_barrier()
#define G8_SCHED __builtin_amdgcn_sched_barrier(0)
    GU cur, nxt; int ui = 0;
    if (!S.next(0, cur)) return;
    if constexpr (P::GATHER) { S.rows(cur, offA); asm volatile("" : "+v"(offA[0][0]), "+v"(offA[0][1]), "+v"(offA[1][0]), "+v"(offA[1][1])); }
    f32x4 acc[2][2][4][2];
#pragma unroll
    for (int a = 0; a < 2; ++a)
#pragma unroll
        for (int b = 0; b < 2; ++b)
#pragma unroll
            for (int m = 0; m < 4; ++m)
#pragma unroll
                for (int n = 0; n < 2; ++n) acc[a][b][m][n] = (f32x4){0.f, 0.f, 0.f, 0.f};
    bf16x8 At[4][2], B0[2][2], B1[2][2];
    const char* cA = cur.A; const char* cB = cur.B;
    G8_STAGE_B(G8_SB(0, 0), cB); G8_STAGE_A(G8_SA(0, 0), cA, offA, 0); G8_STAGE_B(G8_SB(0, 1), cB + hstepB); G8_STAGE_A(G8_SA(0, 1), cA, offA, 1);
    if (wr == 1) G8_BAR;
    G8_WAIT_V(4); G8_BAR;
    G8_STAGE_B(G8_SB(1, 0), cB + kstep); G8_STAGE_A(G8_SA(1, 0), cA + kstep, offA, 0); G8_STAGE_B(G8_SB(1, 1), cB + hstepB + kstep);
    G8_WAIT_V(6); G8_BAR;
    for (;;) {
        const bool has_next = S.next(ui + 1, nxt);
        const char* nA = has_next ? nxt.A : cA; const char* nB = has_next ? nxt.B : cB;
        if constexpr (P::GATHER) {
            if (has_next) S.rows(nxt, offAn);
            else {
#pragma unroll
                for (int h = 0; h < 2; ++h)
#pragma unroll
                    for (int i = 0; i < 2; ++i) offAn[h][i] = offA[h][i]; }
            asm volatile("" : "+v"(offAn[0][0]), "+v"(offAn[0][1]), "+v"(offAn[1][0]), "+v"(offAn[1][1]));
        }
        for (int t = 0; t < nt; t += 2) {
            const bool last = (t == nt - 2);
            const char* a1 = cA + (size_t)(t + 1) * kstep;
            const char* a2 = last ? nA : cA + (size_t)(t + 2) * kstep; const char* b2 = last ? nB : cB + (size_t)(t + 2) * kstep;
            const char* a3 = a2 + kstep; const char* b3 = b2 + kstep;
            unsigned o2[2][2];
#pragma unroll
            for (int h = 0; h < 2; ++h)
#pragma unroll
                for (int i = 0; i < 2; ++i) o2[h][i] = (P::GATHER && last) ? offAn[h][i] : offA[h][i];
            G8_LDB(B0, 0, 0); G8_SCHED; G8_LDA(At, 0, 0); G8_STAGE_A(G8_SA(1, 1), a1, offA, 1);
            G8_WAIT_L(8); G8_BAR; G8_WAIT_L(0); G8_MMA(0, 0, At, B0); G8_BAR; G8_SCHED;
            G8_LDB(B1, 0, 1); G8_STAGE_B(G8_SB(0, 0), b2);
            G8_BAR; G8_WAIT_L(0); G8_MMA(0, 1, At, B1); G8_BAR;
            G8_LDA(At, 0, 1); G8_STAGE_A(G8_SA(0, 0), a2, o2, 0);
            G8_BAR; G8_WAIT_L(0); G8_MMA(1, 0, At, B0); G8_BAR; G8_SCHED;
            G8_STAGE_B(G8_SB(0, 1), b2 + hstepB);
            G8_WAIT_V(6); G8_BAR; G8_MMA(1, 1, At, B1); G8_BAR;
            G8_LDB(B0, 1, 0); G8_SCHED; G8_LDA(At, 1, 0); G8_STAGE_A(G8_SA(0, 1), a2, o2, 1);
            G8_WAIT_L(8); G8_BAR; G8_WAIT_L(0); G8_MMA(0, 0, At, B0); G8_BAR; G8_SCHED;
            G8_LDB(B1, 1, 1); G8_STAGE_B(G8_SB(1, 0), b3);
            G8_BAR; G8_WAIT_L(0); G8_MMA(0, 1, At, B1); G8_BAR;
            G8_LDA(At, 1, 1); G8_STAGE_A(G8_SA(1, 0), a3, o2, 0);
            G8_BAR; G8_WAIT_L(0); G8_MMA(1, 0, At, B0); G8_BAR; G8_SCHED;
            G8_STAGE_B(G8_SB(1, 1), b3 + hstepB);
            G8_WAIT_V(6); G8_BAR; G8_MMA(1, 1, At, B1); G8_BAR;
        }
        S.epi(acc, cur, wr, wc, fr, fq);
        if (!has_next) break;
#pragma unroll
        for (int a = 0; a < 2; ++a)
#pragma unroll
            for (int b = 0; b < 2; ++b)
#pragma unroll
                for (int m = 0; m < 4; ++m)
#pragma unroll
                    for (int n = 0; n < 2; ++n) acc[a][b][m][n] = (f32x4){0.f, 0.f, 0.f, 0.f};
        cur = nxt; cA = nA; cB = nB; ++ui;
        if constexpr (P::GATHER) {
#pragma unroll
            for (int h = 0; h < 2; ++h)
#pragma unroll
                for (int i = 0; i < 2; ++i) offA[h][i] = offAn[h][i]; }
    }
    G8_WAIT_V(0);
    if (wr == 0) G8_BAR;
    G8_BAR;
#undef G8_SA
#undef G8_SB
#undef G8_STAGE_A
#undef G8_STAGE_B
#undef G8_LDA
#undef G8_LDB
#undef G8_MMA
#undef G8_WAIT_V
#undef G8_WAIT_L
#undef G8_BAR
#undef G8_SCHED
}
}

struct PolDenseBf16 {
    static constexpr bool PERM = true, GATHER = false;
    int K; unsigned lda, ldb;
    const char* A; const char* B; bf16_t* C; int ldc; int nM, nN, pm0, G, c;
    __device__ __forceinline__ bool next(int i, g8::GU& u) const {
        const int L = i * G + c; if (L >= nM * nN) return false;
        g8::tile_order(L, nM, nN, u.pm, u.pn); u.pm += pm0; u.aux = 0; u.valid = 256;
        u.A = A + (size_t)u.pm * 256 * lda; u.B = B + (size_t)u.pn * 256 * ldb; return true;
    }
    __device__ __forceinline__ void epi(const f32x4 (&acc)[2][2][4][2], const g8::GU& u, int wr, int wc, int fr, int fq) const {
        const int row0 = u.pm * 256 + wr * 64 + fr, col0 = u.pn * 256 + wc * 32 + 8 * fq;
#pragma unroll
        for (int ai = 0; ai < 2; ++ai)
#pragma unroll
            for (int m = 0; m < 4; ++m) { bf16_t* rowp = C + (size_t)(row0 + ai * 128 + m * 16) * ldc + col0;
#pragma unroll
                for (int bj = 0; bj < 2; ++bj) { const f32x4 v0 = acc[ai][bj][m][0], v1 = acc[ai][bj][m][1];
                    u32x4 w; w.x = cvt_pk_bf16(v0[0], v0[1]); w.y = cvt_pk_bf16(v0[2], v0[3]); w.z = cvt_pk_bf16(v1[0], v1[1]); w.w = cvt_pk_bf16(v1[2], v1[3]);
                    *(u32x4*)(rowp + bj * 128) = w; } }
    }
};
template <int WHICH>
struct PolMoe {
    static constexpr bool PERM = true, GATHER = (WHICH == 1);
    int K; unsigned lda, ldb;
    const char* A; const char* Bw; bf16_t* C; const unsigned* list; int nN, G, c;
    int tid; LAS int* tab;
    __device__ __forceinline__ void init(const unsigned* cntw) {
        if (tid == 0) { int nt = 0;
            for (int e = 0; e < NEXP; ++e) { const int ce = (int)cntw[e];
                for (int t = 0; t * 256 < ce; ++t) { tab[4 + 4 * nt] = e; tab[5 + 4 * nt] = e * NTOK + t * 256; tab[6 + 4 * nt] = (ce - t * 256) < 256 ? (ce - t * 256) : 256; ++nt; } }
            tab[0] = nt; }
        __syncthreads();
    }
    __device__ __forceinline__ bool next(int i, g8::GU& u) const {
        const int L = i * G + c; if (L >= __builtin_amdgcn_readfirstlane(tab[0]) * nN) return false;
        const int mt = L / nN; u.pn = L % nN;
        const int e = __builtin_amdgcn_readfirstlane(tab[4 + 4 * mt]); u.pm = __builtin_amdgcn_readfirstlane(tab[5 + 4 * mt]); u.valid = __builtin_amdgcn_readfirstlane(tab[6 + 4 * mt]); u.aux = mt;
        u.A = (WHICH == 1) ? A : A + (size_t)mt * 256 * lda; u.B = Bw + ((size_t)e * (WHICH == 1 ? 1024 : D) + (size_t)u.pn * 256) * ldb; return true;
    }
    __device__ __forceinline__ unsigned slot_of(const g8::GU& u, int r) const { const int rr = r < u.valid ? r : 0; return list[u.pm + rr]; }
    __device__ __forceinline__ void rows(const g8::GU& u, unsigned (&off)[2][2]) const {
#pragma unroll
        for (int i = 0; i < 2; ++i) { int R, C; g8::stage_rc(tid * 16 + i * 8192, R, C);
#pragma unroll
            for (int h = 0; h < 2; ++h) { const unsigned s = slot_of(u, h * 128 + R); off[h][i] = (s >> 1) * lda + (unsigned)C * 2u; } }
    }
    __device__ __forceinline__ void epi(const f32x4 (&acc)[2][2][4][2], const g8::GU& u, int wr, int wc, int fr, int fq) const {
        if (WHICH == 1) {
#pragma unroll
            for (int ai = 0; ai < 2; ++ai)
#pragma unroll
                for (int m = 0; m < 4; ++m) { const int r = ai * 128 + wr * 64 + m * 16 + fr;
                    const f32x4 g0 = acc[ai][0][m][0], g1 = acc[ai][0][m][1], u0 = acc[ai][1][m][0], u1 = acc[ai][1][m][1];
                    float h[8];
#pragma unroll
                    for (int q = 0; q < 4; ++q) { h[q] = g0[q] * sigmoidf_(g0[q]) * u0[q]; h[4 + q] = g1[q] * sigmoidf_(g1[q]) * u1[q]; }
                    u32x4 w; w.x = cvt_pk_bf16(h[0], h[1]); w.y = cvt_pk_bf16(h[2], h[3]); w.z = cvt_pk_bf16(h[4], h[5]); w.w = cvt_pk_bf16(h[6], h[7]);
                    *(u32x4*)(C + ((size_t)u.aux * 256 + r) * DFF + u.pn * 128 + wc * 32 + 8 * fq) = w; }
        } else {
            unsigned sl[2][4];
#pragma unroll
            for (int ai = 0; ai < 2; ++ai)
#pragma unroll
                for (int m = 0; m < 4; ++m) sl[ai][m] = slot_of(u, ai * 128 + wr * 64 + m * 16 + fr);
#pragma unroll
            for (int ai = 0; ai < 2; ++ai)
#pragma unroll
                for (int m = 0; m < 4; ++m) { const int r = ai * 128 + wr * 64 + m * 16 + fr; const bool ok = r < u.valid;
#pragma unroll
                    for (int bj = 0; bj < 2; ++bj) { const f32x4 v0 = acc[ai][bj][m][0], v1 = acc[ai][bj][m][1];
                        u32x4 w; w.x = cvt_pk_bf16(v0[0], v0[1]); w.y = cvt_pk_bf16(v0[2], v0[3]); w.z = cvt_pk_bf16(v1[0], v1[1]); w.w = cvt_pk_bf16(v1[2], v1[3]);
                        if (ok) *(u32x4*)(C + (size_t)sl[ai][m] * D + u.pn * 256 + bj * 128 + wc * 32 + 8 * fq) = w; } }
        }
    }
};

struct PolMerge {
    static constexpr bool PERM = true, GATHER = false;
    int K; unsigned lda, ldb;
    const char* A; const char* B; bf16_t* Gt; bf16_t* Yo; int nM, pm0, G, c;
    __device__ __forceinline__ bool next(int i, g8::GU& u) const {
        const int L = (i >> 2) * G + c; if (L >= nM * 8) return false;
        g8::tile_order(L, nM, 8, u.pm, u.pn); u.pm += pm0; u.aux = i & 3; u.valid = 256;
        u.A = A + (size_t)u.pm * 256 * lda + (size_t)u.aux * 2048; u.B = B + ((size_t)u.aux * D + (size_t)u.pn * 256) * ldb; return true;
    }
    __device__ __forceinline__ void epi(const f32x4 (&acc)[2][2][4][2], const g8::GU& u, int wr, int wc, int fr, int fq) const {
        const int row0 = u.pm * 256 + wr * 64 + fr, col0 = u.pn * 256 + wc * 32 + 8 * fq, n = u.aux;
#pragma unroll
        for (int ai = 0; ai < 2; ++ai) {
            u32x4 gv[4][2]; unsigned long long pq[4][2][2];
#pragma unroll
            for (int m = 0; m < 4; ++m)
#pragma unroll
                for (int bj = 0; bj < 2; ++bj) { const bf16_t* gp = Gt + (size_t)(row0 + ai * 128 + m * 16) * NG + n * D + col0 + bj * 128;
                    gv[m][bj] = *(const u32x4*)gp;
                    if (n > 0) { const u32x4 pv = *(const u32x4*)(gp - D); pq[m][bj][0] = (unsigned long long)pv.x | ((unsigned long long)pv.y << 32); pq[m][bj][1] = (unsigned long long)pv.z | ((unsigned long long)pv.w << 32); }
                    else { pq[m][bj][0] = 0ull; pq[m][bj][1] = 0ull; } }
#pragma unroll
            for (int m = 0; m < 4; ++m) { bf16_t* grow = Gt + (size_t)(row0 + ai * 128 + m * 16) * NG + n * D + col0;
#pragma unroll
                for (int bj = 0; bj < 2; ++bj) { const f32x4 v0 = acc[ai][bj][m][0], v1 = acc[ai][bj][m][1]; const u32x4 g = gv[m][bj];
                    const unsigned p0 = (unsigned)pq[m][bj][0], p1 = (unsigned)(pq[m][bj][0] >> 32), p2 = (unsigned)pq[m][bj][1], p3 = (unsigned)(pq[m][bj][1] >> 32);
                    float r[8];
                    r[0] = v0[0] * sigmoidf_(bf_lo(g.x)) + bf_lo(p0); r[1] = v0[1] * sigmoidf_(bf_hi(g.x)) + bf_hi(p0); r[2] = v0[2] * sigmoidf_(bf_lo(g.y)) + bf_lo(p1); r[3] = v0[3] * sigmoidf_(bf_hi(g.y)) + bf_hi(p1);
                    r[4] = v1[0] * sigmoidf_(bf_lo(g.z)) + bf_lo(p2); r[5] = v1[1] * sigmoidf_(bf_hi(g.z)) + bf_hi(p2); r[6] = v1[2] * sigmoidf_(bf_lo(g.w)) + bf_lo(p3); r[7] = v1[3] * sigmoidf_(bf_hi(g.w)) + bf_hi(p3);
                    u32x4 w; w.x = cvt_pk_bf16(r[0], r[1]); w.y = cvt_pk_bf16(r[2], r[3]); w.z = cvt_pk_bf16(r[4], r[5]); w.w = cvt_pk_bf16(r[6], r[7]);
                    if (n < 3) *(u32x4*)(grow + bj * 128) = w;
                    else *(u32x4*)(Yo + (size_t)(row0 + ai * 128 + m * 16) * D + col0 + bj * 128) = w; } }
            asm volatile("" ::: "memory");
        }
    }
};
struct PolOut {
    static constexpr bool PERM = false, GATHER = false;
    int K; unsigned lda, ldb;
    const char* A; const char* B; const float* xin_c; const float* xin_l; float* xout_c; float* xout_l; const float* mod_l; int nM, pm0, G, c;
    __device__ __forceinline__ bool next(int i, g8::GU& u) const {
        const int L = i * G + c; if (L >= nM * 8) return false;
        g8::tile_order(L, nM, 8, u.pm, u.pn); u.pm += pm0; u.aux = 0; u.valid = 256;
        u.A = A + (size_t)u.pm * 256 * lda; u.B = B + (size_t)u.pn * 256 * ldb; return true;
    }
    __device__ __forceinline__ void epi(const f32x4 (&acc)[2][2][4][2], const g8::GU& u, int wr, int wc, int fr, int fq) const {
        const bool isc = u.pm < 8;
        const int mi = isc ? 8 : ((u.pm - 8) >> 3);
        const int lrow0 = (isc ? u.pm * 256 : (u.pm - 8) * 256) + wr * 64 + fr, col0 = u.pn * 256 + wc * 32 + 4 * fq;
        const float* xi = isc ? xin_c : xin_l; float* xo = isc ? xout_c : xout_l;
        const float* g1 = mod_l + (size_t)mi * (6 * D) + 2 * D + col0;
        f32x4 gv[2][2];
#pragma unroll
        for (int bj = 0; bj < 2; ++bj)
#pragma unroll
            for (int n = 0; n < 2; ++n) gv[bj][n] = *(const f32x4*)(g1 + bj * 128 + n * 16);
#pragma unroll
        for (int ai = 0; ai < 2; ++ai) {
            f32x4 xv[4][2][2];
#pragma unroll
            for (int m = 0; m < 4; ++m) { const size_t off = (size_t)(lrow0 + ai * 128 + m * 16) * D + col0;
#pragma unroll
                for (int bj = 0; bj < 2; ++bj)
#pragma unroll
                    for (int n = 0; n < 2; ++n) xv[m][bj][n] = *(const f32x4*)(xi + off + bj * 128 + n * 16); }
#pragma unroll
            for (int m = 0; m < 4; ++m) { const size_t off = (size_t)(lrow0 + ai * 128 + m * 16) * D + col0;
#pragma unroll
                for (int bj = 0; bj < 2; ++bj)
#pragma unroll
                    for (int n = 0; n < 2; ++n) *(f32x4*)(xo + off + bj * 128 + n * 16) = xv[m][bj][n] + gv[bj][n] * acc[ai][bj][m][n]; }
            asm volatile("" ::: "memory");
        }
    }
};

constexpr float LOG2E = 1.4426950408889634f;
constexpr int NKEY = CTXL + SEQ;
#define F_KB ((bf16_t*)(F.ws + WS_Y))
#define F_VTB ((bf16_t*)(F.ws + WS_Y + 36 * MiB))
#define F_KA ((bf16_t*)(F.ws + WS_HID))
#define F_VTA ((bf16_t*)(F.ws + WS_HID + 9 * MiB))
__device__ __forceinline__ void prep_phase(const Frame& F, int l) {
    const int gw = F.vcu * NWAVES + F.wave, NGW = F.G * NWAVES, lane = F.lane;
    bf16_t* P1 = F_P1;
    const f32x2 gqa = *(const f32x2*)(F_qn_a + l * 128 + 2 * lane), gka = *(const f32x2*)(F_kn_a + l * 128 + 2 * lane);
    const f32x2 gqb = *(const f32x2*)(F_qn_b + l * 64 + ((2 * lane) & 63)), gkb = *(const f32x2*)(F_kn_b + l * 64 + ((2 * lane) & 63));
    const float invA0 = exp2f(-(float)((2 * lane) & 31) * (13.287712379549449f / 32.0f)), invA1 = exp2f(-(float)((2 * lane + 1) & 31) * (13.287712379549449f / 32.0f));
    const float invB0 = exp2f(-(float)((2 * lane) & 15) * (13.287712379549449f / 16.0f)), invB1 = exp2f(-(float)((2 * lane + 1) & 15) * (13.287712379549449f / 16.0f));
    const float sgnA = (lane & 16) ? 1.f : -1.f, sgnB = (lane & 8) ? 1.f : -1.f;
    for (int row = gw; row < NTOK; row += NGW) {
        const bool isc = row < NCTX; const int b = isc ? (row >> 8) : ((row - NCTX) >> 11), t = isc ? (row & 255) : ((row - NCTX) & 2047);
        const int key = isc ? t : CTXL + t;
        const float prow = (float)(t >> 6), pcol = (float)(t & 63);
        bf16_t* pr = P1 + (size_t)row * N1;
        unsigned raw[26];
#pragma unroll
        for (int hh = 0; hh < 10; ++hh) raw[hh] = *(const unsigned*)(pr + (hh < 8 ? C_AQ + hh * 128 : C_AK + (hh - 8) * 128) + 2 * lane);
#pragma unroll
        for (int hh = 0; hh < 16; ++hh) raw[10 + hh] = *(const unsigned*)(pr + (hh < 8 ? C_BQ : C_BK) + (hh & 7) * 128 + 2 * lane);
        float cA0 = 1.f, sA0 = 0.f, cA1 = 1.f, sA1 = 0.f, cB0 = 1.f, sB0 = 0.f, cB1 = 1.f, sB1 = 0.f;
        if (!isc) { const float pa = (lane & 32) ? pcol : prow, pb = (lane & 16) ? pcol : prow;
            sincosf(pa * invA0, &sA0, &cA0); sincosf(pa * invA1, &sA1, &cA1); sincosf(pb * invB0, &sB0, &cB0); sincosf(pb * invB1, &sB1, &cB1); }
#pragma unroll
        for (int hh = 0; hh < 10; ++hh) {
            const bool isq = hh < 8;
            float a0 = bf_lo(raw[hh]), a1 = bf_hi(raw[hh]);
            const float rinv = rsqrtf(wave_sum(a0 * a0 + a1 * a1, lane) * (1.0f / 128.0f) + 1e-6f);
            a0 *= rinv * (isq ? gqa.x : gka.x); a1 *= rinv * (isq ? gqa.y : gka.y);
            const float p0 = shx(a0, 16, lane), p1 = shx(a1, 16, lane);
            float o0 = a0 * cA0 + sgnA * p0 * sA0, o1 = a1 * cA1 + sgnA * p1 * sA1;
            if (isq) { const float sc = 0.08838834764831845f * LOG2E; o0 *= sc; o1 *= sc; }
            bf16_t* dst = isq ? pr + C_AQ + hh * 128 : F_KA + (((size_t)(b * 2 + (hh - 8)) * NKEY + key) * 128);
            *(unsigned*)(dst + 2 * lane) = cvt_pk_bf16(o0, o1);
        }
#pragma unroll
        for (int hh = 0; hh < 16; ++hh) {
            const bool isq = hh < 8; const int h = hh & 7;
            float a0 = bf_lo(raw[10 + hh]), a1 = bf_hi(raw[10 + hh]);
            float ss = a0 * a0 + a1 * a1;
#pragma unroll
            for (int o = 1; o < 32; o <<= 1) ss += shx(ss, o, lane);
            const float rinv = rsqrtf(ss * (1.0f / 64.0f) + 1e-6f);
            a0 *= rinv * (isq ? gqb.x : gkb.x); a1 *= rinv * (isq ? gqb.y : gkb.y);
            const float p0 = shx(a0, 8, lane), p1 = shx(a1, 8, lane);
            float o0 = a0 * cB0 + sgnB * p0 * sB0, o1 = a1 * cB1 + sgnB * p1 * sB1;
            if (isq) { const float sc = 0.125f * LOG2E; o0 *= sc; o1 *= sc; }
            bf16_t* dst = isq ? pr + C_BQ + h * 128 : F_KB + (((size_t)(b * 8 + h) * NKEY + key) * 128);
            *(unsigned*)(dst + 2 * lane) = cvt_pk_bf16(o0, o1);
        }
    }
    for (int it = gw; it < 288 * 40; it += NGW) {
        const int tile = it / 40, q = it % 40; const bool isA = q < 8; const int head = isA ? (q >> 2) : ((q - 8) >> 2), slab = q & 3;
        const bool isc = tile < 32; const int b = isc ? (tile >> 2) : ((tile - 32) >> 5), t0 = isc ? ((tile & 3) * 64) : (((tile - 32) & 31) * 64);
        const int row = (isc ? b * CTXL : NCTX + b * SEQ) + t0 + lane, key = (isc ? 0 : CTXL) + t0 + lane;
        const bf16_t* src = P1 + (size_t)row * N1 + (isA ? C_AV : C_BV) + head * 128 + slab * 32;
        u32x4 v[4];
#pragma unroll
        for (int j = 0; j < 4; ++j) v[j] = *(const u32x4*)(src + 8 * j);
        const int keyp = (key & ~12) | ((key & 8) >> 1) | ((key & 4) << 1);
        bf16_t* dst = (isA ? F_VTA + ((size_t)(b * 2 + head) * 128 + slab * 32) * NKEY : F_VTB + ((size_t)(b * 8 + head) * 128 + slab * 32) * NKEY) + keyp;
#pragma unroll
        for (int j = 0; j < 4; ++j) { const unsigned w[4] = {v[j].x, v[j].y, v[j].z, v[j].w};
#pragma unroll
            for (int e = 0; e < 4; ++e) { dst[(size_t)(8 * j + 2 * e) * NKEY] = (bf16_t)(w[e] & 0xffffu); dst[(size_t)(8 * j + 2 * e + 1) * NKEY] = (bf16_t)(w[e] >> 16); } }
    }
}

constexpr int AT_KBYTES = 64 * 256, AT_VBYTES = 128 * 128, AT_BUF = AT_KBYTES + AT_VBYTES, AT_XCH = 2 * AT_BUF;
struct AttnUnit { bool isA, isc; int b, h, qt; };
template <bool IS_A>
__device__ __forceinline__ void attn_unit(const Frame& F, int l, const AttnUnit u) {
    constexpr int NS = IS_A ? 8 : 4;
    const int tid = F.tid, lane = F.lane, w = F.wave, r = lane & 31, h5 = lane >> 5;
    LAS unsigned char* lds = F.lds;
    int t, head, dofs, qcol0;
    if (IS_A) { const int g = w >> 1, qb = w & 1; t = u.qt * 64 + 32 * qb + r; head = u.h * 4 + g; dofs = 0; qcol0 = C_AQ + head * 128; }
    else { const int comp = w >> 2, qb = w & 3; t = u.qt * 128 + 32 * qb + r; head = u.h; dofs = comp * 64; qcol0 = C_BQ + head * 128 + comp * 64; }
    const int qrow = (u.isc ? u.b * CTXL : NCTX + u.b * SEQ) + t;
    const int nhk = IS_A ? 2 : 8;
    const bf16_t* Kb = (IS_A ? F_KA : F_KB) + (size_t)(u.b * nhk + u.h) * NKEY * 128;
    const bf16_t* Vt = (IS_A ? F_VTA : F_VTB) + (size_t)(u.b * nhk + u.h) * 128 * NKEY;
    int lt_lo = 0, ntile;
    if (u.isc) ntile = 4;
    else if (IS_A) { lt_lo = u.qt - 2 < 0 ? 0 : u.qt - 2; const int lt_hi = u.qt + 2 > 31 ? 31 : u.qt + 2; ntile = 4 + lt_hi - lt_lo + 1; }
    else ntile = 36;
    const int wu = __builtin_amdgcn_readfirstlane(w);
    auto tile_of = [&](int j) -> int { return (IS_A && !u.isc && j >= 4) ? 4 + lt_lo + (j - 4) : j; };
    auto dma = [&](int kt, int buf) {
#pragma unroll
        for (int i = 0; i < 2; ++i) { const int blk = 2 * wu + i; const int row = 4 * blk + (lane >> 4); const int c = (lane & 15) ^ (row & 15);
            __builtin_amdgcn_global_load_lds((const unsigned*)((const unsigned char*)Kb + ((size_t)(kt * 64 + row)) * 256 + c * 16), (LAS unsigned*)(lds + buf * AT_BUF + blk * 1024), 16, 0, 0); }
#pragma unroll
        for (int i = 0; i < 2; ++i) { const int blk = 2 * wu + i; const int row = 8 * blk + (lane >> 3); const int c = (lane & 7) ^ ((row >> 1) & 7);
            __builtin_amdgcn_global_load_lds((const unsigned*)((const unsigned char*)Vt + (size_t)row * (NKEY * 2) + kt * 128 + c * 16), (LAS unsigned*)(lds + buf * AT_BUF + AT_KBYTES + blk * 1024), 16, 0, 0); }
    };
    dma(tile_of(0), 0);
    float bound2, sinkp = 0.f;
    if (IS_A) { const float gq = wave_max(fmaxf(fabsf(F_qn_a[l * 128 + lane]), fabsf(F_qn_a[l * 128 + 64 + lane])), lane), gk = wave_max(fmaxf(fabsf(F_kn_a[l * 128 + lane]), fabsf(F_kn_a[l * 128 + 64 + lane])), lane);
        bound2 = LOG2E * 11.313708498984761f * gq * gk; sinkp = exp2f(F_sink_a[l * 8 + head] * LOG2E - bound2); }
    else { const float gq = wave_max(fabsf(F_qn_b[l * 64 + lane]), lane), gk = wave_max(fabsf(F_kn_b[l * 64 + lane]), lane); bound2 = LOG2E * 8.0f * gq * gk; }
    bf16x8 qf[NS];
    { const bf16_t* qp = F_P1 + (size_t)qrow * N1 + qcol0 + 8 * h5;
#pragma unroll
        for (int s = 0; s < NS; ++s) qf[s] = *(const bf16x8*)(qp + 16 * s); }
    f32x16 oacc[4];
#pragma unroll
    for (int i = 0; i < 4; ++i)
#pragma unroll
        for (int j = 0; j < 16; ++j) oacc[i][j] = 0.f;
    float lsum = 0.f;
    const int koff0 = r * 256 + (((dofs >> 3) + h5) ^ (r & 15)) * 16;
    const int voff0 = r * 128 + (h5 ^ ((r >> 1) & 7)) * 16;
    asm volatile("s_waitcnt vmcnt(0)" ::: "memory");
    __syncthreads();
    for (int j = 0; j < ntile; ++j) {
        const int kt = tile_of(j);
        if (j + 1 < ntile) dma(tile_of(j + 1), (j + 1) & 1);
        const LAS unsigned char* kb = lds + (j & 1) * AT_BUF; const LAS unsigned char* vb = kb + AT_KBYTES;
        const bool band = IS_A && !u.isc && kt >= 4;
        const int kpos0 = (kt - 4) * 64;
        bf16x8 kf[NS]; u32x4 vf[8];
        auto kread = [&](int sub) {
#pragma unroll
            for (int s = 0; s < NS; ++s) kf[s] = *(const LAS bf16x8*)(kb + 8192 * sub + (koff0 ^ (32 * s))); };
        auto vread = [&](int sub) {
#pragma unroll
            for (int dvt = 0; dvt < 4; ++dvt)
#pragma unroll
                for (int s2 = 0; s2 < 2; ++s2) vf[2 * dvt + s2] = *(const LAS u32x4*)(vb + 4096 * dvt + (voff0 ^ (64 * sub + 32 * s2))); };
        kread(0);
        vread(0);
        __builtin_amdgcn_sched_barrier(0);
#pragma unroll
        for (int sub = 0; sub < 2; ++sub) {
            f32x16 sacc;
#pragma unroll
            for (int i = 0; i < 16; ++i) sacc[i] = -bound2;
#pragma unroll
            for (int s = 0; s < NS; ++s) sacc = __builtin_amdgcn_mfma_f32_32x32x16_bf16(kf[s], qf[s], sacc, 0, 0, 0);
            float p[16];
#pragma unroll
            for (int i = 0; i < 16; ++i) { float e = __builtin_amdgcn_exp2f(sacc[i]);
                if (band) { const int kpos = kpos0 + 32 * sub + (i & 3) + 8 * (i >> 2) + 4 * h5; const int dlt = kpos - t; e = (dlt <= 128 && dlt >= -128) ? e : 0.f; }
                p[i] = e; lsum += e; }
            bf16x8 pb[2];
#pragma unroll
            for (int s2 = 0; s2 < 2; ++s2) { u32x4 pk; pk.x = cvt_pk_bf16(p[8 * s2 + 0], p[8 * s2 + 1]); pk.y = cvt_pk_bf16(p[8 * s2 + 2], p[8 * s2 + 3]); pk.z = cvt_pk_bf16(p[8 * s2 + 4], p[8 * s2 + 5]); pk.w = cvt_pk_bf16(p[8 * s2 + 6], p[8 * s2 + 7]);
                pb[s2] = __builtin_bit_cast(bf16x8, pk); }
            __builtin_amdgcn_sched_barrier(0);
            if (sub == 0) { kread(1); __builtin_amdgcn_sched_barrier(0); }
#pragma unroll
            for (int dvt = 0; dvt < 4; ++dvt)
#pragma unroll
                for (int s2 = 0; s2 < 2; ++s2) oacc[dvt] = __builtin_amdgcn_mfma_f32_32x32x16_bf16(__builtin_bit_cast(bf16x8, vf[2 * dvt + s2]), pb[s2], oacc[dvt], 0, 0, 0);
            __builtin_amdgcn_sched_barrier(0);
            if (sub == 0) { vread(1); __builtin_amdgcn_sched_barrier(0); }
        }
        asm volatile("s_waitcnt vmcnt(0)" ::: "memory");
        __syncthreads();
    }
    float ltot = lsum + shx(lsum, 32, lane) + sinkp;
    const float linv = 1.0f / ltot;
    bf16_t* orow = F_O + (size_t)qrow * 4096;
    if (IS_A) {
#pragma unroll
        for (int dvt = 0; dvt < 4; ++dvt)
#pragma unroll
            for (int g = 0; g < 4; ++g) { u32x2 o; o.x = cvt_pk_bf16(oacc[dvt][4 * g] * linv, oacc[dvt][4 * g + 1] * linv); o.y = cvt_pk_bf16(oacc[dvt][4 * g + 2] * linv, oacc[dvt][4 * g + 3] * linv);
                *(u32x2*)(orow + head * 128 + 32 * dvt + 8 * g + 4 * h5) = o; }
    } else {
        LAS float* xch = (LAS float*)(lds + AT_XCH) + (w & 3) * 4096;
        if (w >= 4) {
#pragma unroll
            for (int dvt = 0; dvt < 4; ++dvt)
#pragma unroll
                for (int i = 0; i < 16; ++i) xch[(dvt * 16 + i) * 64 + lane] = oacc[dvt][i] * linv;
        }
        __syncthreads();
        if (w < 4) {
            const float* lb = F_lam_b + l * 256;
            const float d1 = wave_sum(lb[lane] * lb[64 + lane], lane), d2 = wave_sum(lb[128 + lane] * lb[192 + lane], lane);
            const float lam_init = 0.8f - 0.6f * expf(-0.3f * (float)l), lam = expf(d1) - expf(d2) + lam_init;
            float ss = 0.f;
#pragma unroll
            for (int dvt = 0; dvt < 4; ++dvt)
#pragma unroll
                for (int i = 0; i < 16; ++i) { const float d = oacc[dvt][i] * linv - lam * xch[(dvt * 16 + i) * 64 + lane]; oacc[dvt][i] = d; ss += d * d; }
            ss += shx(ss, 32, lane);
            const float rn = rsqrtf(ss * (1.0f / 128.0f) + 1e-6f) * (1.0f - lam_init);
            const float* sg = F_subln_b + l * 128;
#pragma unroll
            for (int dvt = 0; dvt < 4; ++dvt)
#pragma unroll
                for (int g = 0; g < 4; ++g) { const int dv = 32 * dvt + 8 * g + 4 * h5; const f32x4 gg = *(const f32x4*)(sg + dv);
                    u32x2 o; o.x = cvt_pk_bf16(oacc[dvt][4 * g] * rn * gg.x, oacc[dvt][4 * g + 1] * rn * gg.y); o.y = cvt_pk_bf16(oacc[dvt][4 * g + 2] * rn * gg.z, oacc[dvt][4 * g + 3] * rn * gg.w);
                    *(u32x2*)(orow + 1024 + head * 128 + dv) = o; }
        }
    }
}
__device__ __forceinline__ float gelu_tanh(float x) { const float z = 0.7978845608028654f * (x + 0.044715f * x * x * x); const float e = __expf(2.0f * z); return 0.5f * x * (2.0f - 2.0f / (1.0f + e)); }
#define F_HB ((bf16_t*)(F.ws + WS_HB))
__device__ __forceinline__ void lru_unit(const Frame& F, int l, int b, int blk, int d) {
    const int tid = F.tid, lane = F.lane, w = F.wave, ch = tid & 127, tq = tid >> 7, fr = lane & 15, fq = lane >> 4;
    LAS float* U = (LAS float*)F.lds;
    LAS bf16_t* Ub = (LAS bf16_t*)(F.lds + 32768);
    LAS f32x2* AV = (LAS f32x2*)(F.lds + 32768 + 17408);
    LAS f32x2* SEG = (LAS f32x2*)(F.lds + 32768 + 17408 + 65536);
    LAS float* HC = (LAS float*)(F.lds + 32768 + 17408 + 65536 + 4096);
    const bf16_t* P1 = F_P1;
    const int cg = blk * 128 + ch;
    const float cw0 = F_conv_w[(l * 4 + 0) * 1024 + cg], cw1 = F_conv_w[(l * 4 + 1) * 1024 + cg], cw2 = F_conv_w[(l * 4 + 2) * 1024 + cg], cw3 = F_conv_w[(l * 4 + 3) * 1024 + cg], cb = F_conv_b[l * 1024 + cg];
    const bool ctx_out = l < DEPTH - 1;
    bf16_t* hout = (d == 0) ? F_O + 2048 + cg : F_HB + cg; const size_t hstride = (d == 0) ? 4096 : 1024;
    bf16x8 wr[4], wi[4];
    { const float* wrp = F_w_rg + ((size_t)((l * 2 + d) * 8 + blk) * 128) * 128 + 16 * w + fr; const float* wip = F_w_ig + ((size_t)((l * 2 + d) * 8 + blk) * 128) * 128 + 16 * w + fr;
#pragma unroll
        for (int ks = 0; ks < 4; ++ks) { u32x4 a, c2; const int c0 = 32 * ks + 8 * fq;
            a.x = cvt_pk_bf16(wrp[(c0 + 0) * 128], wrp[(c0 + 1) * 128]); a.y = cvt_pk_bf16(wrp[(c0 + 2) * 128], wrp[(c0 + 3) * 128]); a.z = cvt_pk_bf16(wrp[(c0 + 4) * 128], wrp[(c0 + 5) * 128]); a.w = cvt_pk_bf16(wrp[(c0 + 6) * 128], wrp[(c0 + 7) * 128]);
            c2.x = cvt_pk_bf16(wip[(c0 + 0) * 128], wip[(c0 + 1) * 128]); c2.y = cvt_pk_bf16(wip[(c0 + 2) * 128], wip[(c0 + 3) * 128]); c2.z = cvt_pk_bf16(wip[(c0 + 4) * 128], wip[(c0 + 5) * 128]); c2.w = cvt_pk_bf16(wip[(c0 + 6) * 128], wip[(c0 + 7) * 128]);
            wr[ks] = __builtin_bit_cast(bf16x8, a); wi[ks] = __builtin_bit_cast(bf16x8, c2); } }
    const int cj = blk * 128 + 16 * w + fr;
    const float br = F_b_rg[(l * 2 + d) * 1024 + cj], bi = F_b_ig[(l * 2 + d) * 1024 + cj];
    const float sp8 = 8.0f * log1pf(expf(-F_lru_lambda[(l * 2 + d) * 1024 + cj]));
    if (tid < 128) HC[tid] = 0.f;
    auto geom = [&](int step, int& rowbase, int& t0, int& seglen) { const bool isc = step < 4; const int idx = isc ? step : step - 4, nch = isc ? 4 : 32, ci = (d == 0) ? idx : nch - 1 - idx; t0 = ci * 64; seglen = isc ? CTXL : SEQ; rowbase = isc ? b * CTXL : NCTX + b * SEQ; };
    unsigned short xr[19];
    auto ldraw = [&](int step) { int rowbase, t0, seglen; geom(step, rowbase, t0, seglen); const int ts = t0 + tq * 16;
#pragma unroll
        for (int i = 0; i < 19; ++i) { const int t = ts - 2 + i; xr[i] = (t >= 0 && t < seglen) ? P1[(size_t)(rowbase + t) * N1 + C_CX + cg] : (unsigned short)0; } };
    ldraw(0);
    for (int step = 0; step < 36; ++step) {
        int rowbase, t0, seglen; geom(step, rowbase, t0, seglen);
        const bool isc = step < 4;
#pragma unroll
        for (int tt = 0; tt < 16; ++tt) { const float u = cb + cw0 * bf2f(xr[tt]) + cw1 * bf2f(xr[tt + 1]) + cw2 * bf2f(xr[tt + 2]) + cw3 * bf2f(xr[tt + 3]);
            U[(tq * 16 + tt) * 128 + ch] = u; Ub[(tq * 16 + tt) * 136 + ch] = (bf16_t)(cvt_pk_bf16(u, 0.f) & 0xffffu); }
        __syncthreads();
        if (step + 1 < 36) ldraw(step + 1);
#pragma unroll
        for (int mt = 0; mt < 4; ++mt) { f32x4 ar = (f32x4){0.f, 0.f, 0.f, 0.f}, ai = ar;
#pragma unroll
            for (int ks = 0; ks < 4; ++ks) { const bf16x8 a = *(const LAS bf16x8*)(Ub + (16 * mt + fr) * 136 + 32 * ks + 8 * fq);
                ar = __builtin_amdgcn_mfma_f32_16x16x32_bf16(a, wr[ks], ar, 0, 0, 0); ai = __builtin_amdgcn_mfma_f32_16x16x32_bf16(a, wi[ks], ai, 0, 0, 0); }
#pragma unroll
            for (int rg = 0; rg < 4; ++rg) { const int tok = 16 * mt + 4 * fq + rg, cl = 16 * w + fr;
                const float r = sigmoidf_(ar[rg] + br), ig = sigmoidf_(ai[rg] + bi); const float a_ = __expf(-sp8 * r);
                const float v = __builtin_amdgcn_sqrtf(fmaxf(1.0f - a_ * a_, 0.f)) * ig * U[tok * 128 + cl]; AV[tok * 128 + cl] = (f32x2){a_, v}; } }
        __syncthreads();
        float hl[16], cp[16];
        { float h = 0.f, pr = 1.f;
#pragma unroll
            for (int i = 0; i < 16; ++i) { const int p = 16 * tq + i, tok = (d == 0) ? p : 63 - p; const f32x2 av = AV[tok * 128 + ch]; h = av.x * h + av.y; pr *= av.x; hl[i] = h; cp[i] = pr; }
            SEG[tq * 128 + ch] = (f32x2){pr, h}; }
        __syncthreads();
        { float carry = HC[ch];
#pragma unroll
            for (int sg = 0; sg < 3; ++sg) { const f32x2 ps = SEG[sg * 128 + ch]; carry = (sg < tq) ? ps.x * carry + ps.y : carry; }
            const bool wr_out = !isc || ctx_out;
#pragma unroll
            for (int i = 0; i < 16; ++i) { const float h = hl[i] + cp[i] * carry; hl[i] = h;
                if (wr_out) { const int p = 16 * tq + i, tok = (d == 0) ? p : 63 - p; hout[(size_t)(rowbase + t0 + tok) * hstride] = (bf16_t)(cvt_pk_bf16(h, 0.f) & 0xffffu); } }
            __syncthreads();
            if (tq == 3) HC[ch] = hl[15]; }
    }
    __syncthreads();
}
__device__ __forceinline__ void lru_finish(const Frame& F, int l) {
    const size_t gt = (size_t)F.vcu * NTHR + F.tid, NGT = (size_t)F.G * NTHR;
    const size_t row_lo = (l == DEPTH - 1) ? NCTX : 0;
    for (size_t i = row_lo * 128 + gt; i < (size_t)NTOK * 128; i += NGT) { const size_t row = i >> 7; const int c8 = (int)(i & 127) * 8;
        bf16_t* op = F_O + row * 4096 + 2048 + c8;
        const u32x4 hf = *(const u32x4*)op, hb = *(const u32x4*)(F_HB + row * 1024 + c8), yv = *(const u32x4*)(F_P1 + row * N1 + C_CY + c8);
        u32x4 o;
        o.x = cvt_pk_bf16((bf_lo(hf.x) + bf_lo(hb.x)) * gelu_tanh(bf_lo(yv.x)), (bf_hi(hf.x) + bf_hi(hb.x)) * gelu_tanh(bf_hi(yv.x)));
        o.y = cvt_pk_bf16((bf_lo(hf.y) + bf_lo(hb.y)) * gelu_tanh(bf_lo(yv.y)), (bf_hi(hf.y) + bf_hi(hb.y)) * gelu_tanh(bf_hi(yv.y)));
        o.z = cvt_pk_bf16((bf_lo(hf.z) + bf_lo(hb.z)) * gelu_tanh(bf_lo(yv.z)), (bf_hi(hf.z) + bf_hi(hb.z)) * gelu_tanh(bf_hi(yv.z)));
        o.w = cvt_pk_bf16((bf_lo(hf.w) + bf_lo(hb.w)) * gelu_tanh(bf_lo(yv.w)), (bf_hi(hf.w) + bf_hi(hb.w)) * gelu_tanh(bf_hi(yv.w)));
        *(u32x4*)op = o; }
}

template <int KT>
__device__ __forceinline__ void gla_decay(f32x4& s, const float dA, const float dB) {
    const int src = __builtin_bit_cast(int, KT < 4 ? dA : dB);
    constexpr int L0 = 4 * (KT & 3);
    s[0] *= __builtin_bit_cast(float, __builtin_amdgcn_update_dpp(0, src, 0x150 + L0 + 0, 0xf, 0xf, false));
    s[1] *= __builtin_bit_cast(float, __builtin_amdgcn_update_dpp(0, src, 0x150 + L0 + 1, 0xf, 0xf, false));
    s[2] *= __builtin_bit_cast(float, __builtin_amdgcn_update_dpp(0, src, 0x150 + L0 + 2, 0xf, 0xf, false));
    s[3] *= __builtin_bit_cast(float, __builtin_amdgcn_update_dpp(0, src, 0x150 + L0 + 3, 0xf, 0xf, false));
}
#define F_DSCR ((bf16_t*)(F.ws + WS_DSCR))
__device__ __forceinline__ void gla_unit(const Frame& F, int l, int b, int h, int d) {
    const int tid = F.tid, lane = F.lane, w = F.wave, kk_ = tid & 127, sc_ = tid >> 7, fr = lane & 15, fq = lane >> 4;
    LAS bf16_t* Qt = (LAS bf16_t*)F.lds;
    LAS bf16_t* Kh = (LAS bf16_t*)(F.lds + 17408);
    LAS bf16_t* KtT = (LAS bf16_t*)(F.lds + 34816);
    LAS bf16_t* Vt = (LAS bf16_t*)(F.lds + 34816 + 18432);
    LAS float* Dc = (LAS float*)(F.lds + 34816 + 36864);
    const bf16_t* P1 = F_P1;
    float lbv = 0.f;
    if (l > 0) { const float x0 = F_lb_d[(0 * 2 + d) * 1024 + h * 128 + kk_], x1 = F_lb_d[(1 * 2 + d) * 1024 + h * 128 + kk_]; lbv = 1.0f / (1.0f + expf(x0 - x1)); }
    const int zcol = (d == 0 ? C_DFF : C_DFB) + h * 128 + kk_, qcol = C_DQ + h * 128 + kk_, vcol = C_DI + h * 128 + kk_;
    f32x4 S[8];
#pragma unroll
    for (int i = 0; i < 8; ++i) S[i] = (f32x4){0.f, 0.f, 0.f, 0.f};
    bf16_t* dscr = (d == 0) ? F_O + 3072 : F_DSCR; const size_t dstride = (d == 0) ? 4096 : 1024;
    const bool ctx_out = l < DEPTH - 1;
    unsigned short zr[16], qr[16], vr[16];
    auto geom = [&](int step, int& rowbase, int& t0) { const bool isc = step < 4; const int idx = isc ? step : step - 4, nch = isc ? 4 : 32, ci = (d == 0) ? idx : nch - 1 - idx; t0 = ci * 64; rowbase = isc ? b * CTXL : NCTX + b * SEQ; };
    auto ldraw = [&](int step) { int rowbase, t0; geom(step, rowbase, t0);
#pragma unroll
        for (int tt = 0; tt < 16; ++tt) { const int p = 16 * sc_ + tt; const size_t row = (size_t)(rowbase + t0 + (d == 0 ? p : 63 - p)); zr[tt] = P1[row * N1 + zcol]; qr[tt] = P1[row * N1 + qcol]; vr[tt] = P1[row * N1 + vcol]; } };
    ldraw(0);
    for (int step = 0; step < 36; ++step) {
        const bool isc = step < 4; int rowbase, t0; geom(step, rowbase, t0);
        { float kh[16]; float eb = 1.0f;
#pragma unroll
            for (int tt = 0; tt < 16; ++tt) { const int p = 16 * sc_ + tt;
                const float z = bf2f(zr[tt]), q = bf2f(qr[tt]);
                const float sg = sigmoidf_(z); const float f = lbv + (1.0f - lbv) * sg; eb = fmaxf(eb * f, 1e-35f);
                const float ebi = __builtin_amdgcn_rcpf(eb);
                kh[tt] = (1.0f - lbv) * (1.0f - sg) * ebi;
                Qt[p * 136 + kk_] = (bf16_t)(cvt_pk_bf16(q * eb, 0.f) & 0xffffu);
                Kh[p * 136 + kk_] = (bf16_t)(cvt_pk_bf16(kh[tt], 0.f) & 0xffffu); }
            const float ebl = eb;
            u32x4 k0, k1, v0, v1;
            k0.x = cvt_pk_bf16(kh[0] * ebl, kh[1] * ebl); k0.y = cvt_pk_bf16(kh[2] * ebl, kh[3] * ebl); k0.z = cvt_pk_bf16(kh[4] * ebl, kh[5] * ebl); k0.w = cvt_pk_bf16(kh[6] * ebl, kh[7] * ebl);
            k1.x = cvt_pk_bf16(kh[8] * ebl, kh[9] * ebl); k1.y = cvt_pk_bf16(kh[10] * ebl, kh[11] * ebl); k1.z = cvt_pk_bf16(kh[12] * ebl, kh[13] * ebl); k1.w = cvt_pk_bf16(kh[14] * ebl, kh[15] * ebl);
            v0.x = (unsigned)vr[0] | ((unsigned)vr[1] << 16); v0.y = (unsigned)vr[2] | ((unsigned)vr[3] << 16); v0.z = (unsigned)vr[4] | ((unsigned)vr[5] << 16); v0.w = (unsigned)vr[6] | ((unsigned)vr[7] << 16);
            v1.x = (unsigned)vr[8] | ((unsigned)vr[9] << 16); v1.y = (unsigned)vr[10] | ((unsigned)vr[11] << 16); v1.z = (unsigned)vr[12] | ((unsigned)vr[13] << 16); v1.w = (unsigned)vr[14] | ((unsigned)vr[15] << 16);
            *(LAS u32x4*)(KtT + kk_ * 72 + 16 * sc_) = k0; *(LAS u32x4*)(KtT + kk_ * 72 + 16 * sc_ + 8) = k1;
            *(LAS u32x4*)(Vt + kk_ * 72 + 16 * sc_) = v0; *(LAS u32x4*)(Vt + kk_ * 72 + 16 * sc_ + 8) = v1;
            Dc[sc_ * 128 + kk_] = ebl; }
        __syncthreads();
        if (step + 1 < 36) ldraw(step + 1);
        LAS u32x2* ATT = (LAS u32x2*)(F.lds + 73728);
        if (__builtin_amdgcn_readfirstlane(w) < 4) { const int sc = __builtin_amdgcn_readfirstlane(w); f32x4 att = (f32x4){0.f, 0.f, 0.f, 0.f};
#pragma unroll
            for (int ks = 0; ks < 4; ++ks) { const bf16x8 a = *(const LAS bf16x8*)(Kh + (16 * sc + fr) * 136 + 32 * ks + 8 * fq), bq = *(const LAS bf16x8*)(Qt + (16 * sc + fr) * 136 + 32 * ks + 8 * fq);
                att = __builtin_amdgcn_mfma_f32_16x16x32_bf16(a, bq, att, 0, 0, 0); }
#pragma unroll
            for (int rg = 0; rg < 4; ++rg) att[rg] = (4 * fq + rg <= fr) ? att[rg] : 0.f;
            ATT[sc * 64 + lane] = (u32x2){cvt_pk_bf16(att[0], att[1]), cvt_pk_bf16(att[2], att[3])}; }
        __syncthreads();
        u32x2 attb2[4];
#pragma unroll
        for (int sc = 0; sc < 4; ++sc) attb2[sc] = ATT[sc * 64 + lane];
#pragma unroll
        for (int sc = 0; sc < 4; ++sc) {
            f32x4 o = (f32x4){0.f, 0.f, 0.f, 0.f};
#pragma unroll
            for (int ks = 0; ks < 4; ++ks) { u32x4 sa; sa.x = cvt_pk_bf16(S[2 * ks][0], S[2 * ks][1]); sa.y = cvt_pk_bf16(S[2 * ks][2], S[2 * ks][3]); sa.z = cvt_pk_bf16(S[2 * ks + 1][0], S[2 * ks + 1][1]); sa.w = cvt_pk_bf16(S[2 * ks + 1][2], S[2 * ks + 1][3]);
                const u32x2 q0 = *(const LAS u32x2*)(Qt + (16 * sc + fr) * 136 + 32 * ks + 4 * fq), q1 = *(const LAS u32x2*)(Qt + (16 * sc + fr) * 136 + 32 * ks + 16 + 4 * fq);
                const u32x4 qb = (u32x4){q0.x, q0.y, q1.x, q1.y};
                o = __builtin_amdgcn_mfma_f32_16x16x32_bf16(__builtin_bit_cast(bf16x8, sa), __builtin_bit_cast(bf16x8, qb), o, 0, 0, 0); }
            const u32x2 v0 = *(const LAS u32x2*)(Vt + (16 * w + fr) * 72 + 16 * sc + 4 * fq);
            const float dA = Dc[sc * 128 + 16 * (fr >> 2) + 4 * fq + (fr & 3)], dB = Dc[sc * 128 + 64 + 16 * (fr >> 2) + 4 * fq + (fr & 3)];
            const u32x4 vb = (u32x4){v0.x, v0.y, 0u, 0u};
            o = __builtin_amdgcn_mfma_f32_16x16x32_bf16(__builtin_bit_cast(bf16x8, vb), __builtin_bit_cast(bf16x8, (u32x4){attb2[sc].x, attb2[sc].y, 0u, 0u}), o, 0, 0, 0);
            if (!isc || ctx_out) { const int p = 16 * sc + fr; const size_t row = (size_t)(rowbase + t0 + (d == 0 ? p : 63 - p));
                u32x2 ov; ov.x = cvt_pk_bf16(o[0], o[1]); ov.y = cvt_pk_bf16(o[2], o[3]); *(u32x2*)(dscr + row * dstride + h * 128 + 16 * w + 4 * fq) = ov; }
#define GLA_KT(KT) { gla_decay<KT>(S[KT], dA, dB); \
                const u32x2 ka = *(const LAS u32x2*)(KtT + (16 * KT + fr) * 72 + 16 * sc + 4 * fq); \
                S[KT] = __builtin_amdgcn_mfma_f32_16x16x32_bf16(__builtin_bit_cast(bf16x8, (u32x4){ka.x, ka.y, 0u, 0u}), __builtin_bit_cast(bf16x8, vb), S[KT], 0, 0, 0); }
            GLA_KT(0) GLA_KT(1) GLA_KT(2) GLA_KT(3) GLA_KT(4) GLA_KT(5) GLA_KT(6) GLA_KT(7)
#undef GLA_KT
        }
        __syncthreads();
    }
}
__device__ __forceinline__ void gla_finish(const Frame& F, int l) {
    const int gw = F.vcu * NWAVES + F.wave, NGW = F.G * NWAVES, lane = F.lane;
    const int row_lo = (l == DEPTH - 1) ? NCTX : 0;
    const int c0 = 16 * lane, hc = c0 & 127;
    float gn[16];
#pragma unroll
    for (int q = 0; q < 4; ++q) { const f32x4 g4 = *(const f32x4*)(F_onorm_d + l * 128 + hc + 4 * q); gn[4 * q] = g4.x; gn[4 * q + 1] = g4.y; gn[4 * q + 2] = g4.z; gn[4 * q + 3] = g4.w; }
    for (int row = row_lo + gw; row < NTOK; row += NGW) {
        bf16_t* op = F_O + (size_t)row * 4096 + 3072 + c0;
        const u32x4 a0 = *(const u32x4*)op, a1 = *(const u32x4*)(op + 8);
        const u32x4 b0 = *(const u32x4*)(F_DSCR + (size_t)row * 1024 + c0), b1 = *(const u32x4*)(F_DSCR + (size_t)row * 1024 + c0 + 8);
        const u32x4 g0 = *(const u32x4*)(F_P1 + (size_t)row * N1 + C_DG + c0), g1 = *(const u32x4*)(F_P1 + (size_t)row * N1 + C_DG + c0 + 8);
        const unsigned aw[8] = {a0.x, a0.y, a0.z, a0.w, a1.x, a1.y, a1.z, a1.w}, bw[8] = {b0.x, b0.y, b0.z, b0.w, b1.x, b1.y, b1.z, b1.w}, gw_[8] = {g0.x, g0.y, g0.z, g0.w, g1.x, g1.y, g1.z, g1.w};
        float o[16]; float ss = 0.f;
#pragma unroll
        for (int q = 0; q < 8; ++q) { o[2 * q] = bf_lo(aw[q]) + bf_lo(bw[q]); o[2 * q + 1] = bf_hi(aw[q]) + bf_hi(bw[q]); ss += o[2 * q] * o[2 * q] + o[2 * q + 1] * o[2 * q + 1]; }
        ss += shx(ss, 1, lane); ss += shx(ss, 2, lane); ss += shx(ss, 4, lane);
        const float rn = rsqrtf(ss * (1.0f / 128.0f) + 1e-6f);
        unsigned ow[8];
#pragma unroll
        for (int q = 0; q < 8; ++q) { const float ga = bf_lo(gw_[q]), gb = bf_hi(gw_[q]);
            ow[q] = cvt_pk_bf16(o[2 * q] * rn * gn[2 * q] * ga * sigmoidf_(ga), o[2 * q + 1] * rn * gn[2 * q + 1] * gb * sigmoidf_(gb)); }
        *(u32x4*)op = (u32x4){ow[0], ow[1], ow[2], ow[3]}; *(u32x4*)(op + 8) = (u32x4){ow[4], ow[5], ow[6], ow[7]};
    }
}
__device__ __forceinline__ void mix_phase(const Frame& F0, int l) {
    const Frame& F = F0;
    const bool ctx_out = l < DEPTH - 1;
    const int nBl = 8 * 8 * 16, nBc = ctx_out ? 8 * 8 * 2 : 0, nAl = 8 * 2 * 32, nAc = ctx_out ? 8 * 2 * 4 : 0;
    const int nC = ENABLE_C ? 128 : 0, nD = ENABLE_D ? 128 : 0;
    const int total = nC + nD + nBl + nBc + nAl + nAc;
    volatile LAS int* slot = (volatile LAS int*)(F.lds + MISC_OFF + 64);
    unsigned* head = F_ctl + CW_QUEUE + 64 * l;
    for (;;) {
        __syncthreads();
        if (F.tid == 0) *slot = (int)atomicAdd(head, 1u);
        __syncthreads();
        int q = *slot; q = __builtin_amdgcn_readfirstlane(q);
        if (q >= total) break;
        Frame U = F0;
        U.ws = opaque_ptr(F0.ws); U.out = opaque_ptr(F0.out); asm volatile("" : "+v"(U.tid)); U.lane = U.tid & 63;
        const Frame& F = U;
        AttnUnit u;
        if (q < nC) { lru_unit(F, l, q >> 4, (q >> 1) & 7, q & 1); continue; }
        q -= nC;
        if (q < nD) { gla_unit(F, l, q >> 4, (q >> 1) & 7, q & 1); continue; }
        q -= nD;
        if (q < nBl) { u.isA = false; u.isc = false; u.b = q >> 7; u.h = (q >> 4) & 7; u.qt = q & 15; attn_unit<false>(F, l, u); continue; }
        q -= nBl;
        if (q < nBc) { u.isA = false; u.isc = true; u.b = q >> 4; u.h = (q >> 1) & 7; u.qt = q & 1; attn_unit<false>(F, l, u); continue; }
        q -= nBc;
        if (q < nAl) { u.isA = true; u.isc = false; u.b = q >> 6; u.h = (q >> 5) & 1; u.qt = q & 31; attn_unit<true>(F, l, u); continue; }
        q -= nAl;
        { u.isA = true; u.isc = true; u.b = q >> 3; u.h = (q >> 2) & 1; u.qt = q & 3; attn_unit<true>(F, l, u); }
    }
}
__device__ __forceinline__ void zero_o_cols(const Frame& F, int c0, int c1) {
    const int w8 = (c1 - c0) / 8; const size_t gt = (size_t)F.vcu * NTHR + F.tid, NGT = (size_t)F.G * NTHR;
    unsigned z = 0u; asm volatile("" : "+v"(z));
    for (size_t i = gt; i < (size_t)NTOK * w8; i += NGT) { const size_t row = i / w8, c = i % w8; *(u32x4*)(F_O + row * 4096 + c0 + c * 8) = (u32x4){z, z, z, z}; }
}

constexpr int PH_P0 = 0, PH_PER_LAYER = 10, PH_FINAL = 1 + DEPTH * PH_PER_LAYER, N_PHASES = PH_FINAL + 1;
enum { L_NORM1 = 0, L_INPROJ, L_PREP, L_MIX, L_GATE, L_MERGE, L_OUT, L_NORM2, L_MOE1, L_MOE2 };
__global__ void __launch_bounds__(NTHR, 2) trunk_fwd(Args args) {
    extern __shared__ __attribute__((aligned(16))) unsigned char lds_raw[];
    Frame F;
    F.lds = (LAS unsigned char*)lds_raw;
    F.tid = threadIdx.x; F.lane = F.tid & 63; F.wave = __builtin_amdgcn_readfirstlane(F.tid >> 6);
    F.G = gridDim.x; { const int bx = blockIdx.x; F.vcu = (F.G % 8 == 0) ? (bx % 8) * (F.G / 8) + bx / 8 : bx; }
    F.a = &args; F.ws = args.ws; F.out = args.out;
    volatile LAS unsigned* MISC = (volatile LAS unsigned*)(F.lds + MISC_OFF);
    if (F.tid < 32) MISC[F.tid] = 0u;
    __syncthreads();
    const int lo = args.ph_lo, hi = args.ph_hi;
    XcdBarrier bar; bar.bar = F_ctl + CW_BAR; bar.x = 0; bar.st = nullptr;
    if (hi - lo > 1) bar = xcd_barrier_post(F_ctl + CW_BAR, MISC + 8);
#define IN(k) (lo <= (k) && (k) < hi)
#define SEAM(k) do { if (IN(k) && IN((k) + 1)) xcd_barrier(bar); } while (0)

    if (IN(PH_P0)) { { const Frame P = phase_frame(F); p0_mod(P); } { const Frame P = phase_frame(F); p0_weights(P); }
#if !ENABLE_MIX
        { const Frame P = phase_frame(F); p0_copy_x(P); }
#endif
    }
    SEAM(PH_P0);
    for (int l = 0; l < DEPTH; ++l) {
        const int base = 1 + l * PH_PER_LAYER;
        const int pm0 = (l == DEPTH - 1) ? 8 : 0;
        if (IN(base + L_NORM1)) { const Frame P = phase_frame(F); norm_phase<1>(P, l); }
        SEAM(base + L_NORM1);
#if ENABLE_MIX
        if (IN(base + L_INPROJ)) { const Frame Fo = F; const Frame F = phase_frame(Fo);
            PolDenseBf16 S; S.K = D; S.lda = D * 2; S.ldb = D * 2; S.A = (const char*)F_H; S.B = (const char*)(F_WIN + (size_t)l * INW * D); S.C = F_P1; S.ldc = N1; S.nM = 72; S.nN = 46; S.pm0 = 0; S.G = F.G; S.c = (int)blockIdx.x;
            g8::gemm_phase(F.lds, S, F.tid);
        }
        SEAM(base + L_INPROJ);
        if (IN(base + L_PREP)) { const Frame P = phase_frame(F); prep_phase(P, l); if (!ENABLE_C) zero_o_cols(P, 2048, 3072); if (!ENABLE_D) zero_o_cols(P, 3072, 4096); }
        SEAM(base + L_PREP);
        if (IN(base + L_MIX)) { const Frame P = phase_frame(F); mix_phase(P, l); }
        SEAM(base + L_MIX);
        if (IN(base + L_GATE)) { const Frame Fo = F; const Frame F = phase_frame(Fo);
            if (ENABLE_D) gla_finish(F, l);
            if (ENABLE_C) lru_finish(F, l);
            if (hi - lo > 1) xcd_barrier(bar);
            PolDenseBf16 S; S.K = D; S.lda = D * 2; S.ldb = D * 2; S.A = (const char*)F_H; S.B = (const char*)(F_WIN + ((size_t)l * INW + N1) * D); S.C = F_P1; S.ldc = NG; S.nM = 72 - pm0; S.nN = 32; S.pm0 = pm0; S.G = F.G; S.c = (int)blockIdx.x;
            g8::gemm_phase(F.lds, S, F.tid);
        }
        SEAM(base + L_GATE);
        if (IN(base + L_MERGE)) { const Frame Fo = F; const Frame F = phase_frame(Fo);
            PolMerge S; S.K = 1024; S.lda = 4096 * 2; S.ldb = 1024 * 2; S.A = (const char*)F_O; S.B = (const char*)(F_WBR + (size_t)l * 4 * D * 1024); S.Gt = F_P1; S.Yo = F_Y; S.nM = 64; S.pm0 = 8; S.G = F.G; S.c = (int)blockIdx.x;
            g8::gemm_phase(F.lds, S, F.tid);
        }
        SEAM(base + L_MERGE);
        if (IN(base + L_OUT)) {
            const bool split = (l < DEPTH - 1) && (F.G > 64);
            if (split && (int)blockIdx.x < 64) { const Frame Fo = F; const Frame F = phase_frame(Fo);
                PolMerge S; S.K = 1024; S.lda = 4096 * 2; S.ldb = 1024 * 2; S.A = (const char*)F_O; S.B = (const char*)(F_WBR + (size_t)l * 4 * D * 1024); S.Gt = F_P1; S.Yo = F_Y; S.nM = 8; S.pm0 = 0; S.G = 64; S.c = (int)blockIdx.x;
                g8::gemm_phase(F.lds, S, F.tid);
            } else { const Frame Fo = F; const Frame F = phase_frame(Fo);
                PolOut S; S.K = D; S.lda = D * 2; S.ldb = D * 2; S.A = (const char*)F_Y; S.B = (const char*)(F_WOUT + (size_t)l * D * D);
                S.xin_c = (l == 0) ? F_ctx : F_XC; S.xin_l = (l == 0) ? F_x : F.out; S.xout_c = F_XC; S.xout_l = F.out; S.mod_l = F_MOD + (size_t)l * 9 * 6 * D; S.nM = 64; S.pm0 = 8;
                S.G = split ? F.G - 64 : F.G; S.c = split ? (int)blockIdx.x - 64 : (int)blockIdx.x;
                g8::gemm_phase(F.lds, S, F.tid);
            }
            if (split) {
                if (hi - lo > 1) xcd_barrier(bar);
                const Frame Fo = F; const Frame F = phase_frame(Fo);
                PolOut S; S.K = D; S.lda = D * 2; S.ldb = D * 2; S.A = (const char*)F_Y; S.B = (const char*)(F_WOUT + (size_t)l * D * D);
                S.xin_c = (l == 0) ? F_ctx : F_XC; S.xin_l = (l == 0) ? F_x : F.out; S.xout_c = F_XC; S.xout_l = F.out; S.mod_l = F_MOD + (size_t)l * 9 * 6 * D; S.nM = 8; S.pm0 = 0; S.G = F.G; S.c = (int)blockIdx.x;
                g8::gemm_phase(F.lds, S, F.tid);
            }
        }
        SEAM(base + L_OUT);
#endif
        if (IN(base + L_NORM2)) { const Frame P = phase_frame(F); norm2_phase(P, l); }
        SEAM(base + L_NORM2);
        if (IN(base + L_MOE1)) { const Frame Fo = F; const Frame F = phase_frame(Fo);
            PolMoe<1> S; S.K = D; S.lda = D * 2; S.ldb = D * 2; S.A = (const char*)F_H; S.Bw = (const char*)(F_WGU + (size_t)l * NEXP * 1024 * D); S.C = (bf16_t*)(F.ws + WS_DSCR); S.list = F_LIST; S.nN = 4; S.G = F.G; S.c = (int)blockIdx.x; S.tab = (LAS int*)(F.lds + 131072); S.tid = F.tid;
            S.init(F_ctl + CW_CNT + 64 * l);
            g8::gemm_phase(F.lds, S, F.tid);
        }
        SEAM(base + L_MOE1);
        if (IN(base + L_MOE2)) { const Frame Fo = F; const Frame F = phase_frame(Fo);
            PolMoe<2> S; S.K = DFF; S.lda = DFF * 2; S.ldb = DFF * 2; S.A = (const char*)(F.ws + WS_DSCR); S.Bw = (const char*)(F_WD + (size_t)l * NEXP * D * DFF); S.C = F_O; S.list = F_LIST; S.nN = 8; S.G = F.G; S.c = (int)blockIdx.x; S.tab = (LAS int*)(F.lds + 131072); S.tid = F.tid;
            S.init(F_ctl + CW_CNT + 64 * l);
            g8::gemm_phase(F.lds, S, F.tid);
        }
        SEAM(base + L_MOE2);
        (void)pm0;
    }
    if (IN(PH_FINAL)) { const Frame P = phase_frame(F); norm_phase<3>(P, 0); }
#undef IN
#undef SEAM
}

extern "C" void kernel_launch(void* const* d_in, const int* in_sizes, int n_in, void* d_out, int out_size, void* d_ws, size_t ws_size, hipStream_t stream) {
    static int grid = 0;
    if (grid == 0) {
        if (n_in != 32 || out_size != NLAT * D || ws_size < WS_END) { fprintf(stderr, "kernel_launch: unexpected shapes (n_in %d, out %d, ws %zu)\n", n_in, out_size, ws_size); grid = -1; return; }
        int dev = 0, cus = 0, per_cu = 0;
        if (hipGetDevice(&dev) != hipSuccess || hipDeviceGetAttribute(&cus, hipDeviceAttributeMultiprocessorCount, dev) != hipSuccess) { grid = -1; return; }
        if (hipFuncSetAttribute((const void*)trunk_fwd, hipFuncAttributeMaxDynamicSharedMemorySize, LDS_BYTES) != hipSuccess) { fprintf(stderr, "kernel_launch: hipFuncSetAttribute failed\n"); grid = -1; return; }
        if (hipOccupancyMaxActiveBlocksPerMultiprocessor(&per_cu, (const void*)trunk_fwd, NTHR, LDS_BYTES) != hipSuccess || per_cu < 1) fprintf(stderr, "kernel_launch: occupancy query says %d\n", per_cu);
        (void)hipGetLastError();
        grid = cus;
    }
    if (grid < 0) return;
    if (hipMemsetAsync((char*)d_ws + WS_CTL, 0, CTL_ZERO_BYTES, stream) != hipSuccess) return;
    Args a{};
    for (int i = 0; i < 32; ++i) a.in[i] = (const float*)d_in[i];
    a.out = (float*)d_out; a.ws = (unsigned char*)d_ws;
#if N_LAUNCH_MODE == 1
    a.ph_lo = 0; a.ph_hi = N_PHASES;
    hipLaunchKernelGGL(trunk_fwd, dim3(grid), dim3(NTHR), LDS_BYTES, stream, a);
#else
    for (int p = 0; p < N_PHASES; ++p) {
        const int pl = (p - 1) % PH_PER_LAYER;
#if !ENABLE_MIX
        if (p >= 1 && p < PH_FINAL && pl >= L_INPROJ && pl <= L_OUT) continue;
#endif
        a.ph_lo = p; a.ph_hi = p + 1;
        hipLaunchKernelGGL(trunk_fwd, dim3(grid), dim3(NTHR), LDS_BYTES, stream, a);
    }
#endif
}
```
